# Optimizing an MI355X kernel written in HIP

```python
import math
import jax, jax.numpy as jnp
from jax import lax
import numpy as np

D_MODEL = 4096
BATCH = 1
SEQ = 16384
DEPTH = 2

N_META = 16
D_CONV = D_MODEL // 2
D_SSM = D_MODEL // 4
SSM_GROUP = 16
N_GROUPS = D_SSM // SSM_GROUP
SSM_STATE = 64
D_FF = 3 * D_MODEL
CONV_W = 3
N_IN = 3 * D_CONV + D_SSM + 2 * D_MODEL
EPS = 1e-6

kernel_name = "hybrid_conv_s5_gated_encoder"


def rmsnorm(x, g):
    x32 = x.astype(jnp.float32)
    y = x32 * lax.rsqrt(jnp.mean(x32 * x32, axis=-1, keepdims=True) + EPS)
    return (y * g.astype(jnp.float32)).astype(x.dtype)


def dwconv3(x, w):
    xp = jnp.pad(x, ((0, 0), (1, 1), (0, 0)))
    return xp[:, :-2] * w[0] + xp[:, 1:-1] * w[1] + xp[:, 2:] * w[2]


def _scan_combine(e1, e2):
    a1r, a1i, b1r, b1i = e1
    a2r, a2i, b2r, b2i = e2
    return (a2r * a1r - a2i * a1i,
            a2r * a1i + a2i * a1r,
            a2r * b1r - a2i * b1i + b2r,
            a2r * b1i + a2i * b1r + b2i)


def s5_direction(u, lam_re, lam_im, log_step, b_re, b_im, c_re, c_im, reverse):
    dt = jnp.exp(log_step)[:, None]
    mag = jnp.exp(lam_re * dt)
    abar_re = mag * jnp.cos(lam_im * dt)
    abar_im = mag * jnp.sin(lam_im * dt)
    nr, ni = abar_re - 1.0, abar_im
    den = lam_re * lam_re + lam_im * lam_im
    f_re = (nr * lam_re + ni * lam_im) / den
    f_im = (ni * lam_re - nr * lam_im) / den
    bb_re = f_re[..., None] * b_re - f_im[..., None] * b_im
    bb_im = f_re[..., None] * b_im + f_im[..., None] * b_re
    bu_re = jnp.einsum('blgh,gph->blgp', u, bb_re)
    bu_im = jnp.einsum('blgh,gph->blgp', u, bb_im)
    a_re = jnp.broadcast_to(abar_re, bu_re.shape)
    a_im = jnp.broadcast_to(abar_im, bu_re.shape)
    _, _, s_re, s_im = lax.associative_scan(
        _scan_combine, (a_re, a_im, bu_re, bu_im), axis=1, reverse=reverse)
    return (jnp.einsum('blgp,ghp->blgh', s_re, c_re)
            - jnp.einsum('blgp,ghp->blgh', s_im, c_im))


def setup_inputs(seed: int = 0) -> dict:
    key = jax.random.key(seed)
    ks = jax.random.split(key, 24)
    f32 = jnp.float32

    def nrm(k, shape, scale):
        return jax.random.normal(k, shape, f32) * scale

    n_idx = jnp.arange(SSM_STATE, dtype=f32)
    lam_re = -0.5 + nrm(ks[8], (DEPTH, 2, N_GROUPS, SSM_STATE), 0.01)
    lam_im = math.pi * n_idx + nrm(ks[9], (DEPTH, 2, N_GROUPS, SSM_STATE), 0.01)
    log_step = jax.random.uniform(ks[10], (DEPTH, 2, N_GROUPS), f32,
                                  math.log(1e-3), math.log(1e-1))
    return {
        "x": nrm(ks[0], (BATCH, SEQ, D_MODEL), 1.0),
        "meta_tokens": nrm(ks[1], (N_META, D_MODEL), 1.0),
        "norm_mix": 1.0 + nrm(ks[2], (DEPTH, D_MODEL), 0.02),
        "w_in": nrm(ks[3], (DEPTH, D_MODEL, N_IN), D_MODEL ** -0.5),
        "conv_a_w": nrm(ks[4], (DEPTH, CONV_W, D_CONV), CONV_W ** -0.5),
        "w_a": nrm(ks[5], (DEPTH, D_CONV, D_MODEL), D_CONV ** -0.5),
        "ssm_lambda_re": lam_re,
        "ssm_lambda_im": lam_im,
        "ssm_log_step": log_step,
        "ssm_b_re": nrm(ks[11], (DEPTH, 2, N_GROUPS, SSM_STATE, SSM_GROUP), (2 * SSM_GROUP) ** -0.5),
        "ssm_b_im": nrm(ks[12], (DEPTH, 2, N_GROUPS, SSM_STATE, SSM_GROUP), (2 * SSM_GROUP) ** -0.5),
        "ssm_c_re": nrm(ks[13], (DEPTH, 2, N_GROUPS, SSM_GROUP, SSM_STATE), 0.5),
        "ssm_c_im": nrm(ks[14], (DEPTH, 2, N_GROUPS, SSM_GROUP, SSM_STATE), 0.5),
        "ssm_d": nrm(ks[15], (DEPTH, D_SSM), 1.0),
        "w_glu": nrm(ks[16], (DEPTH, D_SSM, 2 * D_MODEL), D_SSM ** -0.5),
        "w_out": nrm(ks[17], (DEPTH, D_MODEL, D_MODEL), D_MODEL ** -0.5),
        "norm_ffn": 1.0 + nrm(ks[18], (DEPTH, D_MODEL), 0.02),
        "w_up": nrm(ks[19], (DEPTH, D_MODEL, 2 * D_FF), D_MODEL ** -0.5),
        "conv_ffn_w": nrm(ks[20], (DEPTH, CONV_W, 2 * D_FF), CONV_W ** -0.5),
        "w_down": nrm(ks[21], (DEPTH, D_FF, D_MODEL), D_FF ** -0.5),
        "norm_final": 1.0 + nrm(ks[22], (D_MODEL,), 0.02),
    }


def reference(x, meta_tokens, norm_mix, w_in, conv_a_w, w_a,
              ssm_lambda_re, ssm_lambda_im, ssm_log_step,
              ssm_b_re, ssm_b_im, ssm_c_re, ssm_c_im, ssm_d,
              w_glu, w_out, norm_ffn, w_up, conv_ffn_w, w_down, norm_final):
    bsz = x.shape[0]
    meta = jnp.broadcast_to(meta_tokens[None].astype(x.dtype), (bsz, N_META, D_MODEL))
    h_res = jnp.concatenate([meta, x], axis=1)
    L = h_res.shape[1]

    for l in range(DEPTH):
        h = rmsnorm(h_res, norm_mix[l])
        proj = h @ w_in[l]
        o = 0
        bg = proj[..., o:o + D_CONV]; o += D_CONV
        cg = proj[..., o:o + D_CONV]; o += D_CONV
        v = proj[..., o:o + D_CONV]; o += D_CONV
        u = proj[..., o:o + D_SSM]; o += D_SSM
        g_a = jax.nn.sigmoid(proj[..., o:o + D_MODEL]); o += D_MODEL
        g_b = jax.nn.sigmoid(proj[..., o:o + D_MODEL])

        y_a = (bg * dwconv3(cg * v, conv_a_w[l])) @ w_a[l]

        u32 = u.astype(jnp.float32).reshape(bsz, L, N_GROUPS, SSM_GROUP)
        lre = ssm_lambda_re[l].astype(jnp.float32)
        lim = ssm_lambda_im[l].astype(jnp.float32)
        lst = ssm_log_step[l].astype(jnp.float32)
        bre = ssm_b_re[l].astype(jnp.float32); bim = ssm_b_im[l].astype(jnp.float32)
        cre = ssm_c_re[l].astype(jnp.float32); cim = ssm_c_im[l].astype(jnp.float32)
        y_f = s5_direction(u32, lre[0], lim[0], lst[0], bre[0], bim[0], cre[0], cim[0], False)
        y_bw = s5_direction(u32, lre[1], lim[1], lst[1], bre[1], bim[1], cre[1], cim[1], True)
        s = (y_f + y_bw).reshape(bsz, L, D_SSM) + ssm_d[l].astype(jnp.float32) * u32.reshape(bsz, L, D_SSM)
        s = jax.nn.gelu(s).astype(x.dtype)
        glu = s @ w_glu[l]
        y_b = glu[..., :D_MODEL] * jax.nn.sigmoid(glu[..., D_MODEL:])

        h_res = h_res + (g_a * y_a + g_b * y_b) @ w_out[l]

        h = rmsnorm(h_res, norm_ffn[l])
        up = dwconv3(h @ w_up[l], conv_ffn_w[l])
        act = jax.nn.gelu(up[..., :D_FF]) * up[..., D_FF:]
        h_res = h_res + act @ w_down[l]

    out = rmsnorm(h_res, norm_final)
    return out[:, N_META:]
```

```cpp
#include <hip/hip_runtime.h>
#include <cstdio>
#include <cstdint>
namespace pg8 {
#define PG8_LAS __attribute__((address_space(3)))
typedef unsigned short bf16_t;
typedef short bf16x8 __attribute__((ext_vector_type(8)));
typedef float f32x4 __attribute__((ext_vector_type(4)));
typedef unsigned u32x4 __attribute__((ext_vector_type(4)));
typedef int i32x4 __attribute__((ext_vector_type(4)));
constexpr int BM = 256, BK = 64, HALF = 128, HTB = HALF * BK * 2  , STAGE_BYTES = 8 * HTB, NXCD = 8, WGM = 4;

__host__ __device__ __forceinline__ int lds_byte(int r, int c) { const int st = (r >> 4) * 2 + (c >> 5), rr = r & 15, cc = c & 31, ob = rr * 64 + cc * 2; return st * 1024 + (ob ^ (((ob >> 9) & 1) << 5)); }
__host__ __device__ __forceinline__ void stage_rc(int b, int& R, int& C) { const int st = b / 1024, sb = b % 1024, swz = sb ^ (((sb >> 9) & 1) << 5); R = (st >> 1) * 16 + swz / 64; C = (st & 1) * 32 + (swz % 64) / 2; }
__host__ __device__ __forceinline__ int perm32(int rho) { const int n = rho >> 4, i = rho & 15; return 8 * (i >> 2) + 4 * n + (i & 3); }

struct Unit { int pm, pn; };
struct Gemm { const bf16_t* A; const bf16_t* Bt; int M, N, K; };

struct StaticOrder {
    int nM, nN, nwg, G, c;
    __host__ __device__ void init(int M, int N, int G_, int c_) { nM = M / BM; nN = N / BM; nwg = nM * nN; G = G_; c = c_; }
    __host__ __device__ bool next(int i, Unit& u) const {
        const long L = (long)i * G + c; if (L >= nwg) return false;
        int wgid = (int)L; { const int q = nwg / NXCD, r = nwg % NXCD, xcd = wgid % NXCD, off = wgid / NXCD; wgid = (xcd < r ? xcd * (q + 1) : r * (q + 1) + (xcd - r) * q) + off; }
        const int nig = WGM * nN, gid = wgid / nig, fm = gid * WGM, gsz = (nM - fm) < WGM ? (nM - fm) : WGM;
        u.pm = fm + ((wgid % nig) % gsz); u.pn = (wgid % nig) / gsz; return true;
    }
    __device__ __forceinline__ void a_ready(const Unit&) const {}
    __device__ __forceinline__ void done(const Unit&) const {}
};

__device__ __forceinline__ unsigned cvt_pk_bf16(float lo, float hi) { unsigned r; asm volatile("v_cvt_pk_bf16_f32 %0, %1, %2" : "=v"(r) : "v"(lo), "v"(hi)); return r; }
typedef float f32x2 __attribute__((ext_vector_type(2)));
__device__ __forceinline__ f32x2 gelu_pk(f32x2 v) {
    const f32x2 av = __builtin_elementwise_abs(v), d = av * 0.2316418882f + 1.0f;
    f32x2 t; t.x = __builtin_amdgcn_rcpf(d.x); t.y = __builtin_amdgcn_rcpf(d.y);
    f32x2 q = t * 0.5307027145f + (-0.7265760135f); q = q * t + 0.7107068705f; q = q * t + (-0.142248368f); q = q * t + 0.127414796f; q = q * t;
    const f32x2 s = (v * v) * (-0.72134752044f);
    f32x2 e; e.x = __builtin_amdgcn_exp2f(s.x); e.y = __builtin_amdgcn_exp2f(s.y);
    const f32x2 m = v * (q * e), r = v - m;
    f32x2 o; o.x = v.x < 0.f ? m.x : r.x; o.y = v.y < 0.f ? m.y : r.y; return o;
}

template <int ACT  > struct EpiBf16 {
    static constexpr bool PERM = true, AFTER_DRAIN = false; static_assert(ACT == 0 || ACT == 1, "EpiBf16: ACT is 0 (none) or 1 (gelu_pk)");
    bf16_t* O; int ldc; const float* bias; int split_cols; size_t split_stride; float scale0;
    __device__ __forceinline__ void operator()(const f32x4 (&acc)[2][2][4][2], const Unit& u, int wr, int wc, int fr, int fq) const {
        const int row0 = u.pm * BM + wr * 64 + fr; int colt = u.pn * BM; bf16_t* base = O;
        float sc = 1.f; if (split_cols) { const int t = colt / split_cols; base += (size_t)t * split_stride; colt -= t * split_cols; if (t == 0) sc = scale0; }
        const int col0 = colt + wc * 32 + 8 * fq, bcol0 = u.pn * BM + wc * 32 + 8 * fq;
        f32x4 bv[2][2];
#pragma unroll
        for (int bj = 0; bj < 2; ++bj)
#pragma unroll
            for (int n = 0; n < 2; ++n) bv[bj][n] = bias ? *(const f32x4*)(bias + bcol0 + bj * HALF + 4 * n) : (f32x4){0.f, 0.f, 0.f, 0.f};
#pragma unroll
        for (int ai = 0; ai < 2; ++ai)
#pragma unroll
            for (int m = 0; m < 4; ++m) { bf16_t* rowp = base + (size_t)(row0 + ai * HALF + m * 16) * ldc + col0;
#pragma unroll
                for (int bj = 0; bj < 2; ++bj) { f32x4 v0 = acc[ai][bj][m][0] + bv[bj][0], v1 = acc[ai][bj][m][1] + bv[bj][1];
                    if (ACT == 1) { f32x2 a = gelu_pk((f32x2){v0[0], v0[1]}), b = gelu_pk((f32x2){v0[2], v0[3]}), c = gelu_pk((f32x2){v1[0], v1[1]}), d = gelu_pk((f32x2){v1[2], v1[3]});
                        v0 = (f32x4){a.x, a.y, b.x, b.y}; v1 = (f32x4){c.x, c.y, d.x, d.y}; }
                    v0 = v0 * sc; v1 = v1 * sc; u32x4 w; w.x = cvt_pk_bf16(v0[0], v0[1]); w.y = cvt_pk_bf16(v0[2], v0[3]); w.z = cvt_pk_bf16(v1[0], v1[1]); w.w = cvt_pk_bf16(v1[2], v1[3]);
                    *(u32x4*)(rowp + bj * HALF) = w; } }
    }
};
__host__ __device__ __forceinline__ size_t tix(int r, int c, int K) { return ((size_t)(r >> 8) * (size_t)(K >> 6) + (size_t)(c >> 6)) * 16384 + (size_t)((r & 255) * 64 + (c & 63)); }
__device__ __forceinline__ float sigm(float x) { return __builtin_amdgcn_rcpf(1.0f + __builtin_amdgcn_exp2f(-1.44269504089f * x)); }
__device__ __forceinline__ float sigm_pre(float t) { return __builtin_amdgcn_rcpf(1.0f + __builtin_amdgcn_exp2f(t)); }
__device__ __forceinline__ float gelu_t(float x) { const float u = x * __builtin_fmaf(-0.10294324f, x * x, -2.30220815f); return x * __builtin_amdgcn_rcpf(1.0f + __builtin_amdgcn_exp2f(u)); }
__device__ __forceinline__ bf16_t f2bf_s(float f) { unsigned u = __float_as_uint(f); return (bf16_t)((u + 0x7fffu + ((u >> 16) & 1u)) >> 16); }
__device__ __forceinline__ float bf2f_s(bf16_t b) { return __uint_as_float(((unsigned)b) << 16); }
__device__ __forceinline__ f32x4 bflo(unsigned a, unsigned b) { return (f32x4){__uint_as_float(a << 16), __uint_as_float(a & 0xffff0000u), __uint_as_float(b << 16), __uint_as_float(b & 0xffff0000u)}; }
__device__ __forceinline__ u32x4 pack8(f32x4 v0, f32x4 v1) { u32x4 w; w.x = cvt_pk_bf16(v0[0], v0[1]); w.y = cvt_pk_bf16(v0[2], v0[3]); w.z = cvt_pk_bf16(v1[0], v1[1]); w.w = cvt_pk_bf16(v1[2], v1[3]); return w; }

__device__ __forceinline__ void scale_rows(f32x4 (&acc)[2][2][4][2], const float* rstd, int row0) {
#pragma unroll
    for (int ai = 0; ai < 2; ++ai)
#pragma unroll
        for (int m = 0; m < 4; ++m) { const float rs = rstd[row0 + ai * HALF + m * 16];
#pragma unroll
            for (int bj = 0; bj < 2; ++bj)
#pragma unroll
                for (int n = 0; n < 2; ++n) acc[ai][bj][m][n] = acc[ai][bj][m][n] * rs; }
}

struct EpiIn {
    static constexpr bool PERM = true, AFTER_DRAIN = false;
    bf16_t *bg, *cv, *u, *ga, *gb; const float* rstd;
    __device__ __forceinline__ void operator()(f32x4 (&acc)[2][2][4][2], const Unit& un, int wr, int wc, int fr, int fq) const {
        const int pn = un.pn; const int row0 = un.pm * BM + wr * 64 + fr; const int cb = wc * 32 + 8 * fq;
        scale_rows(acc, rstd, row0);
        if (pn >= 8 && pn < 24) {
            bf16_t* base = cv + (size_t)row0 * 2048 + (pn - 8) * 128 + cb;
#pragma unroll
            for (int ai = 0; ai < 2; ++ai)
#pragma unroll
                for (int m = 0; m < 4; ++m) { bf16_t* rowp = base + (size_t)(ai * HALF + m * 16) * 2048;
                    *(u32x4*)rowp = pack8(acc[ai][0][m][0] * acc[ai][1][m][0], acc[ai][0][m][1] * acc[ai][1][m][1]); }
        } else {
            bf16_t* base; int ld; bool sg;
            if (pn < 8) { base = bg + pn * 256; ld = 2048; sg = false; }
            else if (pn < 28) { base = u + (pn - 24) * 256; ld = 1024; sg = false; }
            else if (pn < 44) { base = ga + (pn - 28) * 256; ld = 4096; sg = true; }
            else { base = gb + (pn - 44) * 256; ld = 4096; sg = true; }
            base += (size_t)row0 * ld + cb;
#pragma unroll
            for (int ai = 0; ai < 2; ++ai)
#pragma unroll
                for (int m = 0; m < 4; ++m) { bf16_t* rowp = base + (size_t)(ai * HALF + m * 16) * ld;
#pragma unroll
                    for (int bj = 0; bj < 2; ++bj) { f32x4 v0 = acc[ai][bj][m][0], v1 = acc[ai][bj][m][1];
                        if (sg) {
#pragma unroll
                            for (int j = 0; j < 4; ++j) { v0[j] = sigm_pre(v0[j]); v1[j] = sigm_pre(v1[j]); } }
                        *(u32x4*)(rowp + bj * HALF) = pack8(v0, v1); } }
        }
    }
    __device__ __forceinline__ void tail(int row, int pn, int c, float v0, float v1) const {
        { const float rs = rstd[row]; v0 *= rs; v1 *= rs; }
        if (pn >= 8 && pn < 24) { cv[(size_t)row * 2048 + (pn - 8) * 128 + c] = f2bf_s(v0 * v1); return; }
        bf16_t* base; int ld; bool sg;
        if (pn < 8) { base = bg + pn * 256; ld = 2048; sg = false; }
        else if (pn < 28) { base = u + (pn - 24) * 256; ld = 1024; sg = false; }
        else if (pn < 44) { base = ga + (pn - 28) * 256; ld = 4096; sg = true; }
        else { base = gb + (pn - 44) * 256; ld = 4096; sg = true; }
        if (sg) { v0 = sigm_pre(v0); v1 = sigm_pre(v1); }
        base[(size_t)row * ld + c] = f2bf_s(v0); base[(size_t)row * ld + 128 + c] = f2bf_s(v1);
    }
};
struct EpiGate8 {
    static constexpr bool PERM = true, AFTER_DRAIN = false;
    EpiIn e; const float* colscale;
    __device__ __forceinline__ void operator()(f32x4 (&acc)[2][2][4][2], const Unit& un, int wr, int wc, int fr, int fq) const {
        const int cb = wc * 32 + 8 * fq;
#pragma unroll
        for (int bj = 0; bj < 2; ++bj)
#pragma unroll
            for (int n = 0; n < 2; ++n) { const f32x4 cs = *(const f32x4*)(colscale + un.pn * 256 + bj * HALF + cb + 4 * n);
#pragma unroll
                for (int ai = 0; ai < 2; ++ai)
#pragma unroll
                    for (int m = 0; m < 4; ++m) { const i32x4 iv = __builtin_bit_cast(i32x4, acc[ai][bj][m][n]); acc[ai][bj][m][n] = (f32x4){(float)iv[0], (float)iv[1], (float)iv[2], (float)iv[3]} * cs; } }
        Unit u2 = un; u2.pn += 28; e(acc, u2, wr, wc, fr, fq);
    }
    __device__ __forceinline__ void tail(int row, int pn, int c, float v0, float v1) const { e.tail(row, pn + 28, c, v0 * colscale[pn * 256 + c], v1 * colscale[pn * 256 + 128 + c]); }
};
struct EpiMulGate {
    static constexpr bool PERM = true, AFTER_DRAIN = false;
    const bf16_t* ga; bf16_t* m1;
    __device__ __forceinline__ void operator()(const f32x4 (&acc)[2][2][4][2], const Unit& un, int wr, int wc, int fr, int fq) const {
        const unsigned off0 = ((unsigned)(un.pm * BM + wr * 64 + fr) * 4096u + (unsigned)(un.pn * 256 + wc * 32 + 8 * fq)) * 2u;
        u32x4 g[2][4][2];
#pragma unroll
        for (int ai = 0; ai < 2; ++ai)
#pragma unroll
            for (int m = 0; m < 4; ++m)
#pragma unroll
                for (int bj = 0; bj < 2; ++bj) g[ai][m][bj] = *(const u32x4*)((const char*)ga + (size_t)(off0 + (unsigned)((ai * HALF + m * 16) * 8192 + bj * 256)));
#pragma unroll
        for (int ai = 0; ai < 2; ++ai)
#pragma unroll
            for (int m = 0; m < 4; ++m)
#pragma unroll
                for (int bj = 0; bj < 2; ++bj) { const u32x4 gg = g[ai][m][bj];
                    *(u32x4*)((char*)m1 + (size_t)(off0 + (unsigned)((ai * HALF + m * 16) * 8192 + bj * 256))) = pack8(acc[ai][bj][m][0] * bflo(gg.x, gg.y), acc[ai][bj][m][1] * bflo(gg.z, gg.w)); }
    }
    __device__ __forceinline__ void tail(int row, int pn, int c, float v0, float v1) const {
        const size_t o = (size_t)row * 4096 + pn * 256 + c;
        m1[o] = f2bf_s(v0 * bf2f_s(ga[o])); m1[o + 128] = f2bf_s(v1 * bf2f_s(ga[o + 128]));
    }
};
struct EpiGlu {
    static constexpr bool PERM = true, AFTER_DRAIN = false;
    const bf16_t* gb; const bf16_t* m1; bf16_t* mm;
    __device__ __forceinline__ void operator()(const f32x4 (&acc)[2][2][4][2], const Unit& un, int wr, int wc, int fr, int fq) const {
        const unsigned off0 = ((unsigned)(un.pm * BM + wr * 64 + fr) * 4096u + (unsigned)(un.pn * 128 + wc * 32 + 8 * fq)) * 2u;
        const size_t moff0 = (((size_t)un.pm * 64 + (size_t)(un.pn * 2 + (wc >> 1))) * 16384 + (size_t)((wr * 64 + fr) * 64 + (wc & 1) * 32 + 8 * fq)) * 2;
        u32x4 g[2][4], o[2][4];
#pragma unroll
        for (int ai = 0; ai < 2; ++ai)
#pragma unroll
            for (int m = 0; m < 4; ++m) { const size_t off = (size_t)(off0 + (unsigned)((ai * HALF + m * 16) * 8192));
                g[ai][m] = *(const u32x4*)((const char*)gb + off); o[ai][m] = *(const u32x4*)((const char*)m1 + off); }
#pragma unroll
        for (int ai = 0; ai < 2; ++ai)
#pragma unroll
            for (int m = 0; m < 4; ++m) { const size_t off = (size_t)(off0 + (unsigned)((ai * HALF + m * 16) * 8192));
                f32x4 y0 = acc[ai][0][m][0], y1 = acc[ai][0][m][1]; const f32x4 t0 = acc[ai][1][m][0], t1 = acc[ai][1][m][1];
#pragma unroll
                for (int j = 0; j < 4; ++j) { y0[j] *= sigm(t0[j]); y1[j] *= sigm(t1[j]); }
                const u32x4 gg = g[ai][m], oo = o[ai][m];
                *(u32x4*)((char*)mm + moff0 + (size_t)((ai * HALF + m * 16) * 128)) = pack8(bflo(oo.x, oo.y) + bflo(gg.x, gg.y) * y0, bflo(oo.z, oo.w) + bflo(gg.z, gg.w) * y1); }
    }
    __device__ __forceinline__ void tail(int row, int pn, int c, float v0, float v1) const {
        const size_t o = (size_t)row * 4096 + pn * 128 + c;
        mm[tix(row, pn * 128 + c, 4096)] = f2bf_s(bf2f_s(m1[o]) + bf2f_s(gb[o]) * v0 * sigm(v1));
    }
};
struct EpiStoreDelta {
    static constexpr bool PERM = true, AFTER_DRAIN = false;
    bf16_t* dl;
    __device__ __forceinline__ void operator()(const f32x4 (&acc)[2][2][4][2], const Unit& un, int wr, int wc, int fr, int fq) const {
        const unsigned off0 = ((unsigned)(un.pm * BM + wr * 64 + fr) * 4096u + (unsigned)(un.pn * BM + wc * 32 + 8 * fq)) * 2u;
#pragma unroll
        for (int ai = 0; ai < 2; ++ai)
#pragma unroll
            for (int m = 0; m < 4; ++m)
#pragma unroll
                for (int bj = 0; bj < 2; ++bj) *(u32x4*)((char*)dl + (size_t)(off0 + (unsigned)((ai * HALF + m * 16) * 8192 + bj * 256))) = pack8(acc[ai][bj][m][0], acc[ai][bj][m][1]);
    }
    __device__ __forceinline__ void tail(int row, int pn, int c, float v0, float v1) const {
        const size_t o = (size_t)row * 4096 + pn * 256 + c; dl[o] = f2bf_s(v0); dl[o + 128] = f2bf_s(v1);
    }
};
struct EpiResid {
    static constexpr bool PERM = true, AFTER_DRAIN = false;
    bf16_t* hres; bf16_t* dl; bool add;
    __device__ __forceinline__ void operator()(const f32x4 (&acc)[2][2][4][2], const Unit& un, int wr, int wc, int fr, int fq) const {
        if (add) {
            const unsigned off0 = (((unsigned)un.pm * 64u + (unsigned)(un.pn * 4 + (wc >> 1))) * 16384u + (unsigned)((wr * 64 + fr) * 64 + (wc & 1) * 32 + 8 * fq)) * 2u;
            u32x4 h[2][4][2];
#pragma unroll
            for (int ai = 0; ai < 2; ++ai)
#pragma unroll
                for (int m = 0; m < 4; ++m)
#pragma unroll
                    for (int bj = 0; bj < 2; ++bj) h[ai][m][bj] = *(const u32x4*)((const char*)hres + (size_t)(off0 + (unsigned)((ai * HALF + m * 16) * 128 + bj * 65536)));
#pragma unroll
            for (int ai = 0; ai < 2; ++ai)
#pragma unroll
                for (int m = 0; m < 4; ++m)
#pragma unroll
                    for (int bj = 0; bj < 2; ++bj) { const u32x4 hh = h[ai][m][bj];
                        *(u32x4*)((char*)hres + (size_t)(off0 + (unsigned)((ai * HALF + m * 16) * 128 + bj * 65536))) = pack8(acc[ai][bj][m][0] + bflo(hh.x, hh.y), acc[ai][bj][m][1] + bflo(hh.z, hh.w)); }
        } else {
            const unsigned off0 = ((unsigned)(un.pm * BM + wr * 64 + fr) * 4096u + (unsigned)(un.pn * BM + wc * 32 + 8 * fq)) * 2u;
#pragma unroll
            for (int ai = 0; ai < 2; ++ai)
#pragma unroll
                for (int m = 0; m < 4; ++m)
#pragma unroll
                    for (int bj = 0; bj < 2; ++bj) *(u32x4*)((char*)dl + (size_t)(off0 + (unsigned)((ai * HALF + m * 16) * 8192 + bj * 256))) = pack8(acc[ai][bj][m][0], acc[ai][bj][m][1]);
        }
    }
    __device__ __forceinline__ void tail(int row, int pn, int c, float v0, float v1) const {
        if (add) { const size_t i0 = tix(row, pn * 256 + c, 4096), i1 = tix(row, pn * 256 + 128 + c, 4096); hres[i0] = f2bf_s(bf2f_s(hres[i0]) + v0); hres[i1] = f2bf_s(bf2f_s(hres[i1]) + v1); }
        else { const size_t o = (size_t)row * 4096 + pn * 256 + c; dl[o] = f2bf_s(v0); dl[o + 128] = f2bf_s(v1); }
    }
};
template <int N> __device__ __forceinline__ float dpp_ror(float v) { return __builtin_bit_cast(float, __builtin_amdgcn_mov_dpp(__builtin_bit_cast(int, v), 0x120 + N, 0xf, 0xf, true)); }
struct EpiUpConv {
    static constexpr bool PERM = true, AFTER_DRAIN = false;
    const float* cw; bf16_t* act; float* zedge; PG8_LAS float* xch;
    __device__ __forceinline__ void operator()(f32x4 (&acc)[2][2][4][2], const Unit& un, int wr, int wc, int fr, int fq) const {
        const int cb = wc * 32 + 8 * fq;
        scale_rows(acc, rstd, un.pm * BM + wr * 64 + fr);
        const int lprev = (fq << 4) | ((fr + 15) & 15), lnext = (fq << 4) | ((fr + 1) & 15);
#pragma unroll
        for (int ai = 0; ai < 2; ++ai) { const int b = 2 * ai + wr;
            if (fr == 0) {
#pragma unroll
                for (int bj = 0; bj < 2; ++bj)
#pragma unroll
                    for (int n = 0; n < 2; ++n) *(PG8_LAS f32x4*)(xch + ((b * 2 + 0) * 2 + bj) * 128 + cb + 4 * n) = acc[ai][bj][0][n]; }
            if (fr == 15) {
#pragma unroll
                for (int bj = 0; bj < 2; ++bj)
#pragma unroll
                    for (int n = 0; n < 2; ++n) *(PG8_LAS f32x4*)(xch + ((b * 2 + 1) * 2 + bj) * 128 + cb + 4 * n) = acc[ai][bj][3][n]; } }
        if (wr == 0 && fr < 2) { const unsigned zo = ((unsigned)(un.pm * 4 + fr) * 24576u + (unsigned)(un.pn * 256 + cb)) * 4u;
#pragma unroll
            for (int bj = 0; bj < 2; ++bj)
#pragma unroll
                for (int n = 0; n < 2; ++n) *(f32x4*)((char*)zedge + (size_t)(zo + (unsigned)(bj * 512 + 16 * n))) = acc[0][bj][0][n]; }
        if (wr == 1 && fr >= 14) { const unsigned zo = ((unsigned)(un.pm * 4 + 2 + (fr - 14)) * 24576u + (unsigned)(un.pn * 256 + cb)) * 4u;
#pragma unroll
            for (int bj = 0; bj < 2; ++bj)
#pragma unroll
                for (int n = 0; n < 2; ++n) *(f32x4*)((char*)zedge + (size_t)(zo + (unsigned)(bj * 512 + 16 * n))) = acc[1][bj][3][n]; }
        asm volatile("s_waitcnt lgkmcnt(0)" ::: "memory"); __builtin_amdgcn_s_barrier(); asm volatile("" ::: "memory");
        const int ch0 = un.pn * 128 + cb; const unsigned wo = (unsigned)ch0 * 4u;
        const unsigned ao0 = (((unsigned)un.pm * 192u + (unsigned)(un.pn * 2 + (wc >> 1))) * 16384u + (unsigned)((64 * wr + fr) * 64 + (wc & 1) * 32 + 8 * fq)) * 2u;
#pragma unroll
        for (int ai = 0; ai < 2; ++ai) { const int b = 2 * ai + wr;
            const PG8_LAS float* hpp = xch + (((b > 0 ? b - 1 : 0) * 2 + 1) * 2) * 128 + cb;
            const PG8_LAS float* hnp = xch + (((b < 3 ? b + 1 : 3) * 2 + 0) * 2) * 128 + cb;
            unsigned pkw[4][4];
#pragma unroll
            for (int nj = 0; nj < 4; ++nj) { const int n = nj >> 1, jp = nj & 1;
                float o[4][2];
                f32x2 wg[3], wv[3];
#pragma unroll
                for (int k = 0; k < 3; ++k) { wg[k] = *(const f32x2*)((const char*)(cw + k * 24576) + (size_t)wo + 8 * nj); wv[k] = *(const f32x2*)((const char*)(cw + k * 24576 + 12288) + (size_t)wo + 8 * nj); }
#pragma unroll
                for (int jj = 0; jj < 2; ++jj) { const int j = 2 * jp + jj;
                    float cg[4], cv[4];
#pragma unroll
                    for (int bj = 0; bj < 2; ++bj) {
                        float P[4], Nx[4];
#pragma unroll
                        for (int m = 0; m < 4; ++m) { P[m] = dpp_ror<1>(acc[ai][bj][m][n][j]); Nx[m] = dpp_ror<15>(acc[ai][bj][m][n][j]); }
                        const float hp = (b > 0) ? hpp[bj * 128 + 4 * n + j] : 0.f, hn = (b < 3) ? hnp[bj * 128 + 4 * n + j] : 0.f;
                        const float w0 = bj ? wv[0][jj] : wg[0][jj], w1 = bj ? wv[1][jj] : wg[1][jj], w2 = bj ? wv[2][jj] : wg[2][jj];
#pragma unroll
                        for (int m = 0; m < 4; ++m) {
                            const float up = (fr > 0) ? P[m] : (m > 0 ? P[m > 0 ? m - 1 : 0] : hp);
                            const float dn = (fr < 15) ? Nx[m] : (m < 3 ? Nx[m < 3 ? m + 1 : 3] : hn);
                            const float r = w0 * up + w1 * acc[ai][bj][m][n][j] + w2 * dn;
                            if (bj == 0) cg[m] = r; else cv[m] = r; }
                    }
#pragma unroll
                    for (int m = 0; m < 4; ++m) o[m][jj] = gelu_t(cg[m]) * cv[m];
                    __builtin_amdgcn_sched_barrier(0);
                }
#pragma unroll
                for (int m = 0; m < 4; ++m) pkw[m][nj] = cvt_pk_bf16(o[m][0], o[m][1]);
            }
#pragma unroll
            for (int m = 0; m < 4; ++m) { const int tr = 128 * ai + 64 * wr + 16 * m + fr;
                if (tr != 0 && tr != 255) *(u32x4*)((char*)act + (size_t)(ao0 + (unsigned)((128 * ai + 16 * m) * 128))) = (u32x4){pkw[m][0], pkw[m][1], pkw[m][2], pkw[m][3]}; }
            asm volatile("" ::: "memory");
        }
    }
    float* ztail;
    const float* rstd; const float* colscale;
    __device__ __forceinline__ void tail(int row, int pn, int c, float v0, float v1) const {
        { const float rs = rstd[row]; v0 *= rs; v1 *= rs; }
        if (colscale) { v0 *= colscale[pn * 256 + c]; v1 *= colscale[pn * 256 + 128 + c]; }
        float* z = ztail + (size_t)(row - 16384) * 24576 + pn * 256 + c; z[0] = v0; z[128] = v1;
    }
};

struct EpiUp8 {
    static constexpr bool PERM = true, AFTER_DRAIN = false;
    EpiUpConv e;
    __device__ __forceinline__ void operator()(f32x4 (&acc)[2][2][4][2], const Unit& un, int wr, int wc, int fr_, int fq_) const {
        int fr = fr_, fq = fq_; asm volatile("" : "+v"(fr), "+v"(fq));
        const int cb = wc * 32 + 8 * fq;
#pragma unroll
        for (int bj = 0; bj < 2; ++bj)
#pragma unroll
            for (int n = 0; n < 2; ++n) { const f32x4 cs = *(const f32x4*)(e.colscale + un.pn * 256 + bj * HALF + cb + 4 * n);
#pragma unroll
                for (int ai = 0; ai < 2; ++ai)
#pragma unroll
                    for (int m = 0; m < 4; ++m) { const i32x4 iv = __builtin_bit_cast(i32x4, acc[ai][bj][m][n]); acc[ai][bj][m][n] = (f32x4){(float)iv[0], (float)iv[1], (float)iv[2], (float)iv[3]} * cs; } }
        e(acc, un, wr, wc, fr, fq);
    }
    __device__ __forceinline__ void tail(int row, int pn, int c, float v0, float v1) const { e.tail(row, pn, c, v0, v1); }
};

template <class Epi, bool TB = false, bool I8 = false>
__device__ __forceinline__ void tail_gemm(PG8_LAS unsigned char* lds, const bf16_t* A  , const bf16_t* Bt, int N, int K, int row0, const Epi& E) {
    int tid_ = threadIdx.x; asm volatile("" : "+v"(tid_));
    const int tid = tid_, wid = __builtin_amdgcn_readfirstlane(tid >> 6), lane = tid & 63, r16 = lane & 15, q = lane >> 4;
    const int nitems = (N >> 8) * 8, kw = K >> 3, nks = kw >> 5;
    PG8_LAS f32x4* red = (PG8_LAS f32x4*)lds;
    for (int item = blockIdx.x; item < nitems; item += gridDim.x) {
        const int pn = item >> 3, s8 = item & 7;
        const bf16_t* ap = A + tix(row0 + r16, wid * kw, K) + 8 * q;
        const bf16_t* b0 = TB ? Bt + ((size_t)pn * (K >> 6) + ((wid * kw) >> 6)) * 16384 + (s8 * 16 + r16) * 64 + 8 * q : Bt + (size_t)(pn * 256 + s8 * 16 + r16) * K + wid * kw + 8 * q;
        const bf16_t* b1 = b0 + (TB ? (size_t)128 * 64 : (size_t)128 * K);
        f32x4 c0 = (f32x4){0.f, 0.f, 0.f, 0.f}, c1 = (f32x4){0.f, 0.f, 0.f, 0.f};
        int ks = 0;
        for (; ks + 8 <= nks; ks += 8) {
            bf16x8 a[8], x0[8], x1[8];
#pragma unroll
            for (int i = 0; i < 8; ++i) { a[i] = *(const bf16x8*)(ap + ((ks + i) >> 1) * 16384 + ((ks + i) & 1) * 32); const int ko = TB ? ((ks + i) >> 1) * 16384 + ((ks + i) & 1) * 32 : (ks + i) * 32; x0[i] = *(const bf16x8*)(b0 + ko); x1[i] = *(const bf16x8*)(b1 + ko); }
#pragma unroll
            for (int i = 0; i < 8; ++i) { if constexpr (I8) { c0 = __builtin_bit_cast(f32x4, __builtin_amdgcn_mfma_i32_16x16x64_i8(__builtin_bit_cast(i32x4, a[i]), __builtin_bit_cast(i32x4, x0[i]), __builtin_bit_cast(i32x4, c0), 0, 0, 0)); c1 = __builtin_bit_cast(f32x4, __builtin_amdgcn_mfma_i32_16x16x64_i8(__builtin_bit_cast(i32x4, a[i]), __builtin_bit_cast(i32x4, x1[i]), __builtin_bit_cast(i32x4, c1), 0, 0, 0)); } else { c0 = __builtin_amdgcn_mfma_f32_16x16x32_bf16(a[i], x0[i], c0, 0, 0, 0); c1 = __builtin_amdgcn_mfma_f32_16x16x32_bf16(a[i], x1[i], c1, 0, 0, 0); } }
        }
        for (; ks < nks; ks += 4) {
            bf16x8 a[4], x0[4], x1[4];
#pragma unroll
            for (int i = 0; i < 4; ++i) { a[i] = *(const bf16x8*)(ap + ((ks + i) >> 1) * 16384 + ((ks + i) & 1) * 32); const int ko = TB ? ((ks + i) >> 1) * 16384 + ((ks + i) & 1) * 32 : (ks + i) * 32; x0[i] = *(const bf16x8*)(b0 + ko); x1[i] = *(const bf16x8*)(b1 + ko); }
#pragma unroll
            for (int i = 0; i < 4; ++i) { if constexpr (I8) { c0 = __builtin_bit_cast(f32x4, __builtin_amdgcn_mfma_i32_16x16x64_i8(__builtin_bit_cast(i32x4, a[i]), __builtin_bit_cast(i32x4, x0[i]), __builtin_bit_cast(i32x4, c0), 0, 0, 0)); c1 = __builtin_bit_cast(f32x4, __builtin_amdgcn_mfma_i32_16x16x64_i8(__builtin_bit_cast(i32x4, a[i]), __builtin_bit_cast(i32x4, x1[i]), __builtin_bit_cast(i32x4, c1), 0, 0, 0)); } else { c0 = __builtin_amdgcn_mfma_f32_16x16x32_bf16(a[i], x0[i], c0, 0, 0, 0); c1 = __builtin_amdgcn_mfma_f32_16x16x32_bf16(a[i], x1[i], c1, 0, 0, 0); } }
        }
        if constexpr (I8) { const i32x4 i0 = __builtin_bit_cast(i32x4, c0), i1 = __builtin_bit_cast(i32x4, c1); c0 = (f32x4){(float)i0[0], (float)i0[1], (float)i0[2], (float)i0[3]}; c1 = (f32x4){(float)i1[0], (float)i1[1], (float)i1[2], (float)i1[3]}; }
        red[(wid * 2 + 0) * 64 + lane] = c0; red[(wid * 2 + 1) * 64 + lane] = c1;
        asm volatile("s_waitcnt lgkmcnt(0)" ::: "memory"); __builtin_amdgcn_s_barrier(); asm volatile("" ::: "memory");
        if (tid < 256) {
            const int row = tid >> 4, col = tid & 15, sl = col + 16 * (row >> 2), el = row & 3; float v0 = 0.f, v1 = 0.f;
#pragma unroll
            for (int w = 0; w < 8; ++w) { v0 += ((const PG8_LAS float*)(red + (w * 2 + 0) * 64 + sl))[el]; v1 += ((const PG8_LAS float*)(red + (w * 2 + 1) * 64 + sl))[el]; }
            E.tail(row0 + row, pn, s8 * 16 + col, v0, v1);
        }
        asm volatile("s_waitcnt lgkmcnt(0)" ::: "memory"); __builtin_amdgcn_s_barrier(); asm volatile("" ::: "memory");
    }
}
template <class Epi, class Sched, bool ALIGN_EPI = false, bool SP2 = false, bool TA = false, bool TB = false, bool I8 = false>
__device__ __forceinline__ void gemm_phase(PG8_LAS unsigned char* lds, const Gemm g, const Sched& S, const Epi& E) {
    int tid_ = threadIdx.x; asm volatile("" : "+v"(tid_));
    const int tid = tid_, wid = __builtin_amdgcn_readfirstlane(tid >> 6), lane = tid & 63, wr = wid >> 2, wc = wid & 3, fr = lane & 15, fq = lane >> 4;
    const int K = g.K, nt = K / BK;
    unsigned voffA[2], voffB[2];
#pragma unroll
    for (int i = 0; i < 2; ++i) { int R, C; stage_rc(tid * 16 + i * 8192, R, C); const int Rb = Epi::PERM ? ((R & ~31) + perm32(R & 31)) : R;
        voffA[i] = (unsigned)(R * (TA ? 64 : K) + C) * 2u; voffB[i] = (unsigned)(Rb * (TB ? 64 : K) + C) * 2u; }
    const size_t kstepA = TA ? (size_t)(BM * BK * 2) : (size_t)(BK * 2), kstepB = TB ? (size_t)(BM * BK * 2) : (size_t)(BK * 2);
    const size_t hstepA = TA ? (size_t)(HALF * BK * 2) : (size_t)HALF * K * 2, hstepB = TB ? (size_t)(HALF * BK * 2) : (size_t)HALF * K * 2;
    const size_t tstep = (size_t)BM * K * 2;
    const unsigned ldsw = (unsigned)wid * 1024u;
    const int aoff = lds_byte(wr * 64 + fr, fq * 8), boff = lds_byte(wc * 32 + fr, fq * 8);
#define PG8_SA(b, h) (((b) * 2 + (h)) * HTB)
#define PG8_SB(b, h) ((4 + (b) * 2 + (h)) * HTB)
#define PG8_STAGE(bufoff, gbase, voff) do { _Pragma("unroll") for (int _i = 0; _i < 2; ++_i) \
        __builtin_amdgcn_global_load_lds((const unsigned*)((const char*)(gbase) + (voff)[_i]), (PG8_LAS unsigned*)(lds + (bufoff) + ldsw + _i * 8192), 16, 0, 0); } while (0)
#define PG8_LDA(dst, b, h) do { _Pragma("unroll") for (int m = 0; m < 4; ++m) _Pragma("unroll") for (int k = 0; k < 2; ++k) dst[m][k] = *(const PG8_LAS bf16x8*)(lds + PG8_SA(b, h) + aoff + m * 2048 + k * 1024); } while (0)
#define PG8_LDB(dst, b, h) do { _Pragma("unroll") for (int n = 0; n < 2; ++n) _Pragma("unroll") for (int k = 0; k < 2; ++k) dst[n][k] = *(const PG8_LAS bf16x8*)(lds + PG8_SB(b, h) + boff + n * 2048 + k * 1024); } while (0)
#define PG8_MMA(ai, bj, At, Bt) do { __builtin_amdgcn_s_setprio(1); _Pragma("unroll") for (int m = 0; m < 4; ++m) _Pragma("unroll") for (int n = 0; n < 2; ++n) _Pragma("unroll") for (int k = 0; k < 2; ++k) \
        { if constexpr (I8) acc[ai][bj][m][n] = __builtin_bit_cast(f32x4, __builtin_amdgcn_mfma_i32_16x16x64_i8(__builtin_bit_cast(i32x4, Bt[n][k]), __builtin_bit_cast(i32x4, At[m][k]), __builtin_bit_cast(i32x4, acc[ai][bj][m][n]), 0, 0, 0)); \
          else acc[ai][bj][m][n] = __builtin_amdgcn_mfma_f32_16x16x32_bf16(Bt[n][k], At[m][k], acc[ai][bj][m][n], 0, 0, 0); } __builtin_amdgcn_s_setprio(0); } while (0)
#define PG8_WAIT_V(n) asm volatile("s_waitcnt vmcnt(" #n ")" ::: "memory")
#define PG8_WAIT_L(n) asm volatile("s_waitcnt lgkmcnt(" #n ")" ::: "memory")
#define PG8_BAR __builtin_amdgcn_s_barrier()
#define PG8_SCHED __builtin_amdgcn_sched_barrier(0)
    Unit cur, nxt; int ui = 0;
    if (!S.next(0, cur)) return;
    f32x4 acc[2][2][4][2];
#pragma unroll
    for (int a = 0; a < 2; ++a)
#pragma unroll
        for (int b = 0; b < 2; ++b)
#pragma unroll
            for (int m = 0; m < 4; ++m)
#pragma unroll
                for (int n = 0; n < 2; ++n) acc[a][b][m][n] = (f32x4){0.f, 0.f, 0.f, 0.f};
    bf16x8 At[4][2], B0[2][2], B1[2][2];
    const char* cA = (const char*)g.A + (size_t)cur.pm * tstep; const char* cB = (const char*)g.Bt + (size_t)cur.pn * tstep;
    S.a_ready(cur);
    if constexpr (SP2) {
        PG8_STAGE(PG8_SB(0, 0), cB, voffB); PG8_STAGE(PG8_SB(0, 1), cB + hstepB, voffB); PG8_STAGE(PG8_SA(0, 0), cA, voffA); PG8_STAGE(PG8_SA(0, 1), cA + hstepA, voffA);
        if (wr == 1) PG8_BAR;
        PG8_WAIT_V(2); PG8_BAR;
        PG8_STAGE(PG8_SB(1, 0), cB + kstepB, voffB); PG8_STAGE(PG8_SA(1, 0), cA + kstepA, voffA); PG8_STAGE(PG8_SB(1, 1), cB + hstepB + kstepB, voffB);
        PG8_WAIT_V(6); PG8_BAR;
    } else {
        PG8_STAGE(PG8_SB(0, 0), cB, voffB); PG8_STAGE(PG8_SA(0, 0), cA, voffA); PG8_STAGE(PG8_SB(0, 1), cB + hstepB, voffB); PG8_STAGE(PG8_SA(0, 1), cA + hstepA, voffA);
        if (wr == 1) PG8_BAR;
        PG8_WAIT_V(4); PG8_BAR;
        PG8_STAGE(PG8_SB(1, 0), cB + kstepB, voffB); PG8_STAGE(PG8_SA(1, 0), cA + kstepA, voffA); PG8_STAGE(PG8_SB(1, 1), cB + hstepB + kstepB, voffB);
        PG8_WAIT_V(6); PG8_BAR;
    }
    for (;;) {
        const bool has_next = S.next(ui + 1, nxt);
        const char* nA = has_next ? (const char*)g.A + (size_t)nxt.pm * tstep : cA; const char* nB = has_next ? (const char*)g.Bt + (size_t)nxt.pn * tstep : cB;
        for (int t = 0; t < nt; t += 2) {
            const bool last = (t == nt - 2);
            const char* a1 = cA + (size_t)(t + 1) * kstepA;
            const char* a2 = last ? nA : cA + (size_t)(t + 2) * kstepA; const char* b2 = last ? nB : cB + (size_t)(t + 2) * kstepB;
            const char* a3 = a2 + kstepA; const char* b3 = b2 + kstepB;
            if (last && has_next) S.a_ready(nxt);
            if constexpr (SP2) {
            PG8_LDB(B0, 0, 0); PG8_LDB(B1, 0, 1); PG8_SCHED; PG8_LDA(At, 0, 0); PG8_STAGE(PG8_SA(1, 1), a1 + hstepA, voffA);
            PG8_WAIT_V(8); PG8_WAIT_L(0); PG8_BAR; PG8_MMA(0, 0, At, B0); PG8_MMA(0, 1, At, B1); PG8_BAR; PG8_SCHED;
            PG8_LDA(At, 0, 1); PG8_STAGE(PG8_SB(0, 0), b2, voffB); PG8_STAGE(PG8_SB(0, 1), b2 + hstepB, voffB); PG8_STAGE(PG8_SA(0, 0), a2, voffA);
            PG8_WAIT_V(8); PG8_WAIT_L(0); PG8_BAR; PG8_MMA(1, 0, At, B0); PG8_MMA(1, 1, At, B1); PG8_BAR; PG8_SCHED;
            PG8_LDB(B0, 1, 0); PG8_LDB(B1, 1, 1); PG8_SCHED; PG8_LDA(At, 1, 0); PG8_STAGE(PG8_SA(0, 1), a2 + hstepA, voffA);
            PG8_WAIT_V(8); PG8_WAIT_L(0); PG8_BAR; PG8_MMA(0, 0, At, B0); PG8_MMA(0, 1, At, B1); PG8_BAR; PG8_SCHED;
            PG8_LDA(At, 1, 1); PG8_STAGE(PG8_SB(1, 0), b3, voffB); PG8_STAGE(PG8_SB(1, 1), b3 + hstepB, voffB); PG8_STAGE(PG8_SA(1, 0), a3, voffA);
            PG8_WAIT_V(8); PG8_WAIT_L(0); PG8_BAR; PG8_MMA(1, 0, At, B0); PG8_MMA(1, 1, At, B1); PG8_BAR; PG8_SCHED;
            } else {
            PG8_LDB(B0, 0, 0); PG8_SCHED; PG8_LDA(At, 0, 0); PG8_STAGE(PG8_SA(1, 1), a1 + hstepA, voffA);
            PG8_WAIT_L(8); PG8_BAR; PG8_WAIT_L(0); PG8_MMA(0, 0, At, B0); PG8_BAR; PG8_SCHED;
            PG8_LDB(B1, 0, 1); PG8_STAGE(PG8_SB(0, 0), b2, voffB);
            PG8_BAR; PG8_WAIT_L(0); PG8_MMA(0, 1, At, B1); PG8_BAR;
            PG8_LDA(At, 0, 1); PG8_STAGE(PG8_SA(0, 0), a2, voffA);
            PG8_BAR; PG8_WAIT_L(0); PG8_MMA(1, 0, At, B0); PG8_BAR; PG8_SCHED;
            PG8_STAGE(PG8_SB(0, 1), b2 + hstepB, voffB);
            PG8_WAIT_V(6); PG8_BAR; PG8_MMA(1, 1, At, B1); PG8_BAR;
            PG8_LDB(B0, 1, 0); PG8_SCHED; PG8_LDA(At, 1, 0); PG8_STAGE(PG8_SA(0, 1), a2 + hstepA, voffA);
            PG8_WAIT_L(8); PG8_BAR; PG8_WAIT_L(0); PG8_MMA(0, 0, At, B0); PG8_BAR; PG8_SCHED;
            PG8_LDB(B1, 1, 1); PG8_STAGE(PG8_SB(1, 0), b3, voffB);
            PG8_BAR; PG8_WAIT_L(0); PG8_MMA(0, 1, At, B1); PG8_BAR;
            PG8_LDA(At, 1, 1); PG8_STAGE(PG8_SA(1, 0), a3, voffA);
            PG8_BAR; PG8_WAIT_L(0); PG8_MMA(1, 0, At, B0); PG8_BAR; PG8_SCHED;
            PG8_STAGE(PG8_SB(1, 1), b3 + hstepB, voffB);
            PG8_WAIT_V(6); PG8_BAR; PG8_MMA(1, 1, At, B1); PG8_BAR;
            }
        }
        if constexpr (ALIGN_EPI) { if (wr == 0) PG8_BAR; }
        if constexpr (I8) asm volatile("s_nop 15\n\ts_nop 15\n\ts_nop 15\n\ts_nop 15" ::: "memory");
        if constexpr (!Epi::AFTER_DRAIN) { E(acc, cur, wr, wc, fr, fq); S.done(cur); }
        if (!has_next) break;
#pragma unroll
        for (int a = 0; a < 2; ++a)
#pragma unroll
            for (int b = 0; b < 2; ++b)
#pragma unroll
                for (int m = 0; m < 4; ++m)
#pragma unroll
                    for (int n = 0; n < 2; ++n) acc[a][b][m][n] = (f32x4){0.f, 0.f, 0.f, 0.f};
        cur = nxt; cA = nA; cB = nB; ++ui;
        if constexpr (ALIGN_EPI) { if (wr == 1) PG8_BAR; }
    }
    PG8_WAIT_V(0);
    if constexpr (!ALIGN_EPI) { if (wr == 0) PG8_BAR; }
    PG8_BAR;
    if constexpr (Epi::AFTER_DRAIN) { E.fused(acc, cur, wr, wc, fr, fq, lds, wid, lane); S.done(cur); }
#undef PG8_SA
#undef PG8_SB
#undef PG8_STAGE
#undef PG8_LDA
#undef PG8_LDB
#undef PG8_MMA
#undef PG8_WAIT_V
#undef PG8_WAIT_L
#undef PG8_BAR
#undef PG8_SCHED
}
}

#ifndef MK_N_LAUNCHES
#define MK_N_LAUNCHES 1
#endif
constexpr int NWAVES = 8;
constexpr int DM = 4096, SEQ = 16384, NMETA = 16, LTOK = SEQ + NMETA, MP = 16640, MG = 16384;
constexpr int DC = 2048, DSS = 1024, NG = 64, DFF = 12288, NIN = 15360;
constexpr float EPS = 1e-6f;
#ifndef MK_WTILED
#define MK_WTILED 1
#endif
constexpr bool WTILED = MK_WTILED;
constexpr int NPH = 24;
constexpr int NSEG = 16, SEGLEN = 1056, CHT = 32, NCH = SEGLEN / CHT, XROW = 528, XBUF = CHT * XROW;

constexpr size_t MiB = 1u << 20;
constexpr size_t WS_CTL = 0, CTL_ZERO_BYTES = 1 * MiB;
constexpr size_t WS_RSTD = 6 * MiB;
constexpr size_t WS_RS8 = WS_RSTD + 128 * 1024;
constexpr size_t WS_CS8 = WS_RSTD + 256 * 1024;
constexpr size_t WS_ABAR = 1 * MiB;
constexpr size_t WS_ASEG = WS_ABAR + 256 * 1024;
constexpr size_t WS_BBT = 2 * MiB;
constexpr size_t WS_CCT = 3 * MiB;
constexpr size_t WS_E = 4 * MiB;
constexpr size_t WS_W = 8 * MiB;
constexpr size_t W_IN = 0, W_A = 120 * MiB, W_GLU = 136 * MiB, W_OUT = 152 * MiB, W_UP = 184 * MiB, W_DOWN = 376 * MiB, W_LAYER = 472 * MiB;
constexpr size_t WS_HRES = WS_W + 2 * W_LAYER;
constexpr size_t WS_HB8 = WS_HRES;
constexpr size_t WS_WG8 = WS_HRES + 128 * MiB;
constexpr size_t WS_H = WS_HRES + 260 * MiB;
constexpr size_t WS_R = WS_H + 130 * MiB;
constexpr size_t R_BG = 0, R_CV = 65 * MiB, R_U = 130 * MiB, R_GA = 130 * MiB + 32 * MiB + MiB / 2, R_GB = R_GA + 130 * MiB, R_AIN = R_GB + 130 * MiB, R_S = R_AIN + 65 * MiB,
                 R_M = R_S + 32 * MiB + MiB / 2, R_YF = R_M + 130 * MiB, R_YB = R_YF + 65 * MiB, R_END = R_YB + 65 * MiB;
static_assert(R_END == 780 * MiB, "overlay map");
constexpr size_t WS_ACT = WS_R + 780 * MiB;
constexpr size_t WS_DLT = WS_ACT + 390 * MiB;
constexpr size_t WS_END = WS_DLT + 260 * MiB;
static_assert((size_t)MP * 24576 * 2 == 780 * MiB && (size_t)MP * 4096 * 4 == 260 * MiB && (size_t)MP * 12288 * 2 == 390 * MiB, "sizes");

constexpr int LDS_BYTES = 147456, LDSCTL_OFF = 146944;
static_assert(NWAVES * XBUF <= LDSCTL_OFF && NWAVES * 16640 <= LDSCTL_OFF && 131072 + 8192 <= LDSCTL_OFF, "LDS map");

#define GAS __attribute__((address_space(1)))
#define LAS __attribute__((address_space(3)))
typedef unsigned short bf16;
typedef unsigned v4u __attribute__((ext_vector_type(4)));
typedef unsigned v2u __attribute__((ext_vector_type(2)));
typedef float f32x4 __attribute__((ext_vector_type(4)));
typedef float f32x2 __attribute__((ext_vector_type(2)));
typedef float f32x16 __attribute__((ext_vector_type(16)));
typedef short bf16x8 __attribute__((ext_vector_type(8)));
#define LDS_WAIT() asm volatile("s_waitcnt lgkmcnt(0)" ::: "memory")
#define VM_WAIT() asm volatile("s_waitcnt vmcnt(0)" ::: "memory")
__device__ __forceinline__ unsigned pk2(float lo, float hi) { return pg8::cvt_pk_bf16(lo, hi); }
__device__ __forceinline__ float bf_lo(unsigned w) { return __uint_as_float(w << 16); }
__device__ __forceinline__ float bf_hi(unsigned w) { return __uint_as_float(w & 0xffff0000u); }
__device__ __forceinline__ void unpack8(v4u w, float (&f)[8]) { f[0] = bf_lo(w.x); f[1] = bf_hi(w.x); f[2] = bf_lo(w.y); f[3] = bf_hi(w.y); f[4] = bf_lo(w.z); f[5] = bf_hi(w.z); f[6] = bf_lo(w.w); f[7] = bf_hi(w.w); }
__device__ __forceinline__ unsigned short f2bf1(float f) { unsigned u = __float_as_uint(f); return (unsigned short)((u + 0x7fffu + ((u >> 16) & 1u)) >> 16); }
__device__ __forceinline__ float fma_s(float a, float b, float c) { float r; asm("v_fma_f32 %0, %1, %2, %3" : "=v"(r) : "v"(a), "v"(b), "v"(c)); return r; }
__device__ __forceinline__ float wave_sum(float v) {
#pragma unroll
    for (int o = 1; o < 64; o <<= 1) v += __shfl_xor(v, o);
    return v;
}

#define XB_TMO      128
#define XB_XCNT(j)  (256  + 64 * (j))
#define XB_XSUB(j)  (1280 + 64 * (j))
#define XB_XGEN(j)  (2304 + 64 * (j))
#define XB_TOP      3328
#define XB_TOPGEN   3392
#define XCD_BAR_WORDS 3456
#define XB_SPIN_CAP (1u << 18)

__device__ __forceinline__ unsigned xb_ld(unsigned* p)              { return __hip_atomic_load(p, __ATOMIC_RELAXED, __HIP_MEMORY_SCOPE_AGENT); }
__device__ __forceinline__ unsigned xb_add(unsigned* p, unsigned v) { return __hip_atomic_fetch_add(p, v, __ATOMIC_RELAXED, __HIP_MEMORY_SCOPE_AGENT); }
__device__ __forceinline__ unsigned xb_xcc_id() { return (unsigned)__builtin_amdgcn_s_getreg((3 << 11) | 20) & 0xFu; }
#define XB_SPIN(cond, bar) do { unsigned _sp = 0; while (cond) { __builtin_amdgcn_s_sleep(1); \
    if ((++_sp & 255u) == 0u) { if (xb_ld(&(bar)[XB_TMO])) break; if (_sp > XB_SPIN_CAP) { atomicAdd(&(bar)[XB_TMO], 1u); break; } } } } while (0)

struct XcdBarrier {
    unsigned* bar; unsigned x;
    volatile LAS unsigned* st;
};

__device__ __forceinline__ XcdBarrier xcd_barrier_post(unsigned* bar, volatile LAS unsigned* st) {
    XcdBarrier b; b.bar = bar; b.x = xb_xcc_id(); b.st = st;
    if (threadIdx.x == 0) (void)xb_add(&bar[XB_XCNT(b.x)], 1u);
    return b;
}
__device__ __forceinline__ void xcd_barrier_complete(unsigned* bar, unsigned x, unsigned& nloc, unsigned& nx) {
    const unsigned G = gridDim.x * gridDim.y * gridDim.z;
    unsigned sum, cnt, mine, sp = 0u;
    for (;;) {
        sum = 0u; cnt = 0u; mine = 0u;
#pragma unroll
        for (unsigned j = 0; j < 16; ++j) { const unsigned c = xb_ld(&bar[XB_XCNT(j)]); sum += c; cnt += (c > 0u) ? 1u : 0u; mine = (j == x) ? c : mine; }
        if (sum == G) break;
        __builtin_amdgcn_s_sleep(1);
        if ((++sp & 255u) == 0u) { if (xb_ld(&bar[XB_TMO])) break; if (sp > XB_SPIN_CAP) { atomicAdd(&bar[XB_TMO], 1u); break; } }
    }
    nloc = mine > 0u ? mine : 1u; nx = cnt > 0u ? cnt : 1u;
}

__device__ __forceinline__ void xcd_barrier(const XcdBarrier& b) {
    asm volatile("s_waitcnt vmcnt(0)" ::: "memory");
    __syncthreads();
    if (threadIdx.x == 0) {
        unsigned* bar = b.bar;
        __builtin_amdgcn_s_waitcnt(0);
        unsigned nloc = b.st[0], nx = b.st[1];
        if (nloc == 0u) { xcd_barrier_complete(bar, b.x, nloc, nx); b.st[0] = nloc; b.st[1] = nx; }
        const unsigned old = xb_add(&bar[XB_XSUB(b.x)], 1u);
        const unsigned gen = old / nloc;
        if (old + 1u == (gen + 1u) * nloc) {
            __builtin_amdgcn_fence(__ATOMIC_RELEASE, "agent");
            asm volatile("s_waitcnt vmcnt(0)" ::: "memory");
            const unsigned og = xb_add(&bar[XB_TOP], 1u);
            const unsigned tg = og / nx;
            if (og + 1u == (tg + 1u) * nx) xb_add(&bar[XB_TOPGEN], 1u);
            else XB_SPIN(xb_ld(&bar[XB_TOPGEN]) == tg, bar);
            __builtin_amdgcn_fence(__ATOMIC_ACQUIRE, "agent");
            xb_add(&bar[XB_XGEN(b.x)], 1u);
            asm volatile("s_waitcnt vmcnt(0)" ::: "memory");
        } else {
            XB_SPIN(xb_ld(&bar[XB_XGEN(b.x)]) == gen, bar);
            __builtin_amdgcn_fence(__ATOMIC_ACQUIRE, "agent");
            asm volatile("s_waitcnt vmcnt(0)" ::: "memory");
        }
    }
    __syncthreads();
}


__device__ __forceinline__ int dest_row(int mode, int N, int n) {
    if (mode == 1) {
        if (n < 2048 || n >= 6144) return n;
        if (n < 4096) { const int c = n - 2048; return 2048 + (c >> 7) * 256 + (c & 127); }
        const int c = n - 4096; return 2048 + (c >> 7) * 256 + 128 + (c & 127);
    }
    if (mode == 2) {
        const int h = N >> 1; if (n < h) return (n >> 7) * 256 + (n & 127);
        const int c = n - h; return (c >> 7) * 256 + 128 + (c & 127);
    }
    return n;
}
__device__ __forceinline__ void convert_matrix(const float* W, const float* kgain  , int K, int N, bf16* WT, int mode, LAS float* scr, int gw, int ngw, int lane, int ncols = 0  ) {
    const int nblk = (ncols ? ncols : N) >> 6, nitems = (K >> 6) * nblk;
    for (int it = gw; it < nitems; it += ngw) {
        const int kb = it / nblk, nb = it - kb * nblk, k0 = kb << 6, n0 = nb << 6;
        const int nn = 4 * (lane & 15), kq = lane >> 4;
        f32x4 v[16];
#pragma unroll
        for (int i = 0; i < 16; ++i) { v[i] = *(const GAS f32x4*)(W + (size_t)(k0 + 4 * i + kq) * N + n0 + nn); if (kgain) v[i] = v[i] * kgain[k0 + 4 * i + kq]; }
#pragma unroll
        for (int i = 0; i < 16; ++i) { const int kk = 4 * i + kq;
            scr[(nn + 0) * 65 + kk] = v[i].x; scr[(nn + 1) * 65 + kk] = v[i].y; scr[(nn + 2) * 65 + kk] = v[i].z; scr[(nn + 3) * 65 + kk] = v[i].w; }
        LDS_WAIT();
        const int drow = dest_row(mode, N, n0); const int c = lane & 7;
#pragma unroll
        for (int jr = 0; jr < 8; ++jr) { const int n = 8 * jr + (lane >> 3); const LAS float* s = scr + n * 65 + 8 * c;
            v4u o; o.x = pk2(s[0], s[1]); o.y = pk2(s[2], s[3]); o.z = pk2(s[4], s[5]); o.w = pk2(s[6], s[7]);
            if (WTILED) *(GAS v4u*)(WT + ((size_t)((drow + n) >> 8) * (K >> 6) + kb) * 16384 + ((drow + n) & 255) * 64 + 8 * c) = o;
            else *(GAS v4u*)(WT + (size_t)(drow + n) * K + k0 + 8 * c) = o; }
        LDS_WAIT();
    }
}
__device__ __forceinline__ void sincos_d(double x, double& s, double& c) {
    const double k = rint(x * 0.15915494309189535); double r = fma(-k, 6.283185307179586, x); r = fma(-k, 2.4492935982947064e-16, r);
    const double r2 = r * r; double ss = 1.0, cc = 1.0;
#pragma unroll
    for (int n = 17; n >= 1; --n) { ss = 1.0 - ss * r2 / (double)((2 * n) * (2 * n + 1)); cc = 1.0 - cc * r2 / (double)((2 * n - 1) * (2 * n)); }
    s = r * ss; c = cc;
}
__device__ __forceinline__ void scan_params(int idx, const float* lre_, const float* lim_, const float* lst_, const float* bre_, const float* bim_, const float* cre_, const float* cim_,
                                            f32x2* abar, f32x2* aseg, bf16* BBt, bf16* CCt) {
    const int p = idx & 63, ldg = idx >> 6;
    const double lre = (double)lre_[idx], lim = (double)lim_[idx], dt = exp((double)lst_[ldg]);
    const double mag = exp(lre * dt), ang = lim * dt; double sn, cs; sincos_d(ang, sn, cs);
    const double ar = mag * cs, ai = mag * sn, nr = ar - 1.0, ni = ai, den = lre * lre + lim * lim;
    const double fre = (nr * lre + ni * lim) / den, fim = (ni * lre - nr * lim) / den;
    abar[idx] = (f32x2){(float)ar, (float)ai};
    { const double magn = exp(lre * dt * (double)SEGLEN); double s2, c2; sincos_d(ang * (double)SEGLEN, s2, c2); aseg[idx] = (f32x2){(float)(magn * c2), (float)(magn * s2)}; }
    for (int h = 0; h < 16; ++h) {
        const double br = (double)bre_[(size_t)idx * 16 + h], bi = (double)bim_[(size_t)idx * 16 + h];
        BBt[((size_t)ldg * 128 + p) * 16 + h] = f2bf1((float)(fre * br - fim * bi));
        BBt[((size_t)ldg * 128 + 64 + p) * 16 + h] = f2bf1((float)(fre * bi + fim * br));
        const float cr = cre_[((size_t)ldg * 16 + h) * 64 + p], ci = cim_[((size_t)ldg * 16 + h) * 64 + p];
        CCt[((size_t)ldg * 16 + h) * 128 + 2 * p] = f2bf1(cr);
        CCt[((size_t)ldg * 16 + h) * 128 + 2 * p + 1] = f2bf1(-ci);
    }
}
__device__ __forceinline__ float quant_row8(const f32x4 (&v)[16], signed char* q8, int r, int lane) {
    float mx = 0.f;
#pragma unroll
    for (int j = 0; j < 16; ++j) mx = fmaxf(fmaxf(mx, fmaxf(fabsf(v[j].x), fabsf(v[j].y))), fmaxf(fabsf(v[j].z), fabsf(v[j].w)));
#pragma unroll
    for (int o = 1; o < 64; o <<= 1) mx = fmaxf(mx, __shfl_xor(mx, o));
    mx = fmaxf(mx, 1e-20f); const float sc = 127.0f / mx;
    signed char* rowp = q8 + ((size_t)(r >> 8) * 32 + (lane >> 5)) * 32768 + (size_t)((r & 255) * 128 + 4 * (lane & 31));
#pragma unroll
    for (int j = 0; j < 16; ++j) { const int a = (int)rintf(v[j].x * sc), b = (int)rintf(v[j].y * sc), c = (int)rintf(v[j].z * sc), d = (int)rintf(v[j].w * sc);
        *(GAS unsigned*)(rowp + (size_t)j * 65536) = (unsigned)(a & 255) | ((unsigned)(b & 255) << 8) | ((unsigned)(c & 255) << 16) | ((unsigned)d << 24); }
    return mx * (1.0f / 127.0f);
}
__device__ __forceinline__ float quant_row8w(const float (&v)[8][8], signed char* q8, int r, int lane) {
    float mx = 0.f;
#pragma unroll
    for (int j = 0; j < 8; ++j)
#pragma unroll
        for (int e = 0; e < 8; ++e) mx = fmaxf(mx, fabsf(v[j][e]));
#pragma unroll
    for (int o = 1; o < 64; o <<= 1) mx = fmaxf(mx, __shfl_xor(mx, o));
    mx = fmaxf(mx, 1e-20f); const float sc = 127.0f / mx;
    signed char* rowp = q8 + ((size_t)(r >> 8) * 32 + (lane >> 4)) * 32768 + (size_t)((r & 255) * 128 + 8 * (lane & 15));
#pragma unroll
    for (int j = 0; j < 8; ++j) { v2u w;
        { const int a = (int)rintf(v[j][0] * sc), b = (int)rintf(v[j][1] * sc), c = (int)rintf(v[j][2] * sc), d = (int)rintf(v[j][3] * sc); w.x = (unsigned)(a & 255) | ((unsigned)(b & 255) << 8) | ((unsigned)(c & 255) << 16) | ((unsigned)d << 24); }
        { const int a = (int)rintf(v[j][4] * sc), b = (int)rintf(v[j][5] * sc), c = (int)rintf(v[j][6] * sc), d = (int)rintf(v[j][7] * sc); w.y = (unsigned)(a & 255) | ((unsigned)(b & 255) << 8) | ((unsigned)(c & 255) << 16) | ((unsigned)d << 24); }
        *(GAS v2u*)(rowp + (size_t)j * 4 * 32768) = w; }
    return mx * (1.0f / 127.0f);
}
__device__ __forceinline__ void weights_i8(LAS unsigned char* lds, const float* Win  , int ldw, const float* kgain, signed char* W8, float* cscale, int n0  , int d0  , int wave, int lane, int tid, float csmul = 1.0f  ) {
    LAS float* cmx = (LAS float*)lds;
    const int cq = lane & 7, kq = lane >> 3;
    const float* src = Win + (size_t)(wave * 512 + 16 * kq) * ldw + n0 + 4 * cq;
    const float* gp = kgain + wave * 512 + 16 * kq;
    unsigned pk[16][8];
    f32x4 mx = {0.f, 0.f, 0.f, 0.f};
#pragma unroll
    for (int s = 0; s < 16; ++s) {
        f32x4 v[4];
        const f32x4 g4 = *(const GAS f32x4*)(gp + 128 * (s >> 2) + 4 * (s & 3));
#pragma unroll
        for (int r = 0; r < 4; ++r) v[r] = *(const GAS f32x4*)(src + (size_t)(128 * (s >> 2) + 4 * (s & 3) + r) * ldw) * g4[r];
#pragma unroll
        for (int j = 0; j < 4; ++j) { pk[s][2 * j] = pk2(v[0][j], v[1][j]); pk[s][2 * j + 1] = pk2(v[2][j], v[3][j]);
            mx[j] = fmaxf(fmaxf(mx[j], fmaxf(fabsf(v[0][j]), fabsf(v[1][j]))), fmaxf(fabsf(v[2][j]), fabsf(v[3][j]))); }
    }
#pragma unroll
    for (int j = 0; j < 4; ++j) { mx[j] = fmaxf(mx[j], __shfl_xor(mx[j], 8)); mx[j] = fmaxf(mx[j], __shfl_xor(mx[j], 16)); mx[j] = fmaxf(mx[j], __shfl_xor(mx[j], 32)); }
    if (lane < 8) *(LAS f32x4*)(cmx + wave * 32 + 4 * cq) = mx;
    __syncthreads();
    f32x4 t = {1e-20f, 1e-20f, 1e-20f, 1e-20f};
#pragma unroll
    for (int w = 0; w < 8; ++w) { const f32x4 o = *(const LAS f32x4*)(cmx + w * 32 + 4 * cq); t[0] = fmaxf(t[0], o[0]); t[1] = fmaxf(t[1], o[1]); t[2] = fmaxf(t[2], o[2]); t[3] = fmaxf(t[3], o[3]); }
    if (tid < 8) *(GAS f32x4*)(cscale + d0 + 4 * cq) = t * ((1.0f / 127.0f) * csmul);
    float sc[4];
#pragma unroll
    for (int j = 0; j < 4; ++j) sc[j] = 127.0f / t[j];
#pragma unroll
    for (int j = 0; j < 4; ++j) { const int col = d0 + 4 * cq + j;
        signed char* dst = W8 + ((size_t)(col >> 8) * 32 + wave * 4) * 32768 + (size_t)((col & 255) * 128 + 16 * kq);
#pragma unroll
        for (int st = 0; st < 4; ++st) { v4u o;
#pragma unroll
            for (int q = 0; q < 4; ++q) { const unsigned w0 = pk[4 * st + q][2 * j], w1 = pk[4 * st + q][2 * j + 1];
                const int a = (int)fminf(fmaxf(rintf(bf_lo(w0) * sc[j]), -127.f), 127.f), b = (int)fminf(fmaxf(rintf(bf_hi(w0) * sc[j]), -127.f), 127.f);
                const int c = (int)fminf(fmaxf(rintf(bf_lo(w1) * sc[j]), -127.f), 127.f), d = (int)fminf(fmaxf(rintf(bf_hi(w1) * sc[j]), -127.f), 127.f);
                o[q] = (unsigned)(a & 255) | ((unsigned)(b & 255) << 8) | ((unsigned)(c & 255) << 16) | ((unsigned)d << 24); }
            *(GAS v4u*)(dst + (size_t)st * 32768) = o; } }
    __syncthreads();
}
__device__ __forceinline__ void resid_phase(bf16* hres, const bf16* delta, float* rstd, signed char* q8  , float* rs8, int nrows, int gw, int ngw, int lane) {
    for (int r = gw; r < nrows; r += ngw) {
        bf16* xr = hres + pg8::tix(r, 4 * lane, DM);
        const GAS v2u* dr = (const GAS v2u*)(delta + (size_t)r * DM) + lane; v2u a[16], d[16]; float s = 0.f;
#pragma unroll
        for (int j = 0; j < 16; ++j) { a[j] = *(const GAS v2u*)(xr + (size_t)j * 65536); d[j] = dr[64 * j]; }
        f32x4 vv[16];
#pragma unroll
        for (int j = 0; j < 16; ++j) { const float v0 = bf_lo(a[j].x) + bf_lo(d[j].x), v1 = bf_hi(a[j].x) + bf_hi(d[j].x), v2 = bf_lo(a[j].y) + bf_lo(d[j].y), v3 = bf_hi(a[j].y) + bf_hi(d[j].y);
            s += (v0 * v0 + v1 * v1) + (v2 * v2 + v3 * v3); v2u w; w.x = pk2(v0, v1); w.y = pk2(v2, v3); *(GAS v2u*)(xr + (size_t)j * 65536) = w; vv[j] = (f32x4){v0, v1, v2, v3}; }
        s = wave_sum(s);
        const float rstd_r = 1.0f / sqrtf(s * (1.0f / DM) + EPS);
        if (lane == 0) rstd[r] = rstd_r;
        if (q8) { const float ms = quant_row8(vv, q8, r, lane); if (lane == 0) rs8[r] = ms * rstd_r; }
    }
}
__device__ __forceinline__ void stat_phase(const bf16* hres, float* rstd, signed char* q8, float* rs8, int nrows, int gw, int ngw, int lane) {
    for (int r = gw; r < nrows; r += ngw) {
        const bf16* xr = hres + pg8::tix(r, 8 * lane, DM); v4u a[8]; float s = 0.f;
#pragma unroll
        for (int j = 0; j < 8; ++j) a[j] = *(const GAS v4u*)(xr + (size_t)j * 131072);
        float vv[8][8];
#pragma unroll
        for (int j = 0; j < 8; ++j) { unpack8(a[j], vv[j]);
#pragma unroll
            for (int e = 0; e < 8; ++e) s += vv[j][e] * vv[j][e]; }
        s = wave_sum(s);
        const float rstd_r = 1.0f / sqrtf(s * (1.0f / DM) + EPS);
        if (lane == 0) rstd[r] = rstd_r;
        { const float ms = quant_row8w(vv, q8, r, lane); if (lane == 0) rs8[r] = ms * rstd_r; }
    }
}
__device__ __forceinline__ void final_norm(const bf16* hres  , int row_off, const bf16* delta, const float* gain, float* dst, int nrows, int gw, int ngw, int lane) {
    for (int r = gw; r < nrows; r += ngw) {
        const bf16* xr = hres + pg8::tix(r + row_off, 8 * lane, DM); const GAS v4u* dr = (const GAS v4u*)(delta + (size_t)r * DM) + lane; GAS f32x4* o = (GAS f32x4*)(dst + (size_t)r * DM) + 2 * lane;
        v4u a[8], d[8]; float s = 0.f;
#pragma unroll
        for (int j = 0; j < 8; ++j) { a[j] = *(const GAS v4u*)(xr + (size_t)j * 131072); d[j] = dr[64 * j]; }
        float v[8][8];
#pragma unroll
        for (int j = 0; j < 8; ++j) { float fa[8], fd[8]; unpack8(a[j], fa); unpack8(d[j], fd);
#pragma unroll
            for (int e = 0; e < 8; ++e) { v[j][e] = fa[e] + fd[e]; s += v[j][e] * v[j][e]; } }
        const float rstd = 1.0f / sqrtf(wave_sum(s) * (1.0f / DM) + EPS);
#pragma unroll
        for (int j = 0; j < 8; ++j) { const f32x4 g0 = *((const GAS f32x4*)gain + 2 * lane + 128 * j), g1 = *((const GAS f32x4*)gain + 2 * lane + 128 * j + 1);
            o[128 * j] = (f32x4){v[j][0], v[j][1], v[j][2], v[j][3]} * rstd * g0; o[128 * j + 1] = (f32x4){v[j][4], v[j][5], v[j][6], v[j][7]} * rstd * g1; }
    }
}
__device__ __forceinline__ v4u pack8f(const float (&f)[8]) { v4u w; w.x = pk2(f[0], f[1]); w.y = pk2(f[2], f[3]); w.z = pk2(f[4], f[5]); w.w = pk2(f[6], f[7]); return w; }
__device__ __forceinline__ void conv_a_phase(const bf16* bg, const bf16* cv, const float* cw  , bf16* ain, int gtid, int nthr) {
    for (int idx = gtid; idx < 256 * (LTOK / 8); idx += nthr) {
        const int c0 = (idx & 255) * 8, t0 = (idx >> 8) * 8;
        v4u rc[10], rb[8];
#pragma unroll
        for (int i = 0; i < 10; ++i) { int t = t0 - 1 + i; t = t < 0 ? 0 : (t < LTOK ? t : LTOK - 1); rc[i] = *(const GAS v4u*)(cv + (size_t)t * DC + c0); }
#pragma unroll
        for (int i = 0; i < 8; ++i) rb[i] = *(const GAS v4u*)(bg + (size_t)(t0 + i) * DC + c0);
        float w0[8], w1[8], w2[8];
#pragma unroll
        for (int h = 0; h < 2; ++h) { const f32x4 a0 = *(const GAS f32x4*)(cw + c0 + 4 * h), a1 = *(const GAS f32x4*)(cw + 2048 + c0 + 4 * h), a2 = *(const GAS f32x4*)(cw + 4096 + c0 + 4 * h);
#pragma unroll
            for (int e = 0; e < 4; ++e) { w0[4 * h + e] = a0[e]; w1[4 * h + e] = a1[e]; w2[4 * h + e] = a2[e]; } }
        const v4u z4 = (v4u){0u, 0u, 0u, 0u};
        float pv[8], cu[8], nx[8];
        unpack8(t0 > 0 ? rc[0] : z4, pv);
        unpack8(rc[1], cu);
#pragma unroll
        for (int tt = 0; tt < 8; ++tt) { const int t = t0 + tt;
            unpack8((t + 1 < LTOK) ? rc[tt + 2] : z4, nx);
            float b[8], o[8]; unpack8(rb[tt], b);
#pragma unroll
            for (int j = 0; j < 8; ++j) { o[j] = b[j] * (w0[j] * pv[j] + w1[j] * cu[j] + w2[j] * nx[j]); pv[j] = cu[j]; cu[j] = nx[j]; }
            *(GAS v4u*)(ain + pg8::tix(t, c0, DC)) = pack8f(o); }
    }
}
__device__ __forceinline__ void conv_edge_phase(const float* zedge, const float* ztail, const float* cw  , bf16* act, int gtid, int nthr) {
    for (int idx = gtid; idx < 144 * 1536; idx += nthr) {
        const int cgi = idx % 1536, it = idx / 1536, c0 = cgi * 8, zg = (c0 >> 7) * 256 + (c0 & 127);
        int row; const float *pz, *cz, *nz; bool hp = true, hn = true;
        if (it < 128) { const int pm = it >> 1, wh = it & 1; row = pm * 256 + (wh ? 255 : 0);
            cz = zedge + (size_t)(pm * 4 + (wh ? 3 : 0)) * 24576;
            pz = wh ? zedge + (size_t)(pm * 4 + 2) * 24576 : zedge + (size_t)((pm > 0 ? pm - 1 : 0) * 4 + 3) * 24576; hp = wh || pm > 0;
            nz = wh ? (pm < 63 ? zedge + (size_t)((pm + 1) * 4) * 24576 : ztail) : zedge + (size_t)(pm * 4 + 1) * 24576;
        } else { const int i = it - 128; row = MG + i; cz = ztail + (size_t)i * 24576;
            pz = i > 0 ? ztail + (size_t)(i - 1) * 24576 : zedge + (size_t)(63 * 4 + 3) * 24576;
            nz = ztail + (size_t)(i < 15 ? i + 1 : 15) * 24576; hn = i < 15; }
        pz += zg; cz += zg; nz += zg;
        float o[8];
#pragma unroll
        for (int q = 0; q < 2; ++q) {
            const f32x4 z4 = (f32x4){0.f, 0.f, 0.f, 0.f};
            const f32x4 pg = hp ? *(const GAS f32x4*)(pz + 4 * q) : z4, pv = hp ? *(const GAS f32x4*)(pz + 128 + 4 * q) : z4;
            const f32x4 cg = *(const GAS f32x4*)(cz + 4 * q), cv = *(const GAS f32x4*)(cz + 128 + 4 * q);
            const f32x4 ng = hn ? *(const GAS f32x4*)(nz + 4 * q) : z4, nv = hn ? *(const GAS f32x4*)(nz + 128 + 4 * q) : z4;
            const f32x4 g0 = *(const GAS f32x4*)(cw + c0 + 4 * q), g1 = *(const GAS f32x4*)(cw + 24576 + c0 + 4 * q), g2 = *(const GAS f32x4*)(cw + 49152 + c0 + 4 * q);
            const f32x4 v0 = *(const GAS f32x4*)(cw + DFF + c0 + 4 * q), v1 = *(const GAS f32x4*)(cw + 24576 + DFF + c0 + 4 * q), v2 = *(const GAS f32x4*)(cw + 49152 + DFF + c0 + 4 * q);
            const f32x4 a = g0 * pg + g1 * cg + g2 * ng, b = v0 * pv + v1 * cv + v2 * nv;
#pragma unroll
            for (int j = 0; j < 4; ++j) o[4 * q + j] = pg8::gelu_t(a[j]) * b[j];
        }
        *(GAS v4u*)(act + pg8::tix(row, c0, DFF)) = pack8f(o);
    }
}

__device__ __forceinline__ f32x2 cmulf(f32x2 a, f32x2 b) { return (f32x2){a.x * b.x - a.y * b.y, a.x * b.y + a.y * b.x}; }
__device__ __forceinline__ void scan_pass1_reg(int layer, const bf16* u, const f32x2* abar, const bf16* BBt, f32x2* E, int wave, int lane) {
    const int dir = wave & 1, hh = lane >> 5, pl = lane & 31;
    for (int pi0 = (int)blockIdx.x * 4; pi0 < NG * NSEG; pi0 += (int)gridDim.x * 4) {
        const int pi = pi0 + (wave >> 1), g = pi & 63, seg = pi >> 6, ldg = (layer * 2 + dir) * NG + g;
        bf16x8 bbf[4];
#pragma unroll
        for (int nb = 0; nb < 4; ++nb) bbf[nb] = *(const GAS bf16x8*)(BBt + ((size_t)ldg * 128 + 32 * nb + pl) * 16 + 8 * hh);
        f32x2 w[2][16], a32[2];
#pragma unroll
        for (int b = 0; b < 2; ++b) {
            const f32x2 a = abar[ldg * 64 + pl + 32 * b];
            f32x2 P[33]; P[0] = (f32x2){1.f, 0.f};
#pragma unroll
            for (int k = 1; k <= 32; ++k) P[k] = cmulf(P[k - 1], a);
            a32[b] = P[32];
            const bool up4 = dir ? (hh == 1) : (hh == 0);
            const f32x2 F = up4 ? P[4] : (f32x2){1.f, 0.f};
#pragma unroll
            for (int i = 0; i < 16; ++i) { const int base = (i & 3) + 8 * (i >> 2); const f32x2 pw = dir ? P[base] : P[27 - base]; w[b][i] = cmulf(pw, F); }
        }
        f32x2 S[2] = {(f32x2){0.f, 0.f}, (f32x2){0.f, 0.f}};
        int nv = (LTOK - seg * SEGLEN + CHT - 1) / CHT; nv = nv > NCH ? NCH : nv; nv = __builtin_amdgcn_readfirstlane(nv);
        const bf16* ubase = u + (size_t)g * 16 + 8 * hh;
        constexpr int PF1 = 4;
        bf16x8 cur[PF1], nxt[PF1];
#pragma unroll
        for (int k = 0; k < PF1; ++k) { const int cc = k < nv ? k : nv - 1; int tl = seg * SEGLEN + (dir ? nv - 1 - cc : cc) * CHT + pl; tl = tl < LTOK ? tl : LTOK - 1; cur[k] = *(const GAS bf16x8*)(ubase + (size_t)tl * DSS); }
        for (int cb = 0; cb < nv; cb += PF1) {
#pragma unroll
            for (int k = 0; k < PF1; ++k) { const int cn = cb + PF1 + k, cc = cn < nv ? cn : nv - 1; int tl = seg * SEGLEN + (dir ? nv - 1 - cc : cc) * CHT + pl; tl = tl < LTOK ? tl : LTOK - 1; nxt[k] = *(const GAS bf16x8*)(ubase + (size_t)tl * DSS); }
#pragma unroll
            for (int k = 0; k < PF1; ++k) { const int ci = cb + k; if (ci < nv) {
                const int tlk = seg * SEGLEN + (dir ? nv - 1 - ci : ci) * CHT + pl;
                const bf16x8 uf = tlk < LTOK ? cur[k] : (bf16x8){0, 0, 0, 0, 0, 0, 0, 0};
                const f32x16 z16 = (f32x16){0.f, 0.f, 0.f, 0.f, 0.f, 0.f, 0.f, 0.f, 0.f, 0.f, 0.f, 0.f, 0.f, 0.f, 0.f, 0.f};
#pragma unroll
                for (int b = 0; b < 2; ++b) {
                    const f32x16 xr = __builtin_amdgcn_mfma_f32_32x32x16_bf16(uf, bbf[b], z16, 0, 0, 0);
                    const f32x16 xi = __builtin_amdgcn_mfma_f32_32x32x16_bf16(uf, bbf[b + 2], z16, 0, 0, 0);
                    float er = 0.f, ei = 0.f;
#pragma unroll
                    for (int i = 0; i < 16; ++i) { er += w[b][i].x * xr[i] - w[b][i].y * xi[i]; ei += w[b][i].x * xi[i] + w[b][i].y * xr[i]; }
                    er += __shfl_xor(er, 32); ei += __shfl_xor(ei, 32);
                    const f32x2 s = S[b]; S[b] = (f32x2){a32[b].x * s.x - a32[b].y * s.y + er, a32[b].x * s.y + a32[b].y * s.x + ei};
                }
            } }
#pragma unroll
            for (int k = 0; k < PF1; ++k) cur[k] = nxt[k];
        }
        if (hh == 0) { f32x2* Ep = E + ((size_t)(dir * NG + g) * NSEG + seg) * 64 + pl; Ep[0] = S[0]; Ep[32] = S[1]; }
    }
}

template <bool PASS2>
__device__ __forceinline__ void scan_pass(LAS unsigned char* lds, int layer, const bf16* u, const f32x2* abar, const f32x2* aseg, const bf16* BBt, const bf16* CCt, f32x2* E,
                                          float* yf, float* yb, const float* Dv, bf16* sout, int wave, int lane, int tid) {
    LAS unsigned char* xb = lds + wave * XBUF;
    const int dir = wave & 1;
    float* ybuf = dir ? yb : yf;
    for (int pi0 = (int)blockIdx.x * 4; pi0 < NG * NSEG; pi0 += (int)gridDim.x * 4) {
        const int pi = pi0 + (wave >> 1), g = pi & 63, seg = pi >> 6, ldg = (layer * 2 + dir) * NG + g;
        const f32x2 a = abar[ldg * 64 + lane]; const float nay = -a.y;
        bf16x8 bbf[4];
#pragma unroll
        for (int nb = 0; nb < 4; ++nb) bbf[nb] = *(const GAS bf16x8*)(BBt + ((size_t)ldg * 128 + 32 * nb + (lane & 31)) * 16 + 8 * (lane >> 5));
        bf16x8 ccf[4];
        float sr = 0.f, si = 0.f;
        if (PASS2) {
#pragma unroll
            for (int ks = 0; ks < 4; ++ks) ccf[ks] = *(const GAS bf16x8*)(CCt + ((size_t)ldg * 16 + (lane & 15)) * 128 + 32 * ks + 8 * (lane >> 4));
            const f32x2 as = aseg[ldg * 64 + lane]; const f32x2* Eb = E + ((size_t)(dir * NG + g) * NSEG) * 64 + lane;
            if (dir == 0) { for (int s2 = 0; s2 < seg; ++s2) { const f32x2 e = Eb[s2 * 64]; const float nr = as.x * sr - as.y * si + e.x, ni = as.x * si + as.y * sr + e.y; sr = nr; si = ni; } }
            else { for (int s2 = NSEG - 1; s2 > seg; --s2) { const f32x2 e = Eb[s2 * 64]; const float nr = as.x * sr - as.y * si + e.x, ni = as.x * si + as.y * sr + e.y; sr = nr; si = ni; } }
        }
        int nv = (LTOK - seg * SEGLEN + CHT - 1) / CHT; nv = nv > NCH ? NCH : nv; nv = __builtin_amdgcn_readfirstlane(nv);
        const bf16* ubase = u + (size_t)g * 16 + 8 * (lane >> 5);
        constexpr int PF2 = 2;
        bf16x8 cur[PF2], nxt[PF2];
#pragma unroll
        for (int k = 0; k < PF2; ++k) { const int cc = k < nv ? k : nv - 1; int tl = seg * SEGLEN + (dir ? nv - 1 - cc : cc) * CHT + (lane & 31); tl = tl < LTOK ? tl : LTOK - 1; cur[k] = *(const GAS bf16x8*)(ubase + (size_t)tl * DSS); }
        __builtin_amdgcn_s_waitcnt(0x0F70);
        for (int cb = 0; cb < nv; cb += PF2) {
#pragma unroll
          for (int k = 0; k < PF2; ++k) { const int cn = cb + PF2 + k, cc = cn < nv ? cn : nv - 1; int tl = seg * SEGLEN + (dir ? nv - 1 - cc : cc) * CHT + (lane & 31); tl = tl < LTOK ? tl : LTOK - 1; nxt[k] = *(const GAS bf16x8*)(ubase + (size_t)tl * DSS); }
#pragma unroll
          for (int k = 0; k < PF2; ++k) { const int ci = cb + k; if (ci < nv) {
            const int c = dir ? (nv - 1 - ci) : ci; const int t0 = __builtin_amdgcn_readfirstlane(seg * SEGLEN + c * CHT);
            const bf16x8 uf = (t0 + (lane & 31)) < LTOK ? cur[k] : (bf16x8){0, 0, 0, 0, 0, 0, 0, 0};
            const f32x16 z16 = (f32x16){0.f, 0.f, 0.f, 0.f, 0.f, 0.f, 0.f, 0.f, 0.f, 0.f, 0.f, 0.f, 0.f, 0.f, 0.f, 0.f};
#pragma unroll
            for (int b = 0; b < 2; ++b) {
                const f32x16 xr = __builtin_amdgcn_mfma_f32_32x32x16_bf16(uf, bbf[b], z16, 0, 0, 0);
                const f32x16 xi = __builtin_amdgcn_mfma_f32_32x32x16_bf16(uf, bbf[b + 2], z16, 0, 0, 0);
                LAS unsigned char* wp = xb + (4 * (lane >> 5)) * XROW + (32 * b + (lane & 31)) * 8;
#pragma unroll
                for (int i = 0; i < 16; ++i) { LAS float* q = (LAS float*)(wp + ((i & 3) + 8 * (i >> 2)) * XROW); q[0] = xr[i]; q[1] = xi[i]; }
            }
            LDS_WAIT();
            f32x2 xs[CHT];
#pragma unroll
            for (int j = 0; j < CHT; ++j) xs[j] = *(const LAS f32x2*)(xb + j * XROW + lane * 8);
            if (dir == 0) {
#pragma unroll
                for (int j = 0; j < CHT; ++j) { const float t1 = fma_s(a.x, sr, xs[j].x), t2 = fma_s(a.x, si, xs[j].y); const float nr = fma_s(nay, si, t1), ni = fma_s(a.y, sr, t2); sr = nr; si = ni; if (PASS2) { xs[j].x = sr; xs[j].y = si; } }
            } else {
#pragma unroll
                for (int j = CHT - 1; j >= 0; --j) { const float t1 = fma_s(a.x, sr, xs[j].x), t2 = fma_s(a.x, si, xs[j].y); const float nr = fma_s(nay, si, t1), ni = fma_s(a.y, sr, t2); sr = nr; si = ni; if (PASS2) { xs[j].x = sr; xs[j].y = si; } }
            }
            if (PASS2) {
#pragma unroll
                for (int j = 0; j < CHT; ++j) *(LAS unsigned*)(xb + j * XROW + 4 * lane) = pk2(xs[j].x, xs[j].y);
                LDS_WAIT();
#pragma unroll
                for (int mb = 0; mb < 2; ++mb) {
                    f32x4 y = (f32x4){0.f, 0.f, 0.f, 0.f};
#pragma unroll
                    for (int ks = 0; ks < 4; ++ks) { const bf16x8 af = *(const LAS bf16x8*)(xb + (16 * mb + (lane & 15)) * XROW + (32 * ks + 8 * (lane >> 4)) * 2);
                        y = __builtin_amdgcn_mfma_f32_16x16x32_bf16(ccf[ks], af, y, 0, 0, 0); }
                    { const int tok = t0 + 16 * mb + (lane & 15); *(GAS f32x4*)(ybuf + (size_t)tok * DSS + g * 16 + 4 * (lane >> 4)) = y; }
                }
                LDS_WAIT();
            }
          } }
#pragma unroll
          for (int k = 0; k < PF2; ++k) cur[k] = nxt[k];
        }
        if (!PASS2) E[((size_t)(dir * NG + g) * NSEG + seg) * 64 + lane] = (f32x2){sr, si};
        if (PASS2) {
            VM_WAIT(); __syncthreads();
            const int g0 = pi0 & 63, sg = pi0 >> 6, cq = tid & 15, tb = sg * SEGLEN;
            const int te = (tb + SEGLEN < LTOK) ? tb + SEGLEN : LTOK;
            const f32x4 dv = *(const GAS f32x4*)(Dv + g0 * 16 + 4 * cq);
            for (int t0 = tb + (tid >> 4); t0 < te; t0 += 128) {
                f32x4 a1[4], a2[4]; v2u uu[4];
#pragma unroll
                for (int q = 0; q < 4; ++q) { const int t = t0 + 32 * q, tc = t < te ? t : te - 1; const size_t off = (size_t)tc * DSS + g0 * 16 + 4 * cq;
                    a1[q] = *(const GAS f32x4*)(yf + off); a2[q] = *(const GAS f32x4*)(yb + off); uu[q] = *(const GAS v2u*)(u + off); }
#pragma unroll
                for (int q = 0; q < 4; ++q) { const int t = t0 + 32 * q;
                    if (t < te) {
                        const float v0 = a1[q].x + a2[q].x + dv.x * bf_lo(uu[q].x), v1 = a1[q].y + a2[q].y + dv.y * bf_hi(uu[q].x), v2 = a1[q].z + a2[q].z + dv.z * bf_lo(uu[q].y), v3 = a1[q].w + a2[q].w + dv.w * bf_hi(uu[q].y);
                        v2u w; w.x = pk2(pg8::gelu_t(v0), pg8::gelu_t(v1)); w.y = pk2(pg8::gelu_t(v2), pg8::gelu_t(v3));
                        *(GAS v2u*)(sout + pg8::tix(t, g0 * 16 + 4 * cq, DSS)) = w; } }
            }
            __syncthreads();
        }
    }
}

struct Args { const float* in[21]; float* out; unsigned char* ws; int ph_lo, ph_hi; };
__global__ void __launch_bounds__(NWAVES * 64, 2) mk_fwd(Args args) {
    extern __shared__ __attribute__((aligned(16))) unsigned char lds_raw[];
    LAS unsigned char* lds = (LAS unsigned char*)lds_raw;
    const int G = gridDim.x, bx = blockIdx.x, ngw = G * NWAVES, nthr = G * NWAVES * 64;
#define SITE_IDS() int tid = threadIdx.x; asm volatile("" : "+v"(tid)); const int lane = tid & 63, wave = __builtin_amdgcn_readfirstlane(tid >> 6), gw = bx * NWAVES + wave, gtid = bx * (NWAVES * 64) + tid; (void)lane; (void)wave; (void)gw; (void)gtid
    unsigned char* ws = args.ws;
    volatile LAS unsigned* MISC = (volatile LAS unsigned*)(lds + LDSCTL_OFF);
    for (int i = threadIdx.x; i < (LDS_BYTES - LDSCTL_OFF) / 4; i += NWAVES * 64) MISC[i] = 0u;
    __syncthreads();
    const int lo = args.ph_lo, hi = args.ph_hi;
    XcdBarrier bar; bar.bar = (unsigned*)(ws + WS_CTL) + 4096; bar.x = 0; bar.st = nullptr;
    if (hi - lo > 1) bar = xcd_barrier_post((unsigned*)(ws + WS_CTL) + 4096, MISC + 8);
#ifndef SITE_MASK
#define SITE_MASK 0xFFFF
#endif
#define EN(s) ((SITE_MASK >> (s)) & 1)
#define IN(k) (lo <= (k) && (k) < hi)
#define SEAM(k) do { if (IN((k) + 1)) xcd_barrier(bar); } while (0)

    const float* x = args.in[0]; const float* meta = args.in[1];
    signed char* hb8 = (signed char*)(ws + WS_HB8); signed char* wg8 = (signed char*)(ws + WS_WG8); float* rs8b = (float*)(ws + WS_RS8); float* cs8b = (float*)(ws + WS_CS8); float* csub = (float*)(ws + WS_RSTD + 1 * MiB);
    bf16* hb = (bf16*)(ws + WS_H);
    bf16* bgb = (bf16*)(ws + WS_R + R_BG); bf16* cvb = (bf16*)(ws + WS_R + R_CV); bf16* ub = (bf16*)(ws + WS_R + R_U); bf16* gab = (bf16*)(ws + WS_R + R_GA); bf16* gbb = (bf16*)(ws + WS_R + R_GB);
    bf16* ainb = (bf16*)(ws + WS_R + R_AIN); bf16* sb = (bf16*)(ws + WS_R + R_S); bf16* mb = (bf16*)(ws + WS_R + R_M); float* yfb = (float*)(ws + WS_R + R_YF); float* ybb = (float*)(ws + WS_R + R_YB);
    bf16* m1b = (bf16*)(ws + WS_R);
    bf16* dlt = (bf16*)(ws + WS_R + 650 * MiB);     float* rstdb = (float*)(ws + WS_RSTD);
    float* zedge = (float*)(ws + WS_R); float* ztail = (float*)(ws + WS_R + 32 * MiB); bf16* actb = (bf16*)(ws + WS_R + 64 * MiB);
    f32x2* abar = (f32x2*)(ws + WS_ABAR); f32x2* aseg = (f32x2*)(ws + WS_ASEG); bf16* BBt = (bf16*)(ws + WS_BBT); bf16* CCt = (bf16*)(ws + WS_CCT); f32x2* Eb = (f32x2*)(ws + WS_E);

    if (EN(0) && IN(0)) { SITE_IDS();
        LAS float* scr = (LAS float*)(lds + wave * 16640);
        for (int l = 0; l < 2; ++l) {
            unsigned char* wl = ws + WS_W + (size_t)l * W_LAYER;
            convert_matrix(args.in[3] + (size_t)l * DM * NIN, args.in[2] + l * DM, DM, NIN, (bf16*)(wl + W_IN), 1, scr, gw, ngw, lane, 7168);
            convert_matrix(args.in[5] + (size_t)l * DC * DM, nullptr, DC, DM, (bf16*)(wl + W_A), 0, scr, gw, ngw, lane);
            convert_matrix(args.in[14] + (size_t)l * DSS * 2 * DM, nullptr, DSS, 2 * DM, (bf16*)(wl + W_GLU), 2, scr, gw, ngw, lane);
            convert_matrix(args.in[15] + (size_t)l * DM * DM, nullptr, DM, DM, (bf16*)(wl + W_OUT), 0, scr, gw, ngw, lane);
            convert_matrix(args.in[19] + (size_t)l * DFF * DM, nullptr, DFF, DM, (bf16*)(wl + W_DOWN), 0, scr, gw, ngw, lane);
        }
        __syncthreads();
        for (int t = bx; t < 512 + 1536; t += G) {
            if (t < 512) { const int ly = t >> 8, cbk = t & 255;
                weights_i8(lds, args.in[3] + (size_t)ly * DM * NIN, NIN, args.in[2] + ly * DM, wg8 + (size_t)ly * (32 * MiB), cs8b + ly * 8192, 7168 + 32 * cbk, 32 * cbk, wave, lane, tid, -1.44269504089f); }
            else { const int u = t - 512, ly = u / 768, cbk = u % 768;
                weights_i8(lds, args.in[17] + (size_t)ly * DM * 2 * DFF, 2 * DFF, args.in[16] + ly * DM, (signed char*)(ws + WS_W + (size_t)ly * W_LAYER + W_UP), csub + ly * 24576, 32 * cbk, dest_row(2, 2 * DFF, 32 * cbk), wave, lane, tid); }
        }
        if (gtid < 2 * 2 * NG * 64) scan_params(gtid, args.in[6], args.in[7], args.in[8], args.in[9], args.in[10], args.in[11], args.in[12], abar, aseg, BBt, CCt);
        for (int r = gw; r < LTOK; r += ngw) {
            const GAS f32x4* xr = (const GAS f32x4*)(r < NMETA ? meta + (size_t)r * DM : x + (size_t)(r - NMETA) * DM) + 2 * lane;
            float s = 0.f; float vv[8][8];
#pragma unroll
            for (int j = 0; j < 8; ++j) { const f32x4 v0 = xr[128 * j], v1 = xr[128 * j + 1];
                vv[j][0] = v0.x; vv[j][1] = v0.y; vv[j][2] = v0.z; vv[j][3] = v0.w; vv[j][4] = v1.x; vv[j][5] = v1.y; vv[j][6] = v1.z; vv[j][7] = v1.w; }
#pragma unroll
            for (int j = 0; j < 8; ++j) {
#pragma unroll
                for (int e = 0; e < 8; ++e) s += vv[j][e] * vv[j][e];
                v4u w; w.x = pk2(vv[j][0], vv[j][1]); w.y = pk2(vv[j][2], vv[j][3]); w.z = pk2(vv[j][4], vv[j][5]); w.w = pk2(vv[j][6], vv[j][7]);
                *(GAS v4u*)(hb + pg8::tix(r, 8 * lane + 512 * j, DM)) = w; }
            s = wave_sum(s);
            const float rstd_r = 1.0f / sqrtf(s * (1.0f / DM) + EPS);
            if (lane == 0) rstdb[r] = rstd_r;
            { const float ms = quant_row8w(vv, hb8, r, lane); if (lane == 0) rs8b[r] = ms * rstd_r; }
        }
        SEAM(0);
    }
    for (int l = 0; l < 2; ++l) {
        const int pb = 1 + 11 * l;
        unsigned char* wl = ws + WS_W + (size_t)l * W_LAYER;
        if (EN(1) && IN(pb + 0) && l > 0) { SITE_IDS(); stat_phase(hb, rstdb, hb8, rs8b, LTOK, gw, ngw, lane); SEAM(pb + 0); }
        if (EN(2) && IN(pb + 1)) {
            pg8::Gemm g{hb, (const bf16*)(wl + W_IN), MG, 7168, DM}; pg8::StaticOrder S; S.init(MG, 7168, G, bx);
            pg8::EpiIn E{bgb, cvb, ub, gab, gbb, rstdb};
            pg8::gemm_phase<pg8::EpiIn, pg8::StaticOrder, true, true, true, WTILED>(lds, g, S, E);
            { pg8::Gemm g8{(const bf16*)hb8, (const bf16*)(wg8 + (size_t)l * (32 * MiB)), MG, 8192, 2048}; pg8::StaticOrder S8; S8.init(MG, 8192, G, bx);
              pg8::EpiGate8 E8{pg8::EpiIn{bgb, cvb, ub, gab, gbb, rs8b}, cs8b + l * 8192};
              pg8::gemm_phase<pg8::EpiGate8, pg8::StaticOrder, true, true, true, true, true>(lds, g8, S8, E8); }
            pg8::tail_gemm<decltype(E), WTILED>(lds, hb, (const bf16*)(wl + W_IN), 7168, DM, MG, E);
            { pg8::EpiGate8 E8{pg8::EpiIn{bgb, cvb, ub, gab, gbb, rs8b}, cs8b + l * 8192}; pg8::tail_gemm<decltype(E8), true, true>(lds, (const bf16*)hb8, (const bf16*)(wg8 + (size_t)l * (32 * MiB)), 8192, 2048, MG, E8); }
            SEAM(pb + 1);
        }
        if (EN(3) && IN(pb + 2)) { SITE_IDS();
            scan_pass1_reg(l, ub, abar, BBt, Eb, wave, lane);
            conv_a_phase(bgb, cvb, args.in[4] + l * 3 * DC, ainb, gtid, nthr);
            SEAM(pb + 2);
        }
        if (EN(4) && IN(pb + 3)) { SITE_IDS();
            scan_pass<true>(lds, l, ub, abar, aseg, BBt, CCt, Eb, yfb, ybb, args.in[13] + l * DSS, sb, wave, lane, tid);
        }
        if (EN(5) && IN(pb + 3)) {
            pg8::Gemm g{ainb, (const bf16*)(wl + W_A), MG, DM, DC}; pg8::StaticOrder S; S.init(MG, DM, G, bx);
            pg8::EpiMulGate E{gab, m1b};
            pg8::gemm_phase<pg8::EpiMulGate, pg8::StaticOrder, true, true, true, WTILED>(lds, g, S, E);
            pg8::tail_gemm<decltype(E), WTILED>(lds, ainb, (const bf16*)(wl + W_A), DM, DC, MG, E);
            SEAM(pb + 4);
        }
        if (EN(6) && IN(pb + 5)) {
            pg8::Gemm g{sb, (const bf16*)(wl + W_GLU), MG, 2 * DM, DSS}; pg8::StaticOrder S; S.init(MG, 2 * DM, G, bx);
            pg8::EpiGlu E{gbb, m1b, mb};
            pg8::gemm_phase<pg8::EpiGlu, pg8::StaticOrder, true, true, true, WTILED>(lds, g, S, E);
            pg8::tail_gemm<decltype(E), WTILED>(lds, sb, (const bf16*)(wl + W_GLU), 2 * DM, DSS, MG, E);
            SEAM(pb + 5);
        }
        if (EN(7) && IN(pb + 6)) {
            pg8::Gemm g{mb, (const bf16*)(wl + W_OUT), MG, DM, DM}; pg8::StaticOrder S; S.init(MG, DM, G, bx);
            pg8::EpiResid E{hb, dlt, true};
            pg8::gemm_phase<pg8::EpiResid, pg8::StaticOrder, true, true, true, WTILED>(lds, g, S, E);
            pg8::tail_gemm<decltype(E), WTILED>(lds, mb, (const bf16*)(wl + W_OUT), DM, DM, MG, E);
            SEAM(pb + 6);
        }
        if (EN(8) && IN(pb + 7)) { SITE_IDS(); stat_phase(hb, rstdb, hb8, rs8b, LTOK, gw, ngw, lane); SEAM(pb + 7); }
        if (EN(9) && IN(pb + 8)) {
            unsigned char* wsl = ws; asm volatile("" : "+s"(wsl));
            const bf16* a8 = (const bf16*)(wsl + WS_HB8); const bf16* w8 = (const bf16*)(wsl + WS_W + (size_t)l * W_LAYER + W_UP);
            pg8::Gemm g{a8, w8, MG, 2 * DFF, 2048}; pg8::StaticOrder S; S.init(MG, 2 * DFF, G, bx);
            pg8::EpiUp8 E{pg8::EpiUpConv{args.in[18] + (size_t)l * 3 * 2 * DFF, (bf16*)(wsl + WS_R + 64 * MiB), (float*)(wsl + WS_R), (LAS float*)(lds + pg8::STAGE_BYTES), (float*)(wsl + WS_R + 32 * MiB), (const float*)(wsl + WS_RS8), (const float*)(wsl + WS_RSTD + 1 * MiB) + l * 24576}};
            pg8::gemm_phase<pg8::EpiUp8, pg8::StaticOrder, true, true, true, true, true>(lds, g, S, E);
            pg8::tail_gemm<decltype(E), true, true>(lds, a8, w8, 2 * DFF, 2048, MG, E);
            SEAM(pb + 8);
        }
        if (EN(10) && IN(pb + 9)) { SITE_IDS(); conv_edge_phase(zedge, ztail, args.in[18] + (size_t)l * 3 * 2 * DFF, actb, gtid, nthr); SEAM(pb + 9); }
        if (EN(11) && IN(pb + 10)) {
            pg8::Gemm g{actb, (const bf16*)(wl + W_DOWN), MG, DM, DFF}; pg8::StaticOrder S; S.init(MG, DM, G, bx);
            pg8::EpiResid E{hb, dlt, l == 0};
            pg8::gemm_phase<pg8::EpiResid, pg8::StaticOrder, true, true, true, WTILED>(lds, g, S, E);
            pg8::tail_gemm<decltype(E), WTILED>(lds, actb, (const bf16*)(wl + W_DOWN), DM, DFF, MG, E);
            SEAM(pb + 10);
        }
    }
    if (EN(12) && IN(23)) { SITE_IDS(); final_norm(hb, NMETA, dlt + (size_t)NMETA * DM, args.in[20], args.out, SEQ, gw, ngw, lane); }
#undef IN
#undef SEAM
}

extern "C" void kernel_launch(void* const* d_in, const int* in_sizes, int n_in, void* d_out, int out_size, void* d_ws, size_t ws_size, hipStream_t stream) {
    static int grid = 0;
    if (grid == 0) {
        if (n_in != 21 || out_size != SEQ * DM || ws_size < WS_END) { fprintf(stderr, "kernel_launch: unexpected shapes: n_in %d out %d ws %zu (need %zu)\n", n_in, out_size, ws_size, (size_t)WS_END); grid = -1; return; }
        int dev = 0, cus = 0, per_cu = 0;
        if (hipGetDevice(&dev) != hipSuccess || hipDeviceGetAttribute(&cus, hipDeviceAttributeMultiprocessorCount, dev) != hipSuccess) { grid = -1; return; }
        if (hipFuncSetAttribute((const void*)mk_fwd, hipFuncAttributeMaxDynamicSharedMemorySize, LDS_BYTES) != hipSuccess) { fprintf(stderr, "kernel_launch: hipFuncSetAttribute failed\n"); grid = -1; return; }
        if (hipOccupancyMaxActiveBlocksPerMultiprocessor(&per_cu, (const void*)mk_fwd, NWAVES * 64, LDS_BYTES) != hipSuccess || per_cu < 1) { fprintf(stderr, "kernel_launch: occupancy query says %d\n", per_cu); }
        (void)hipGetLastError();
        grid = cus;
    }
    if (grid < 0) return;
    if (hipMemsetAsync((char*)d_ws + WS_CTL, 0, CTL_ZERO_BYTES, stream) != hipSuccess) return;
    Args a{};
    for (int i = 0; i < 21; ++i) a.in[i] = (const float*)d_in[i];
    a.out = (float*)d_out; a.ws = (unsigned char*)d_ws;
#if MK_N_LAUNCHES == 1
    a.ph_lo = 0; a.ph_hi = NPH;
    hipLaunchKernelGGL(mk_fwd, dim3(grid), dim3(NWAVES * 64), LDS_BYTES, stream, a);
#else
    for (int p = 0; p < NPH; ++p) { a.ph_lo = p; a.ph_hi = p + 1; hipLaunchKernelGGL(mk_fwd, dim3(grid), dim3(NWAVES * 64), LDS_BYTES, stream, a); }
#endif
}
```

```cpp
#include <hip/hip_runtime.h>
#include <cstdio>
#include <cstdint>
namespace pg8 {
#define PG8_LAS __attribute__((address_space(3)))
typedef unsigned short bf16_t;
typedef short bf16x8 __attribute__((ext_vector_type(8)));
typedef float f32x4 __attribute__((ext_vector_type(4)));
typedef unsigned u32x4 __attribute__((ext_vector_type(4)));
typedef int i32x4 __attribute__((ext_vector_type(4)));
constexpr int BM = 256, BK = 64, HALF = 128, HTB = HALF * BK * 2  , STAGE_BYTES = 8 * HTB, NXCD = 8, WGM = 4;

__host__ __device__ __forceinline__ int lds_byte(int r, int c) { const int st = (r >> 4) * 2 + (c >> 5), rr = r & 15, cc = c & 31, ob = rr * 64 + cc * 2; return st * 1024 + (ob ^ (((ob >> 9) & 1) << 5)); }
__host__ __device__ __forceinline__ void stage_rc(int b, int& R, int& C) { const int st = b / 1024, sb = b % 1024, swz = sb ^ (((sb >> 9) & 1) << 5); R = (st >> 1) * 16 + swz / 64; C = (st & 1) * 32 + (swz % 64) / 2; }
__host__ __device__ __forceinline__ int perm32(int rho) { const int n = rho >> 4, i = rho & 15; return 8 * (i >> 2) + 4 * n + (i & 3); }

struct Unit { int pm, pn; };
struct Gemm { const bf16_t* A; const bf16_t* Bt; int M, N, K; };

struct StaticOrder {
    int nM, nN, nwg, G, c;
    __host__ __device__ void init(int M, int N, int G_, int c_) { nM = M / BM; nN = N / BM; nwg = nM * nN; G = G_; c = c_; }
    __host__ __device__ bool next(int i, Unit& u) const {
        const long L = (long)i * G + c; if (L >= nwg) return false;
        int wgid = (int)L; { const int q = nwg / NXCD, r = nwg % NXCD, xcd = wgid % NXCD, off = wgid / NXCD; wgid = (xcd < r ? xcd * (q + 1) : r * (q + 1) + (xcd - r) * q) + off; }
        const int nig = WGM * nN, gid = wgid / nig, fm = gid * WGM, gsz = (nM - fm) < WGM ? (nM - fm) : WGM;
        u.pm = fm + ((wgid % nig) % gsz); u.pn = (wgid % nig) / gsz; return true;
    }
    __device__ __forceinline__ void a_ready(const Unit&) const {}
    __device__ __forceinline__ void done(const Unit&) const {}
};

__device__ __forceinline__ unsigned cvt_pk_bf16(float lo, float hi) { unsigned r; asm volatile("v_cvt_pk_bf16_f32 %0, %1, %2" : "=v"(r) : "v"(lo), "v"(hi)); return r; }
typedef float f32x2 __attribute__((ext_vector_type(2)));
__device__ __forceinline__ f32x2 gelu_pk(f32x2 v) {
    const f32x2 av = __builtin_elementwise_abs(v), d = av * 0.2316418882f + 1.0f;
    f32x2 t; t.x = __builtin_amdgcn_rcpf(d.x); t.y = __builtin_amdgcn_rcpf(d.y);
    f32x2 q = t * 0.5307027145f + (-0.7265760135f); q = q * t + 0.7107068705f; q = q * t + (-0.142248368f); q = q * t + 0.127414796f; q = q * t;
    const f32x2 s = (v * v) * (-0.72134752044f);
    f32x2 e; e.x = __builtin_amdgcn_exp2f(s.x); e.y = __builtin_amdgcn_exp2f(s.y);
    const f32x2 m = v * (q * e), r = v - m;
    f32x2 o; o.x = v.x < 0.f ? m.x : r.x; o.y = v.y < 0.f ? m.y : r.y; return o;
}

template <int ACT  > struct EpiBf16 {
    static constexpr bool PERM = true, AFTER_DRAIN = false; static_assert(ACT == 0 || ACT == 1, "EpiBf16: ACT is 0 (none) or 1 (gelu_pk)");
    bf16_t* O; int ldc; const float* bias; int split_cols; size_t split_stride; float scale0;
    __device__ __forceinline__ void operator()(const f32x4 (&acc)[2][2][4][2], const Unit& u, int wr, int wc, int fr, int fq) const {
        const int row0 = u.pm * BM + wr * 64 + fr; int colt = u.pn * BM; bf16_t* base = O;
        float sc = 1.f; if (split_cols) { const int t = colt / split_cols; base += (size_t)t * split_stride; colt -= t * split_cols; if (t == 0) sc = scale0; }
        const int col0 = colt + wc * 32 + 8 * fq, bcol0 = u.pn * BM + wc * 32 + 8 * fq;
        f32x4 bv[2][2];
#pragma unroll
        for (int bj = 0; bj < 2; ++bj)
#pragma unroll
            for (int n = 0; n < 2; ++n) bv[bj][n] = bias ? *(const f32x4*)(bias + bcol0 + bj * HALF + 4 * n) : (f32x4){0.f, 0.f, 0.f, 0.f};
#pragma unroll
        for (int ai = 0; ai < 2; ++ai)
#pragma unroll
            for (int m = 0; m < 4; ++m) { bf16_t* rowp = base + (size_t)(row0 + ai * HALF + m * 16) * ldc + col0;
#pragma unroll
                for (int bj = 0; bj < 2; ++bj) { f32x4 v0 = acc[ai][bj][m][0] + bv[bj][0], v1 = acc[ai][bj][m][1] + bv[bj][1];
                    if (ACT == 1) { f32x2 a = gelu_pk((f32x2){v0[0], v0[1]}), b = gelu_pk((f32x2){v0[2], v0[3]}), c = gelu_pk((f32x2){v1[0], v1[1]}), d = gelu_pk((f32x2){v1[2], v1[3]});
                        v0 = (f32x4){a.x, a.y, b.x, b.y}; v1 = (f32x4){c.x, c.y, d.x, d.y}; }
                    v0 = v0 * sc; v1 = v1 * sc; u32x4 w; w.x = cvt_pk_bf16(v0[0], v0[1]); w.y = cvt_pk_bf16(v0[2], v0[3]); w.z = cvt_pk_bf16(v1[0], v1[1]); w.w = cvt_pk_bf16(v1[2], v1[3]);
                    *(u32x4*)(rowp + bj * HALF) = w; } }
    }
};
__host__ __device__ __forceinline__ size_t tix(int r, int c, int K) { return ((size_t)(r >> 8) * (size_t)(K >> 6) + (size_t)(c >> 6)) * 16384 + (size_t)((r & 255) * 64 + (c & 63)); }
__device__ __forceinline__ float sigm(float x) { return __builtin_amdgcn_rcpf(1.0f + __builtin_amdgcn_exp2f(-1.44269504089f * x)); }
__device__ __forceinline__ float sigm_pre(float t) { return __builtin_amdgcn_rcpf(1.0f + __builtin_amdgcn_exp2f(t)); }
__device__ __forceinline__ float gelu_t(float x) { const float u = x * __builtin_fmaf(-0.10294324f, x * x, -2.30220815f); return x * __builtin_amdgcn_rcpf(1.0f + __builtin_amdgcn_exp2f(u)); }
__device__ __forceinline__ bf16_t f2bf_s(float f) { unsigned u = __float_as_uint(f); return (bf16_t)((u + 0x7fffu + ((u >> 16) & 1u)) >> 16); }
__device__ __forceinline__ float bf2f_s(bf16_t b) { return __uint_as_float(((unsigned)b) << 16); }
__device__ __forceinline__ f32x4 bflo(unsigned a, unsigned b) { return (f32x4){__uint_as_float(a << 16), __uint_as_float(a & 0xffff0000u), __uint_as_float(b << 16), __uint_as_float(b & 0xffff0000u)}; }
__device__ __forceinline__ u32x4 pack8(f32x4 v0, f32x4 v1) { u32x4 w; w.x = cvt_pk_bf16(v0[0], v0[1]); w.y = cvt_pk_bf16(v0[2], v0[3]); w.z = cvt_pk_bf16(v1[0], v1[1]); w.w = cvt_pk_bf16(v1[2], v1[3]); return w; }

__device__ __forceinline__ void scale_rows(f32x4 (&acc)[2][2][4][2], const float* rstd, int row0) {
#pragma unroll
    for (int ai = 0; ai < 2; ++ai)
#pragma unroll
        for (int m = 0; m < 4; ++m) { const float rs = rstd[row0 + ai * HALF + m * 16];
#pragma unroll
            for (int bj = 0; bj < 2; ++bj)
#pragma unroll
                for (int n = 0; n < 2; ++n) acc[ai][bj][m][n] = acc[ai][bj][m][n] * rs; }
}

struct EpiIn {
    static constexpr bool PERM = true, AFTER_DRAIN = false;
    bf16_t *bg, *cv, *u, *ga, *gb; const float* rstd;
    __device__ __forceinline__ void operator()(f32x4 (&acc)[2][2][4][2], const Unit& un, int wr, int wc, int fr, int fq) const {
        const int pn = un.pn; const int row0 = un.pm * BM + wr * 64 + fr; const int cb = wc * 32 + 8 * fq;
        scale_rows(acc, rstd, row0);
        if (pn >= 8 && pn < 24) {
            bf16_t* base = cv + (size_t)row0 * 2048 + (pn - 8) * 128 + cb;
#pragma unroll
            for (int ai = 0; ai < 2; ++ai)
#pragma unroll
                for (int m = 0; m < 4; ++m) { bf16_t* rowp = base + (size_t)(ai * HALF + m * 16) * 2048;
                    *(u32x4*)rowp = pack8(acc[ai][0][m][0] * acc[ai][1][m][0], acc[ai][0][m][1] * acc[ai][1][m][1]); }
        } else {
            bf16_t* base; int ld; bool sg;
            if (pn < 8) { base = bg + pn * 256; ld = 2048; sg = false; }
            else if (pn < 28) { base = u + (pn - 24) * 256; ld = 1024; sg = false; }
            else if (pn < 44) { base = ga + (pn - 28) * 256; ld = 4096; sg = true; }
            else { base = gb + (pn - 44) * 256; ld = 4096; sg = true; }
            base += (size_t)row0 * ld + cb;
#pragma unroll
            for (int ai = 0; ai < 2; ++ai)
#pragma unroll
                for (int m = 0; m < 4; ++m) { bf16_t* rowp = base + (size_t)(ai * HALF + m * 16) * ld;
#pragma unroll
                    for (int bj = 0; bj < 2; ++bj) { f32x4 v0 = acc[ai][bj][m][0], v1 = acc[ai][bj][m][1];
                        if (sg) {
#pragma unroll
                            for (int j = 0; j < 4; ++j) { v0[j] = sigm_pre(v0[j]); v1[j] = sigm_pre(v1[j]); } }
                        *(u32x4*)(rowp + bj * HALF) = pack8(v0, v1); } }
        }
    }
    __device__ __forceinline__ void tail(int row, int pn, int c, float v0, float v1) const {
        { const float rs = rstd[row]; v0 *= rs; v1 *= rs; }
        if (pn >= 8 && pn < 24) { cv[(size_t)row * 2048 + (pn - 8) * 128 + c] = f2bf_s(v0 * v1); return; }
        bf16_t* base; int ld; bool sg;
        if (pn < 8) { base = bg + pn * 256; ld = 2048; sg = false; }
        else if (pn < 28) { base = u + (pn - 24) * 256; ld = 1024; sg = false; }
        else if (pn < 44) { base = ga + (pn - 28) * 256; ld = 4096; sg = true; }
        else { base = gb + (pn - 44) * 256; ld = 4096; sg = true; }
        if (sg) { v0 = sigm_pre(v0); v1 = sigm_pre(v1); }
        base[(size_t)row * ld + c] = f2bf_s(v0); base[(size_t)row * ld + 128 + c] = f2bf_s(v1);
    }
};
struct EpiGate8 {
    static constexpr bool PERM = true, AFTER_DRAIN = false;
    EpiIn e; const float* colscale;
    __device__ __forceinline__ void operator()(f32x4 (&acc)[2][2][4][2], const Unit& un, int wr, int wc, int fr, int fq) const {
        const int cb = wc * 32 + 8 * fq;
#pragma unroll
        for (int bj = 0; bj < 2; ++bj)
#pragma unroll
            for (int n = 0; n < 2; ++n) { const f32x4 cs = *(const f32x4*)(colscale + un.pn * 256 + bj * HALF + cb + 4 * n);
#pragma unroll
                for (int ai = 0; ai < 2; ++ai)
#pragma unroll
                    for (int m = 0; m < 4; ++m) { const i32x4 iv = __builtin_bit_cast(i32x4, acc[ai][bj][m][n]); acc[ai][bj][m][n] = (f32x4){(float)iv[0], (float)iv[1], (float)iv[2], (float)iv[3]} * cs; } }
        Unit u2 = un; u2.pn += 28; e(acc, u2, wr, wc, fr, fq);
    }
    __device__ __forceinline__ void tail(int row, int pn, int c, float v0, float v1) const { e.tail(row, pn + 28, c, v0 * colscale[pn * 256 + c], v1 * colscale[pn * 256 + 128 + c]); }
};
struct EpiMulGate {
    static constexpr bool PERM = true, AFTER_DRAIN = false;
    const bf16_t* ga; bf16_t* m1;
    __device__ __forceinline__ void operator()(const f32x4 (&acc)[2][2][4][2], const Unit& un, int wr, int wc, int fr, int fq) const {
        const unsigned off0 = ((unsigned)(un.pm * BM + wr * 64 + fr) * 4096u + (unsigned)(un.pn * 256 + wc * 32 + 8 * fq)) * 2u;
        u32x4 g[2][4][2];
#pragma unroll
        for (int ai = 0; ai < 2; ++ai)
#pragma unroll
            for (int m = 0; m < 4; ++m)
#pragma unroll
                for (int bj = 0; bj < 2; ++bj) g[ai][m][bj] = *(const u32x4*)((const char*)ga + (size_t)(off0 + (unsigned)((ai * HALF + m * 16) * 8192 + bj * 256)));
#pragma unroll
        for (int ai = 0; ai < 2; ++ai)
#pragma unroll
            for (int m = 0; m < 4; ++m)
#pragma unroll
                for (int bj = 0; bj < 2; ++bj) { const u32x4 gg = g[ai][m][bj];
                    *(u32x4*)((char*)m1 + (size_t)(off0 + (unsigned)((ai * HALF + m * 16) * 8192 + bj * 256))) = pack8(acc[ai][bj][m][0] * bflo(gg.x, gg.y), acc[ai][bj][m][1] * bflo(gg.z, gg.w)); }
    }
    __device__ __forceinline__ void tail(int row, int pn, int c, float v0, float v1) const {
        const size_t o = (size_t)row * 4096 + pn * 256 + c;
        m1[o] = f2bf_s(v0 * bf2f_s(ga[o])); m1[o + 128] = f2bf_s(v1 * bf2f_s(ga[o + 128]));
    }
};
struct EpiGlu {
    static constexpr bool PERM = true, AFTER_DRAIN = false;
    const bf16_t* gb; const bf16_t* m1; bf16_t* mm;
    __device__ __forceinline__ void operator()(const f32x4 (&acc)[2][2][4][2], const Unit& un, int wr, int wc, int fr, int fq) const {
        const unsigned off0 = ((unsigned)(un.pm * BM + wr * 64 + fr) * 4096u + (unsigned)(un.pn * 128 + wc * 32 + 8 * fq)) * 2u;
        const size_t moff0 = (((size_t)un.pm * 64 + (size_t)(un.pn * 2 + (wc >> 1))) * 16384 + (size_t)((wr * 64 + fr) * 64 + (wc & 1) * 32 + 8 * fq)) * 2;
        u32x4 g[2][4], o[2][4];
#pragma unroll
        for (int ai = 0; ai < 2; ++ai)
#pragma unroll
            for (int m = 0; m < 4; ++m) { const size_t off = (size_t)(off0 + (unsigned)((ai * HALF + m * 16) * 8192));
                g[ai][m] = *(const u32x4*)((const char*)gb + off); o[ai][m] = *(const u32x4*)((const char*)m1 + off); }
#pragma unroll
        for (int ai = 0; ai < 2; ++ai)
#pragma unroll
            for (int m = 0; m < 4; ++m) { const size_t off = (size_t)(off0 + (unsigned)((ai * HALF + m * 16) * 8192));
                f32x4 y0 = acc[ai][0][m][0], y1 = acc[ai][0][m][1]; const f32x4 t0 = acc[ai][1][m][0], t1 = acc[ai][1][m][1];
#pragma unroll
                for (int j = 0; j < 4; ++j) { y0[j] *= sigm_pre(t0[j]); y1[j] *= sigm_pre(t1[j]); }
                const u32x4 gg = g[ai][m], oo = o[ai][m];
                *(u32x4*)((char*)mm + moff0 + (size_t)((ai * HALF + m * 16) * 128)) = pack8(bflo(oo.x, oo.y) + bflo(gg.x, gg.y) * y0, bflo(oo.z, oo.w) + bflo(gg.z, gg.w) * y1); }
    }
    __device__ __forceinline__ void tail(int row, int pn, int c, float v0, float v1) const {
        const size_t o = (size_t)row * 4096 + pn * 128 + c;
        mm[tix(row, pn * 128 + c, 4096)] = f2bf_s(bf2f_s(m1[o]) + bf2f_s(gb[o]) * v0 * sigm_pre(v1));
    }
};
struct EpiStoreDelta {
    static constexpr bool PERM = true, AFTER_DRAIN = false;
    bf16_t* dl;
    __device__ __forceinline__ void operator()(const f32x4 (&acc)[2][2][4][2], const Unit& un, int wr, int wc, int fr, int fq) const {
        const unsigned off0 = ((unsigned)(un.pm * BM + wr * 64 + fr) * 4096u + (unsigned)(un.pn * BM + wc * 32 + 8 * fq)) * 2u;
#pragma unroll
        for (int ai = 0; ai < 2; ++ai)
#pragma unroll
            for (int m = 0; m < 4; ++m)
#pragma unroll
                for (int bj = 0; bj < 2; ++bj) *(u32x4*)((char*)dl + (size_t)(off0 + (unsigned)((ai * HALF + m * 16) * 8192 + bj * 256))) = pack8(acc[ai][bj][m][0], acc[ai][bj][m][1]);
    }
    __device__ __forceinline__ void tail(int row, int pn, int c, float v0, float v1) const {
        const size_t o = (size_t)row * 4096 + pn * 256 + c; dl[o] = f2bf_s(v0); dl[o + 128] = f2bf_s(v1);
    }
};
struct EpiResid {
    static constexpr bool PERM = true, AFTER_DRAIN = false;
    bf16_t* hres; bf16_t* dl; bool add;
    __device__ __forceinline__ void operator()(const f32x4 (&acc)[2][2][4][2], const Unit& un, int wr, int wc, int fr, int fq) const {
        if (add) {
            const unsigned off0 = (((unsigned)un.pm * 64u + (unsigned)(un.pn * 4 + (wc >> 1))) * 16384u + (unsigned)((wr * 64 + fr) * 64 + (wc & 1) * 32 + 8 * fq)) * 2u;
            u32x4 h[2][4][2];
#pragma unroll
            for (int ai = 0; ai < 2; ++ai)
#pragma unroll
                for (int m = 0; m < 4; ++m)
#pragma unroll
                    for (int bj = 0; bj < 2; ++bj) h[ai][m][bj] = *(const u32x4*)((const char*)hres + (size_t)(off0 + (unsigned)((ai * HALF + m * 16) * 128 + bj * 65536)));
#pragma unroll
            for (int ai = 0; ai < 2; ++ai)
#pragma unroll
                for (int m = 0; m < 4; ++m)
#pragma unroll
                    for (int bj = 0; bj < 2; ++bj) { const u32x4 hh = h[ai][m][bj];
                        *(u32x4*)((char*)hres + (size_t)(off0 + (unsigned)((ai * HALF + m * 16) * 128 + bj * 65536))) = pack8(acc[ai][bj][m][0] + bflo(hh.x, hh.y), acc[ai][bj][m][1] + bflo(hh.z, hh.w)); }
        } else {
            const unsigned off0 = ((unsigned)(un.pm * BM + wr * 64 + fr) * 4096u + (unsigned)(un.pn * BM + wc * 32 + 8 * fq)) * 2u;
#pragma unroll
            for (int ai = 0; ai < 2; ++ai)
#pragma unroll
                for (int m = 0; m < 4; ++m)
#pragma unroll
                    for (int bj = 0; bj < 2; ++bj) *(u32x4*)((char*)dl + (size_t)(off0 + (unsigned)((ai * HALF + m * 16) * 8192 + bj * 256))) = pack8(acc[ai][bj][m][0], acc[ai][bj][m][1]);
        }
    }
    __device__ __forceinline__ void tail(int row, int pn, int c, float v0, float v1) const {
        if (add) { const size_t i0 = tix(row, pn * 256 + c, 4096), i1 = tix(row, pn * 256 + 128 + c, 4096); hres[i0] = f2bf_s(bf2f_s(hres[i0]) + v0); hres[i1] = f2bf_s(bf2f_s(hres[i1]) + v1); }
        else { const size_t o = (size_t)row * 4096 + pn * 256 + c; dl[o] = f2bf_s(v0); dl[o + 128] = f2bf_s(v1); }
    }
};
template <int N> __device__ __forceinline__ float dpp_ror(float v) { return __builtin_bit_cast(float, __builtin_amdgcn_mov_dpp(__builtin_bit_cast(int, v), 0x120 + N, 0xf, 0xf, true)); }
struct EpiUpConv {
    static constexpr bool PERM = true, AFTER_DRAIN = false;
    const float* cw; bf16_t* act; float* zedge; PG8_LAS float* xch;
    __device__ __forceinline__ void operator()(f32x4 (&acc)[2][2][4][2], const Unit& un, int wr, int wc, int fr, int fq) const {
        const int cb = wc * 32 + 8 * fq;
        scale_rows(acc, rstd, un.pm * BM + wr * 64 + fr);
        const int lprev = (fq << 4) | ((fr + 15) & 15), lnext = (fq << 4) | ((fr + 1) & 15);
#pragma unroll
        for (int ai = 0; ai < 2; ++ai) { const int b = 2 * ai + wr;
            if (fr == 0) {
#pragma unroll
                for (int bj = 0; bj < 2; ++bj)
#pragma unroll
                    for (int n = 0; n < 2; ++n) *(PG8_LAS f32x4*)(xch + ((b * 2 + 0) * 2 + bj) * 128 + cb + 4 * n) = acc[ai][bj][0][n]; }
            if (fr == 15) {
#pragma unroll
                for (int bj = 0; bj < 2; ++bj)
#pragma unroll
                    for (int n = 0; n < 2; ++n) *(PG8_LAS f32x4*)(xch + ((b * 2 + 1) * 2 + bj) * 128 + cb + 4 * n) = acc[ai][bj][3][n]; } }
        if (wr == 0 && fr < 2) { const unsigned zo = ((unsigned)(un.pm * 4 + fr) * 24576u + (unsigned)(un.pn * 256 + cb)) * 4u;
#pragma unroll
            for (int bj = 0; bj < 2; ++bj)
#pragma unroll
                for (int n = 0; n < 2; ++n) *(f32x4*)((char*)zedge + (size_t)(zo + (unsigned)(bj * 512 + 16 * n))) = acc[0][bj][0][n]; }
        if (wr == 1 && fr >= 14) { const unsigned zo = ((unsigned)(un.pm * 4 + 2 + (fr - 14)) * 24576u + (unsigned)(un.pn * 256 + cb)) * 4u;
#pragma unroll
            for (int bj = 0; bj < 2; ++bj)
#pragma unroll
                for (int n = 0; n < 2; ++n) *(f32x4*)((char*)zedge + (size_t)(zo + (unsigned)(bj * 512 + 16 * n))) = acc[1][bj][3][n]; }
        asm volatile("s_waitcnt lgkmcnt(0)" ::: "memory"); __builtin_amdgcn_s_barrier(); asm volatile("" ::: "memory");
        const int ch0 = un.pn * 128 + cb; const unsigned wo = (unsigned)ch0 * 4u;
        const unsigned ao0 = (((unsigned)un.pm * 192u + (unsigned)(un.pn * 2 + (wc >> 1))) * 16384u + (unsigned)((64 * wr + fr) * 64 + (wc & 1) * 32 + 8 * fq)) * 2u;
#pragma unroll
        for (int ai = 0; ai < 2; ++ai) { const int b = 2 * ai + wr;
            const PG8_LAS float* hpp = xch + (((b > 0 ? b - 1 : 0) * 2 + 1) * 2) * 128 + cb;
            const PG8_LAS float* hnp = xch + (((b < 3 ? b + 1 : 3) * 2 + 0) * 2) * 128 + cb;
            unsigned pkw[4][4];
#pragma unroll
            for (int nj = 0; nj < 4; ++nj) { const int n = nj >> 1, jp = nj & 1;
                float o[4][2];
                f32x2 wg[3], wv[3];
#pragma unroll
                for (int k = 0; k < 3; ++k) { wg[k] = *(const f32x2*)((const char*)(cw + k * 24576) + (size_t)wo + 8 * nj); wv[k] = *(const f32x2*)((const char*)(cw + k * 24576 + 12288) + (size_t)wo + 8 * nj); }
#pragma unroll
                for (int jj = 0; jj < 2; ++jj) { const int j = 2 * jp + jj;
                    float cg[4], cv[4];
#pragma unroll
                    for (int bj = 0; bj < 2; ++bj) {
                        float P[4], Nx[4];
#pragma unroll
                        for (int m = 0; m < 4; ++m) { P[m] = dpp_ror<1>(acc[ai][bj][m][n][j]); Nx[m] = dpp_ror<15>(acc[ai][bj][m][n][j]); }
                        const float hp = (b > 0) ? hpp[bj * 128 + 4 * n + j] : 0.f, hn = (b < 3) ? hnp[bj * 128 + 4 * n + j] : 0.f;
                        const float w0 = bj ? wv[0][jj] : wg[0][jj], w1 = bj ? wv[1][jj] : wg[1][jj], w2 = bj ? wv[2][jj] : wg[2][jj];
#pragma unroll
                        for (int m = 0; m < 4; ++m) {
                            const float up = (fr > 0) ? P[m] : (m > 0 ? P[m > 0 ? m - 1 : 0] : hp);
                            const float dn = (fr < 15) ? Nx[m] : (m < 3 ? Nx[m < 3 ? m + 1 : 3] : hn);
                            const float r = w0 * up + w1 * acc[ai][bj][m][n][j] + w2 * dn;
                            if (bj == 0) cg[m] = r; else cv[m] = r; }
                    }
#pragma unroll
                    for (int m = 0; m < 4; ++m) o[m][jj] = gelu_t(cg[m]) * cv[m];
                    __builtin_amdgcn_sched_barrier(0);
                }
#pragma unroll
                for (int m = 0; m < 4; ++m) pkw[m][nj] = cvt_pk_bf16(o[m][0], o[m][1]);
            }
#pragma unroll
            for (int m = 0; m < 4; ++m) { const int tr = 128 * ai + 64 * wr + 16 * m + fr;
                if (tr != 0 && tr != 255) *(u32x4*)((char*)act + (size_t)(ao0 + (unsigned)((128 * ai + 16 * m) * 128))) = (u32x4){pkw[m][0], pkw[m][1], pkw[m][2], pkw[m][3]}; }
            asm volatile("" ::: "memory");
        }
    }
    float* ztail;
    const float* rstd; const float* colscale;
    __device__ __forceinline__ void tail(int row, int pn, int c, float v0, float v1) const {
        { const float rs = rstd[row]; v0 *= rs; v1 *= rs; }
        if (colscale) { v0 *= colscale[pn * 256 + c]; v1 *= colscale[pn * 256 + 128 + c]; }
        float* z = ztail + (size_t)(row - 16384) * 24576 + pn * 256 + c; z[0] = v0; z[128] = v1;
    }
};

struct EpiUp8 {
    static constexpr bool PERM = true, AFTER_DRAIN = false;
    EpiUpConv e;
    __device__ __forceinline__ void operator()(f32x4 (&acc)[2][2][4][2], const Unit& un, int wr, int wc, int fr_, int fq_) const {
        int fr = fr_, fq = fq_; asm volatile("" : "+v"(fr), "+v"(fq));
        const int cb = wc * 32 + 8 * fq;
#pragma unroll
        for (int bj = 0; bj < 2; ++bj)
#pragma unroll
            for (int n = 0; n < 2; ++n) { const f32x4 cs = *(const f32x4*)(e.colscale + un.pn * 256 + bj * HALF + cb + 4 * n);
#pragma unroll
                for (int ai = 0; ai < 2; ++ai)
#pragma unroll
                    for (int m = 0; m < 4; ++m) { const i32x4 iv = __builtin_bit_cast(i32x4, acc[ai][bj][m][n]); acc[ai][bj][m][n] = (f32x4){(float)iv[0], (float)iv[1], (float)iv[2], (float)iv[3]} * cs; } }
        e(acc, un, wr, wc, fr, fq);
    }
    __device__ __forceinline__ void tail(int row, int pn, int c, float v0, float v1) const { e.tail(row, pn, c, v0, v1); }
};

template <class Epi, bool TB = false, bool I8 = false>
__device__ __forceinline__ void tail_gemm(PG8_LAS unsigned char* lds, const bf16_t* A  , const bf16_t* Bt, int N, int K, int row0, const Epi& E) {
    int tid_ = threadIdx.x; asm volatile("" : "+v"(tid_));
    const int tid = tid_, wid = __builtin_amdgcn_readfirstlane(tid >> 6), lane = tid & 63, r16 = lane & 15, q = lane >> 4;
    const int nitems = (N >> 8) * 8, kw = K >> 3, nks = kw >> 5;
    PG8_LAS f32x4* red = (PG8_LAS f32x4*)lds;
    for (int item = blockIdx.x; item < nitems; item += gridDim.x) {
        const int pn = item >> 3, s8 = item & 7;
        const bf16_t* ap = A + tix(row0 + r16, wid * kw, K) + 8 * q;
        const bf16_t* b0 = TB ? Bt + ((size_t)pn * (K >> 6) + ((wid * kw) >> 6)) * 16384 + (s8 * 16 + r16) * 64 + 8 * q : Bt + (size_t)(pn * 256 + s8 * 16 + r16) * K + wid * kw + 8 * q;
        const bf16_t* b1 = b0 + (TB ? (size_t)128 * 64 : (size_t)128 * K);
        f32x4 c0 = (f32x4){0.f, 0.f, 0.f, 0.f}, c1 = (f32x4){0.f, 0.f, 0.f, 0.f};
        int ks = 0;
        for (; ks + 8 <= nks; ks += 8) {
            bf16x8 a[8], x0[8], x1[8];
#pragma unroll
            for (int i = 0; i < 8; ++i) { a[i] = *(const bf16x8*)(ap + ((ks + i) >> 1) * 16384 + ((ks + i) & 1) * 32); const int ko = TB ? ((ks + i) >> 1) * 16384 + ((ks + i) & 1) * 32 : (ks + i) * 32; x0[i] = *(const bf16x8*)(b0 + ko); x1[i] = *(const bf16x8*)(b1 + ko); }
#pragma unroll
            for (int i = 0; i < 8; ++i) { if constexpr (I8) { c0 = __builtin_bit_cast(f32x4, __builtin_amdgcn_mfma_i32_16x16x64_i8(__builtin_bit_cast(i32x4, a[i]), __builtin_bit_cast(i32x4, x0[i]), __builtin_bit_cast(i32x4, c0), 0, 0, 0)); c1 = __builtin_bit_cast(f32x4, __builtin_amdgcn_mfma_i32_16x16x64_i8(__builtin_bit_cast(i32x4, a[i]), __builtin_bit_cast(i32x4, x1[i]), __builtin_bit_cast(i32x4, c1), 0, 0, 0)); } else { c0 = __builtin_amdgcn_mfma_f32_16x16x32_bf16(a[i], x0[i], c0, 0, 0, 0); c1 = __builtin_amdgcn_mfma_f32_16x16x32_bf16(a[i], x1[i], c1, 0, 0, 0); } }
        }
        for (; ks < nks; ks += 4) {
            bf16x8 a[4], x0[4], x1[4];
#pragma unroll
            for (int i = 0; i < 4; ++i) { a[i] = *(const bf16x8*)(ap + ((ks + i) >> 1) * 16384 + ((ks + i) & 1) * 32); const int ko = TB ? ((ks + i) >> 1) * 16384 + ((ks + i) & 1) * 32 : (ks + i) * 32; x0[i] = *(const bf16x8*)(b0 + ko); x1[i] = *(const bf16x8*)(b1 + ko); }
#pragma unroll
            for (int i = 0; i < 4; ++i) { if constexpr (I8) { c0 = __builtin_bit_cast(f32x4, __builtin_amdgcn_mfma_i32_16x16x64_i8(__builtin_bit_cast(i32x4, a[i]), __builtin_bit_cast(i32x4, x0[i]), __builtin_bit_cast(i32x4, c0), 0, 0, 0)); c1 = __builtin_bit_cast(f32x4, __builtin_amdgcn_mfma_i32_16x16x64_i8(__builtin_bit_cast(i32x4, a[i]), __builtin_bit_cast(i32x4, x1[i]), __builtin_bit_cast(i32x4, c1), 0, 0, 0)); } else { c0 = __builtin_amdgcn_mfma_f32_16x16x32_bf16(a[i], x0[i], c0, 0, 0, 0); c1 = __builtin_amdgcn_mfma_f32_16x16x32_bf16(a[i], x1[i], c1, 0, 0, 0); } }
        }
        if constexpr (I8) { const i32x4 i0 = __builtin_bit_cast(i32x4, c0), i1 = __builtin_bit_cast(i32x4, c1); c0 = (f32x4){(float)i0[0], (float)i0[1], (float)i0[2], (float)i0[3]}; c1 = (f32x4){(float)i1[0], (float)i1[1], (float)i1[2], (float)i1[3]}; }
        red[(wid * 2 + 0) * 64 + lane] = c0; red[(wid * 2 + 1) * 64 + lane] = c1;
        asm volatile("s_waitcnt lgkmcnt(0)" ::: "memory"); __builtin_amdgcn_s_barrier(); asm volatile("" ::: "memory");
        if (tid < 256) {
            const int row = tid >> 4, col = tid & 15, sl = col + 16 * (row >> 2), el = row & 3; float v0 = 0.f, v1 = 0.f;
#pragma unroll
            for (int w = 0; w < 8; ++w) { v0 += ((const PG8_LAS float*)(red + (w * 2 + 0) * 64 + sl))[el]; v1 += ((const PG8_LAS float*)(red + (w * 2 + 1) * 64 + sl))[el]; }
            E.tail(row0 + row, pn, s8 * 16 + col, v0, v1);
        }
        asm volatile("s_waitcnt lgkmcnt(0)" ::: "memory"); __builtin_amdgcn_s_barrier(); asm volatile("" ::: "memory");
    }
}
template <class Epi, class Sched, bool ALIGN_EPI = false, bool SP2 = false, bool TA = false, bool TB = false, bool I8 = false>
__device__ __forceinline__ void gemm_phase(PG8_LAS unsigned char* lds, const Gemm g, const Sched& S, const Epi& E) {
    int tid_ = threadIdx.x; asm volatile("" : "+v"(tid_));
    const int tid = tid_, wid = __builtin_amdgcn_readfirstlane(tid >> 6), lane = tid & 63, wr = wid >> 2, wc = wid & 3, fr = lane & 15, fq = lane >> 4;
    const int K = g.K, nt = K / BK;
    unsigned voffA[2], voffB[2];
#pragma unroll
    for (int i = 0; i < 2; ++i) { int R, C; stage_rc(tid * 16 + i * 8192, R, C); const int Rb = Epi::PERM ? ((R & ~31) + perm32(R & 31)) : R;
        voffA[i] = (unsigned)(R * (TA ? 64 : K) + C) * 2u; voffB[i] = (unsigned)(Rb * (TB ? 64 : K) + C) * 2u; }
    const size_t kstepA = TA ? (size_t)(BM * BK * 2) : (size_t)(BK * 2), kstepB = TB ? (size_t)(BM * BK * 2) : (size_t)(BK * 2);
    const size_t hstepA = TA ? (size_t)(HALF * BK * 2) : (size_t)HALF * K * 2, hstepB = TB ? (size_t)(HALF * BK * 2) : (size_t)HALF * K * 2;
    const size_t tstep = (size_t)BM * K * 2;
    const unsigned ldsw = (unsigned)wid * 1024u;
    const int aoff = lds_byte(wr * 64 + fr, fq * 8), boff = lds_byte(wc * 32 + fr, fq * 8);
#define PG8_SA(b, h) (((b) * 2 + (h)) * HTB)
#define PG8_SB(b, h) ((4 + (b) * 2 + (h)) * HTB)
#define PG8_STAGE(bufoff, gbase, voff) do { _Pragma("unroll") for (int _i = 0; _i < 2; ++_i) \
        __builtin_amdgcn_global_load_lds((const unsigned*)((const char*)(gbase) + (voff)[_i]), (PG8_LAS unsigned*)(lds + (bufoff) + ldsw + _i * 8192), 16, 0, 0); } while (0)
#define PG8_LDA(dst, b, h) do { _Pragma("unroll") for (int m = 0; m < 4; ++m) _Pragma("unroll") for (int k = 0; k < 2; ++k) dst[m][k] = *(const PG8_LAS bf16x8*)(lds + PG8_SA(b, h) + aoff + m * 2048 + k * 1024); } while (0)
#define PG8_LDB(dst, b, h) do { _Pragma("unroll") for (int n = 0; n < 2; ++n) _Pragma("unroll") for (int k = 0; k < 2; ++k) dst[n][k] = *(const PG8_LAS bf16x8*)(lds + PG8_SB(b, h) + boff + n * 2048 + k * 1024); } while (0)
#define PG8_MMA(ai, bj, At, Bt) do { __builtin_amdgcn_s_setprio(1); _Pragma("unroll") for (int m = 0; m < 4; ++m) _Pragma("unroll") for (int n = 0; n < 2; ++n) _Pragma("unroll") for (int k = 0; k < 2; ++k) \
        { if constexpr (I8) acc[ai][bj][m][n] = __builtin_bit_cast(f32x4, __builtin_amdgcn_mfma_i32_16x16x64_i8(__builtin_bit_cast(i32x4, Bt[n][k]), __builtin_bit_cast(i32x4, At[m][k]), __builtin_bit_cast(i32x4, acc[ai][bj][m][n]), 0, 0, 0)); \
          else acc[ai][bj][m][n] = __builtin_amdgcn_mfma_f32_16x16x32_bf16(Bt[n][k], At[m][k], acc[ai][bj][m][n], 0, 0, 0); } __builtin_amdgcn_s_setprio(0); } while (0)
#define PG8_WAIT_V(n) asm volatile("s_waitcnt vmcnt(" #n ")" ::: "memory")
#define PG8_WAIT_L(n) asm volatile("s_waitcnt lgkmcnt(" #n ")" ::: "memory")
#define PG8_BAR __builtin_amdgcn_s_barrier()
#define PG8_SCHED __builtin_amdgcn_sched_barrier(0)
    Unit cur, nxt; int ui = 0;
    if (!S.next(0, cur)) return;
    f32x4 acc[2][2][4][2];
#pragma unroll
    for (int a = 0; a < 2; ++a)
#pragma unroll
        for (int b = 0; b < 2; ++b)
#pragma unroll
            for (int m = 0; m < 4; ++m)
#pragma unroll
                for (int n = 0; n < 2; ++n) acc[a][b][m][n] = (f32x4){0.f, 0.f, 0.f, 0.f};
    bf16x8 At[4][2], B0[2][2], B1[2][2];
    const char* cA = (const char*)g.A + (size_t)cur.pm * tstep; const char* cB = (const char*)g.Bt + (size_t)cur.pn * tstep;
    S.a_ready(cur);
    if constexpr (SP2) {
        PG8_STAGE(PG8_SB(0, 0), cB, voffB); PG8_STAGE(PG8_SB(0, 1), cB + hstepB, voffB); PG8_STAGE(PG8_SA(0, 0), cA, voffA); PG8_STAGE(PG8_SA(0, 1), cA + hstepA, voffA);
        if (wr == 1) PG8_BAR;
        PG8_WAIT_V(2); PG8_BAR;
        PG8_STAGE(PG8_SB(1, 0), cB + kstepB, voffB); PG8_STAGE(PG8_SA(1, 0), cA + kstepA, voffA); PG8_STAGE(PG8_SB(1, 1), cB + hstepB + kstepB, voffB);
        PG8_WAIT_V(6); PG8_BAR;
    } else {
        PG8_STAGE(PG8_SB(0, 0), cB, voffB); PG8_STAGE(PG8_SA(0, 0), cA, voffA); PG8_STAGE(PG8_SB(0, 1), cB + hstepB, voffB); PG8_STAGE(PG8_SA(0, 1), cA + hstepA, voffA);
        if (wr == 1) PG8_BAR;
        PG8_WAIT_V(4); PG8_BAR;
        PG8_STAGE(PG8_SB(1, 0), cB + kstepB, voffB); PG8_STAGE(PG8_SA(1, 0), cA + kstepA, voffA); PG8_STAGE(PG8_SB(1, 1), cB + hstepB + kstepB, voffB);
        PG8_WAIT_V(6); PG8_BAR;
    }
    for (;;) {
        const bool has_next = S.next(ui + 1, nxt);
        const char* nA = has_next ? (const char*)g.A + (size_t)nxt.pm * tstep : cA; const char* nB = has_next ? (const char*)g.Bt + (size_t)nxt.pn * tstep : cB;
        for (int t = 0; t < nt; t += 2) {
            const bool last = (t == nt - 2);
            const char* a1 = cA + (size_t)(t + 1) * kstepA;
            const char* a2 = last ? nA : cA + (size_t)(t + 2) * kstepA; const char* b2 = last ? nB : cB + (size_t)(t + 2) * kstepB;
            const char* a3 = a2 + kstepA; const char* b3 = b2 + kstepB;
            if (last && has_next) S.a_ready(nxt);
            if constexpr (SP2) {
            PG8_LDB(B0, 0, 0); PG8_LDB(B1, 0, 1); PG8_SCHED; PG8_LDA(At, 0, 0); PG8_STAGE(PG8_SA(1, 1), a1 + hstepA, voffA);
            PG8_WAIT_V(8); PG8_WAIT_L(0); PG8_BAR; PG8_MMA(0, 0, At, B0); PG8_MMA(0, 1, At, B1); PG8_BAR; PG8_SCHED;
            PG8_LDA(At, 0, 1); PG8_STAGE(PG8_SB(0, 0), b2, voffB); PG8_STAGE(PG8_SB(0, 1), b2 + hstepB, voffB); PG8_STAGE(PG8_SA(0, 0), a2, voffA);
            PG8_WAIT_V(8); PG8_WAIT_L(0); PG8_BAR; PG8_MMA(1, 0, At, B0); PG8_MMA(1, 1, At, B1); PG8_BAR; PG8_SCHED;
            PG8_LDB(B0, 1, 0); PG8_LDB(B1, 1, 1); PG8_SCHED; PG8_LDA(At, 1, 0); PG8_STAGE(PG8_SA(0, 1), a2 + hstepA, voffA);
            PG8_WAIT_V(8); PG8_WAIT_L(0); PG8_BAR; PG8_MMA(0, 0, At, B0); PG8_MMA(0, 1, At, B1); PG8_BAR; PG8_SCHED;
            PG8_LDA(At, 1, 1); PG8_STAGE(PG8_SB(1, 0), b3, voffB); PG8_STAGE(PG8_SB(1, 1), b3 + hstepB, voffB); PG8_STAGE(PG8_SA(1, 0), a3, voffA);
            PG8_WAIT_V(8); PG8_WAIT_L(0); PG8_BAR; PG8_MMA(1, 0, At, B0); PG8_MMA(1, 1, At, B1); PG8_BAR; PG8_SCHED;
            } else {
            PG8_LDB(B0, 0, 0); PG8_SCHED; PG8_LDA(At, 0, 0); PG8_STAGE(PG8_SA(1, 1), a1 + hstepA, voffA);
            PG8_WAIT_L(8); PG8_BAR; PG8_WAIT_L(0); PG8_MMA(0, 0, At, B0); PG8_BAR; PG8_SCHED;
            PG8_LDB(B1, 0, 1); PG8_STAGE(PG8_SB(0, 0), b2, voffB);
            PG8_BAR; PG8_WAIT_L(0); PG8_MMA(0, 1, At, B1); PG8_BAR;
            PG8_LDA(At, 0, 1); PG8_STAGE(PG8_SA(0, 0), a2, voffA);
            PG8_BAR; PG8_WAIT_L(0); PG8_MMA(1, 0, At, B0); PG8_BAR; PG8_SCHED;
            PG8_STAGE(PG8_SB(0, 1), b2 + hstepB, voffB);
            PG8_WAIT_V(6); PG8_BAR; PG8_MMA(1, 1, At, B1); PG8_BAR;
            PG8_LDB(B0, 1, 0); PG8_SCHED; PG8_LDA(At, 1, 0); PG8_STAGE(PG8_SA(0, 1), a2 + hstepA, voffA);
            PG8_WAIT_L(8); PG8_BAR; PG8_WAIT_L(0); PG8_MMA(0, 0, At, B0); PG8_BAR; PG8_SCHED;
            PG8_LDB(B1, 1, 1); PG8_STAGE(PG8_SB(1, 0), b3, voffB);
            PG8_BAR; PG8_WAIT_L(0); PG8_MMA(0, 1, At, B1); PG8_BAR;
            PG8_LDA(At, 1, 1); PG8_STAGE(PG8_SA(1, 0), a3, voffA);
            PG8_BAR; PG8_WAIT_L(0); PG8_MMA(1, 0, At, B0); PG8_BAR; PG8_SCHED;
            PG8_STAGE(PG8_SB(1, 1), b3 + hstepB, voffB);
            PG8_WAIT_V(6); PG8_BAR; PG8_MMA(1, 1, At, B1); PG8_BAR;
            }
        }
        if constexpr (ALIGN_EPI) { if (wr == 0) PG8_BAR; }
        if constexpr (I8) asm volatile("s_nop 15\n\ts_nop 15\n\ts_nop 15\n\ts_nop 15" ::: "memory");
        if constexpr (!Epi::AFTER_DRAIN) { E(acc, cur, wr, wc, fr, fq); S.done(cur); }
        if (!has_next) break;
#pragma unroll
        for (int a = 0; a < 2; ++a)
#pragma unroll
            for (int b = 0; b < 2; ++b)
#pragma unroll
                for (int m = 0; m < 4; ++m)
#pragma unroll
                    for (int n = 0; n < 2; ++n) acc[a][b][m][n] = (f32x4){0.f, 0.f, 0.f, 0.f};
        cur = nxt; cA = nA; cB = nB; ++ui;
        if constexpr (ALIGN_EPI) { if (wr == 1) PG8_BAR; }
    }
    PG8_WAIT_V(0);
    if constexpr (!ALIGN_EPI) { if (wr == 0) PG8_BAR; }
    PG8_BAR;
    if constexpr (Epi::AFTER_DRAIN) { E.fused(acc, cur, wr, wc, fr, fq, lds, wid, lane); S.done(cur); }
#undef PG8_SA
#undef PG8_SB
#undef PG8_STAGE
#undef PG8_LDA
#undef PG8_LDB
#undef PG8_MMA
#undef PG8_WAIT_V
#undef PG8_WAIT_L
#undef PG8_BAR
#undef PG8_SCHED
}
}

#ifndef MK_N_LAUNCHES
#define MK_N_LAUNCHES 1
#endif
constexpr int NWAVES = 8;
constexpr int DM = 4096, SEQ = 16384, NMETA = 16, LTOK = SEQ + NMETA, MP = 16640, MG = 16384;
constexpr int DC = 2048, DSS = 1024, NG = 64, DFF = 12288, NIN = 15360;
constexpr float EPS = 1e-6f;
#ifndef MK_WTILED
#define MK_WTILED 1
#endif
constexpr bool WTILED = MK_WTILED;
constexpr int NPH = 24;
constexpr int NSEG = 16, SEGLEN = 1056, CHT = 32, NCH = SEGLEN / CHT, XROW = 528, XBUF = CHT * XROW;

constexpr size_t MiB = 1u << 20;
constexpr size_t WS_CTL = 0, CTL_ZERO_BYTES = 1 * MiB;
constexpr size_t WS_RSTD = 6 * MiB;
constexpr size_t WS_RS8 = WS_RSTD + 128 * 1024;
constexpr size_t WS_CS8 = WS_RSTD + 256 * 1024;
constexpr size_t WS_ABAR = 1 * MiB;
constexpr size_t WS_ASEG = WS_ABAR + 256 * 1024;
constexpr size_t WS_BBT = 2 * MiB;
constexpr size_t WS_CCT = 3 * MiB;
constexpr size_t WS_E = 4 * MiB;
constexpr size_t WS_W = 8 * MiB;
constexpr size_t W_IN = 0, W_A = 120 * MiB, W_GLU = 136 * MiB, W_OUT = 152 * MiB, W_UP = 184 * MiB, W_DOWN = 376 * MiB, W_LAYER = 472 * MiB;
constexpr size_t WS_HRES = WS_W + 2 * W_LAYER;
constexpr size_t WS_HB8 = WS_HRES;
constexpr size_t WS_WG8 = WS_HRES + 128 * MiB;
constexpr size_t WS_H = WS_HRES + 260 * MiB;
constexpr size_t WS_R = WS_H + 130 * MiB;
constexpr size_t R_BG = 0, R_CV = 65 * MiB, R_U = 130 * MiB, R_GA = 130 * MiB + 32 * MiB + MiB / 2, R_GB = R_GA + 130 * MiB, R_AIN = R_GB + 130 * MiB, R_S = R_AIN + 65 * MiB,
                 R_M = R_S + 32 * MiB + MiB / 2, R_YF = R_M + 130 * MiB, R_YB = R_YF + 65 * MiB, R_END = R_YB + 65 * MiB;
static_assert(R_END == 780 * MiB, "overlay map");
constexpr size_t WS_ACT = WS_R + 780 * MiB;
constexpr size_t WS_DLT = WS_ACT + 390 * MiB;
constexpr size_t WS_END = WS_DLT + 260 * MiB;
static_assert((size_t)MP * 24576 * 2 == 780 * MiB && (size_t)MP * 4096 * 4 == 260 * MiB && (size_t)MP * 12288 * 2 == 390 * MiB, "sizes");

constexpr int LDS_BYTES = 147456, LDSCTL_OFF = 146944;
static_assert(NWAVES * XBUF <= LDSCTL_OFF && NWAVES * 16640 <= LDSCTL_OFF && 131072 + 8192 <= LDSCTL_OFF, "LDS map");

#define GAS __attribute__((address_space(1)))
#define LAS __attribute__((address_space(3)))
typedef unsigned short bf16;
typedef unsigned v4u __attribute__((ext_vector_type(4)));
typedef unsigned v2u __attribute__((ext_vector_type(2)));
typedef float f32x4 __attribute__((ext_vector_type(4)));
typedef float f32x2 __attribute__((ext_vector_type(2)));
typedef float f32x16 __attribute__((ext_vector_type(16)));
typedef short bf16x8 __attribute__((ext_vector_type(8)));
#define LDS_WAIT() asm volatile("s_waitcnt lgkmcnt(0)" ::: "memory")
#define VM_WAIT() asm volatile("s_waitcnt vmcnt(0)" ::: "memory")
__device__ __forceinline__ unsigned pk2(float lo, float hi) { return pg8::cvt_pk_bf16(lo, hi); }
__device__ __forceinline__ float bf_lo(unsigned w) { return __uint_as_float(w << 16); }
__device__ __forceinline__ float bf_hi(unsigned w) { return __uint_as_float(w & 0xffff0000u); }
__device__ __forceinline__ void unpack8(v4u w, float (&f)[8]) { f[0] = bf_lo(w.x); f[1] = bf_hi(w.x); f[2] = bf_lo(w.y); f[3] = bf_hi(w.y); f[4] = bf_lo(w.z); f[5] = bf_hi(w.z); f[6] = bf_lo(w.w); f[7] = bf_hi(w.w); }
__device__ __forceinline__ unsigned short f2bf1(float f) { unsigned u = __float_as_uint(f); return (unsigned short)((u + 0x7fffu + ((u >> 16) & 1u)) >> 16); }
__device__ __forceinline__ float fma_s(float a, float b, float c) { float r; asm("v_fma_f32 %0, %1, %2, %3" : "=v"(r) : "v"(a), "v"(b), "v"(c)); return r; }
__device__ __forceinline__ float wave_sum(float v) {
#pragma unroll
    for (int o = 1; o < 64; o <<= 1) v += __shfl_xor(v, o);
    return v;
}

#define XB_TMO      128
#define XB_XCNT(j)  (256  + 64 * (j))
#define XB_XSUB(j)  (1280 + 64 * (j))
#define XB_XGEN(j)  (2304 + 64 * (j))
#define XB_TOP      3328
#define XB_TOPGEN   3392
#define XCD_BAR_WORDS 3456
#define XB_SPIN_CAP (1u << 18)

__device__ __forceinline__ unsigned xb_ld(unsigned* p)              { return __hip_atomic_load(p, __ATOMIC_RELAXED, __HIP_MEMORY_SCOPE_AGENT); }
__device__ __forceinline__ unsigned xb_add(unsigned* p, unsigned v) { return __hip_atomic_fetch_add(p, v, __ATOMIC_RELAXED, __HIP_MEMORY_SCOPE_AGENT); }
__device__ __forceinline__ unsigned xb_xcc_id() { return (unsigned)__builtin_amdgcn_s_getreg((3 << 11) | 20) & 0xFu; }
#define XB_SPIN(cond, bar) do { unsigned _sp = 0; while (cond) { __builtin_amdgcn_s_sleep(1); \
    if ((++_sp & 255u) == 0u) { if (xb_ld(&(bar)[XB_TMO])) break; if (_sp > XB_SPIN_CAP) { atomicAdd(&(bar)[XB_TMO], 1u); break; } } } } while (0)

struct XcdBarrier {
    unsigned* bar; unsigned x;
    volatile LAS unsigned* st;
};

__device__ __forceinline__ XcdBarrier xcd_barrier_post(unsigned* bar, volatile LAS unsigned* st) {
    XcdBarrier b; b.bar = bar; b.x = xb_xcc_id(); b.st = st;
    if (threadIdx.x == 0) (void)xb_add(&bar[XB_XCNT(b.x)], 1u);
    return b;
}
__device__ __forceinline__ void xcd_barrier_complete(unsigned* bar, unsigned x, unsigned& nloc, unsigned& nx) {
    const unsigned G = gridDim.x * gridDim.y * gridDim.z;
    unsigned sum, cnt, mine, sp = 0u;
    for (;;) {
        sum = 0u; cnt = 0u; mine = 0u;
#pragma unroll
        for (unsigned j = 0; j < 16; ++j) { const unsigned c = xb_ld(&bar[XB_XCNT(j)]); sum += c; cnt += (c > 0u) ? 1u : 0u; mine = (j == x) ? c : mine; }
        if (sum == G) break;
        __builtin_amdgcn_s_sleep(1);
        if ((++sp & 255u) == 0u) { if (xb_ld(&bar[XB_TMO])) break; if (sp > XB_SPIN_CAP) { atomicAdd(&bar[XB_TMO], 1u); break; } }
    }
    nloc = mine > 0u ? mine : 1u; nx = cnt > 0u ? cnt : 1u;
}

__device__ __forceinline__ void xcd_barrier(const XcdBarrier& b) {
    asm volatile("s_waitcnt vmcnt(0)" ::: "memory");
    __syncthreads();
    if (threadIdx.x == 0) {
        unsigned* bar = b.bar;
        __builtin_amdgcn_s_waitcnt(0);
        unsigned nloc = b.st[0], nx = b.st[1];
        if (nloc == 0u) { xcd_barrier_complete(bar, b.x, nloc, nx); b.st[0] = nloc; b.st[1] = nx; }
        const unsigned old = xb_add(&bar[XB_XSUB(b.x)], 1u);
        const unsigned gen = old / nloc;
        if (old + 1u == (gen + 1u) * nloc) {
            __builtin_amdgcn_fence(__ATOMIC_RELEASE, "agent");
            asm volatile("s_waitcnt vmcnt(0)" ::: "memory");
            const unsigned og = xb_add(&bar[XB_TOP], 1u);
            const unsigned tg = og / nx;
            if (og + 1u == (tg + 1u) * nx) xb_add(&bar[XB_TOPGEN], 1u);
            else XB_SPIN(xb_ld(&bar[XB_TOPGEN]) == tg, bar);
            __builtin_amdgcn_fence(__ATOMIC_ACQUIRE, "agent");
            xb_add(&bar[XB_XGEN(b.x)], 1u);
            asm volatile("s_waitcnt vmcnt(0)" ::: "memory");
        } else {
            XB_SPIN(xb_ld(&bar[XB_XGEN(b.x)]) == gen, bar);
            __builtin_amdgcn_fence(__ATOMIC_ACQUIRE, "agent");
            asm volatile("s_waitcnt vmcnt(0)" ::: "memory");
        }
    }
    __syncthreads();
}


__device__ __forceinline__ int dest_row(int mode, int N, int n) {
    if (mode == 1) {
        if (n < 2048 || n >= 6144) return n;
        if (n < 4096) { const int c = n - 2048; return 2048 + (c >> 7) * 256 + (c & 127); }
        const int c = n - 4096; return 2048 + (c >> 7) * 256 + 128 + (c & 127);
    }
    if (mode == 2) {
        const int h = N >> 1; if (n < h) return (n >> 7) * 256 + (n & 127);
        const int c = n - h; return (c >> 7) * 256 + 128 + (c & 127);
    }
    return n;
}
__device__ __forceinline__ void convert_matrix(const float* W, const float* kgain  , int K, int N, bf16* WT, int mode, LAS float* scr, int gw, int ngw, int lane, int ncols = 0  ) {
    const int nblk = (ncols ? ncols : N) >> 6, nitems = (K >> 6) * nblk;
    for (int it = gw; it < nitems; it += ngw) {
        const int kb = it / nblk, nb = it - kb * nblk, k0 = kb << 6, n0 = nb << 6;
        const int nn = 4 * (lane & 15), kq = lane >> 4;
        f32x4 v[16];
#pragma unroll
        for (int i = 0; i < 16; ++i) { v[i] = *(const GAS f32x4*)(W + (size_t)(k0 + 4 * i + kq) * N + n0 + nn); if (kgain) v[i] = v[i] * kgain[k0 + 4 * i + kq]; }
        if (mode == 2 && n0 >= (N >> 1)) {
#pragma unroll
            for (int i = 0; i < 16; ++i) v[i] = v[i] * -1.44269504089f; }
#pragma unroll
        for (int i = 0; i < 16; ++i) { const int kk = 4 * i + kq;
            scr[(nn + 0) * 65 + kk] = v[i].x; scr[(nn + 1) * 65 + kk] = v[i].y; scr[(nn + 2) * 65 + kk] = v[i].z; scr[(nn + 3) * 65 + kk] = v[i].w; }
        LDS_WAIT();
        const int drow = dest_row(mode, N, n0); const int c = lane & 7;
#pragma unroll
        for (int jr = 0; jr < 8; ++jr) { const int n = 8 * jr + (lane >> 3); const LAS float* s = scr + n * 65 + 8 * c;
            v4u o; o.x = pk2(s[0], s[1]); o.y = pk2(s[2], s[3]); o.z = pk2(s[4], s[5]); o.w = pk2(s[6], s[7]);
            if (WTILED) *(GAS v4u*)(WT + ((size_t)((drow + n) >> 8) * (K >> 6) + kb) * 16384 + ((drow + n) & 255) * 64 + 8 * c) = o;
            else *(GAS v4u*)(WT + (size_t)(drow + n) * K + k0 + 8 * c) = o; }
        LDS_WAIT();
    }
}
__device__ __forceinline__ void sincos_d(double x, double& s, double& c) {
    const double k = rint(x * 0.15915494309189535); double r = fma(-k, 6.283185307179586, x); r = fma(-k, 2.4492935982947064e-16, r);
    const double r2 = r * r; double ss = 1.0, cc = 1.0;
#pragma unroll
    for (int n = 17; n >= 1; --n) { ss = 1.0 - ss * r2 / (double)((2 * n) * (2 * n + 1)); cc = 1.0 - cc * r2 / (double)((2 * n - 1) * (2 * n)); }
    s = r * ss; c = cc;
}
__device__ __forceinline__ void scan_params(int idx, const float* lre_, const float* lim_, const float* lst_, const float* bre_, const float* bim_, const float* cre_, const float* cim_,
                                            f32x2* abar, f32x2* aseg, bf16* BBt, bf16* CCt) {
    const int p = idx & 63, ldg = idx >> 6;
    const double lre = (double)lre_[idx], lim = (double)lim_[idx], dt = exp((double)lst_[ldg]);
    const double mag = exp(lre * dt), ang = lim * dt; double sn, cs; sincos_d(ang, sn, cs);
    const double ar = mag * cs, ai = mag * sn, nr = ar - 1.0, ni = ai, den = lre * lre + lim * lim;
    const double fre = (nr * lre + ni * lim) / den, fim = (ni * lre - nr * lim) / den;
    abar[idx] = (f32x2){(float)ar, (float)ai};
    { const double magn = exp(lre * dt * (double)SEGLEN); double s2, c2; sincos_d(ang * (double)SEGLEN, s2, c2); aseg[idx] = (f32x2){(float)(magn * c2), (float)(magn * s2)}; }
    for (int h = 0; h < 16; ++h) {
        const double br = (double)bre_[(size_t)idx * 16 + h], bi = (double)bim_[(size_t)idx * 16 + h];
        BBt[((size_t)ldg * 128 + p) * 16 + h] = f2bf1((float)(fre * br - fim * bi));
        BBt[((size_t)ldg * 128 + 64 + p) * 16 + h] = f2bf1((float)(fre * bi + fim * br));
        const float cr = cre_[((size_t)ldg * 16 + h) * 64 + p], ci = cim_[((size_t)ldg * 16 + h) * 64 + p];
        CCt[((size_t)ldg * 16 + h) * 128 + 2 * p] = f2bf1(cr);
        CCt[((size_t)ldg * 16 + h) * 128 + 2 * p + 1] = f2bf1(-ci);
    }
}
__device__ __forceinline__ float quant_row8(const f32x4 (&v)[16], signed char* q8, int r, int lane) {
    float mx = 0.f;
#pragma unroll
    for (int j = 0; j < 16; ++j) mx = fmaxf(fmaxf(mx, fmaxf(fabsf(v[j].x), fabsf(v[j].y))), fmaxf(fabsf(v[j].z), fabsf(v[j].w)));
#pragma unroll
    for (int o = 1; o < 64; o <<= 1) mx = fmaxf(mx, __shfl_xor(mx, o));
    mx = fmaxf(mx, 1e-20f); const float sc = 127.0f / mx;
    signed char* rowp = q8 + ((size_t)(r >> 8) * 32 + (lane >> 5)) * 32768 + (size_t)((r & 255) * 128 + 4 * (lane & 31));
#pragma unroll
    for (int j = 0; j < 16; ++j) { const int a = (int)rintf(v[j].x * sc), b = (int)rintf(v[j].y * sc), c = (int)rintf(v[j].z * sc), d = (int)rintf(v[j].w * sc);
        *(GAS unsigned*)(rowp + (size_t)j * 65536) = (unsigned)(a & 255) | ((unsigned)(b & 255) << 8) | ((unsigned)(c & 255) << 16) | ((unsigned)d << 24); }
    return mx * (1.0f / 127.0f);
}
__device__ __forceinline__ float quant_row8w(const float (&v)[8][8], signed char* q8, int r, int lane) {
    float mx = 0.f;
#pragma unroll
    for (int j = 0; j < 8; ++j)
#pragma unroll
        for (int e = 0; e < 8; ++e) mx = fmaxf(mx, fabsf(v[j][e]));
#pragma unroll
    for (int o = 1; o < 64; o <<= 1) mx = fmaxf(mx, __shfl_xor(mx, o));
    mx = fmaxf(mx, 1e-20f); const float sc = 127.0f / mx;
    signed char* rowp = q8 + ((size_t)(r >> 8) * 32 + (lane >> 4)) * 32768 + (size_t)((r & 255) * 128 + 8 * (lane & 15));
#pragma unroll
    for (int j = 0; j < 8; ++j) { v2u w;
        { const int a = (int)rintf(v[j][0] * sc), b = (int)rintf(v[j][1] * sc), c = (int)rintf(v[j][2] * sc), d = (int)rintf(v[j][3] * sc); w.x = (unsigned)(a & 255) | ((unsigned)(b & 255) << 8) | ((unsigned)(c & 255) << 16) | ((unsigned)d << 24); }
        { const int a = (int)rintf(v[j][4] * sc), b = (int)rintf(v[j][5] * sc), c = (int)rintf(v[j][6] * sc), d = (int)rintf(v[j][7] * sc); w.y = (unsigned)(a & 255) | ((unsigned)(b & 255) << 8) | ((unsigned)(c & 255) << 16) | ((unsigned)d << 24); }
        *(GAS v2u*)(rowp + (size_t)j * 4 * 32768) = w; }
    return mx * (1.0f / 127.0f);
}
__device__ __forceinline__ void weights_i8(LAS unsigned char* lds, const float* Win  , int ldw, const float* kgain, signed char* W8, float* cscale, int n0  , int d0  , int wave, int lane, int tid, float csmul = 1.0f  ) {
    LAS float* cmx = (LAS float*)lds;
    const int cq = lane & 7, kq = lane >> 3;
    const float* src = Win + (size_t)(wave * 512 + 16 * kq) * ldw + n0 + 4 * cq;
    const float* gp = kgain + wave * 512 + 16 * kq;
    unsigned pk[16][8];
    f32x4 mx = {0.f, 0.f, 0.f, 0.f};
#pragma unroll
    for (int s = 0; s < 16; ++s) {
        f32x4 v[4];
        const f32x4 g4 = *(const GAS f32x4*)(gp + 128 * (s >> 2) + 4 * (s & 3));
#pragma unroll
        for (int r = 0; r < 4; ++r) v[r] = *(const GAS f32x4*)(src + (size_t)(128 * (s >> 2) + 4 * (s & 3) + r) * ldw) * g4[r];
#pragma unroll
        for (int j = 0; j < 4; ++j) { pk[s][2 * j] = pk2(v[0][j], v[1][j]); pk[s][2 * j + 1] = pk2(v[2][j], v[3][j]);
            mx[j] = fmaxf(fmaxf(mx[j], fmaxf(fabsf(v[0][j]), fabsf(v[1][j]))), fmaxf(fabsf(v[2][j]), fabsf(v[3][j]))); }
    }
#pragma unroll
    for (int j = 0; j < 4; ++j) { mx[j] = fmaxf(mx[j], __shfl_xor(mx[j], 8)); mx[j] = fmaxf(mx[j], __shfl_xor(mx[j], 16)); mx[j] = fmaxf(mx[j], __shfl_xor(mx[j], 32)); }
    if (lane < 8) *(LAS f32x4*)(cmx + wave * 32 + 4 * cq) = mx;
    __syncthreads();
    f32x4 t = {1e-20f, 1e-20f, 1e-20f, 1e-20f};
#pragma unroll
    for (int w = 0; w < 8; ++w) { const f32x4 o = *(const LAS f32x4*)(cmx + w * 32 + 4 * cq); t[0] = fmaxf(t[0], o[0]); t[1] = fmaxf(t[1], o[1]); t[2] = fmaxf(t[2], o[2]); t[3] = fmaxf(t[3], o[3]); }
    if (tid < 8) *(GAS f32x4*)(cscale + d0 + 4 * cq) = t * ((1.0f / 127.0f) * csmul);
    float sc[4];
#pragma unroll
    for (int j = 0; j < 4; ++j) sc[j] = 127.0f / t[j];
#pragma unroll
    for (int j = 0; j < 4; ++j) { const int col = d0 + 4 * cq + j;
        signed char* dst = W8 + ((size_t)(col >> 8) * 32 + wave * 4) * 32768 + (size_t)((col & 255) * 128 + 16 * kq);
#pragma unroll
        for (int st = 0; st < 4; ++st) { v4u o;
#pragma unroll
            for (int q = 0; q < 4; ++q) { const unsigned w0 = pk[4 * st + q][2 * j], w1 = pk[4 * st + q][2 * j + 1];
                const int a = (int)fminf(fmaxf(rintf(bf_lo(w0) * sc[j]), -127.f), 127.f), b = (int)fminf(fmaxf(rintf(bf_hi(w0) * sc[j]), -127.f), 127.f);
                const int c = (int)fminf(fmaxf(rintf(bf_lo(w1) * sc[j]), -127.f), 127.f), d = (int)fminf(fmaxf(rintf(bf_hi(w1) * sc[j]), -127.f), 127.f);
                o[q] = (unsigned)(a & 255) | ((unsigned)(b & 255) << 8) | ((unsigned)(c & 255) << 16) | ((unsigned)d << 24); }
            *(GAS v4u*)(dst + (size_t)st * 32768) = o; } }
    __syncthreads();
}
__device__ __forceinline__ void resid_phase(bf16* hres, const bf16* delta, float* rstd, signed char* q8  , float* rs8, int nrows, int gw, int ngw, int lane) {
    for (int r = gw; r < nrows; r += ngw) {
        bf16* xr = hres + pg8::tix(r, 4 * lane, DM);
        const GAS v2u* dr = (const GAS v2u*)(delta + (size_t)r * DM) + lane; v2u a[16], d[16]; float s = 0.f;
#pragma unroll
        for (int j = 0; j < 16; ++j) { a[j] = *(const GAS v2u*)(xr + (size_t)j * 65536); d[j] = dr[64 * j]; }
        f32x4 vv[16];
#pragma unroll
        for (int j = 0; j < 16; ++j) { const float v0 = bf_lo(a[j].x) + bf_lo(d[j].x), v1 = bf_hi(a[j].x) + bf_hi(d[j].x), v2 = bf_lo(a[j].y) + bf_lo(d[j].y), v3 = bf_hi(a[j].y) + bf_hi(d[j].y);
            s += (v0 * v0 + v1 * v1) + (v2 * v2 + v3 * v3); v2u w; w.x = pk2(v0, v1); w.y = pk2(v2, v3); *(GAS v2u*)(xr + (size_t)j * 65536) = w; vv[j] = (f32x4){v0, v1, v2, v3}; }
        s = wave_sum(s);
        const float rstd_r = 1.0f / sqrtf(s * (1.0f / DM) + EPS);
        if (lane == 0) rstd[r] = rstd_r;
        if (q8) { const float ms = quant_row8(vv, q8, r, lane); if (lane == 0) rs8[r] = ms * rstd_r; }
    }
}
__device__ __forceinline__ void stat_phase(const bf16* hres, float* rstd, signed char* q8, float* rs8, int nrows, int gw, int ngw, int lane) {
    for (int r = gw; r < nrows; r += ngw) {
        const bf16* xr = hres + pg8::tix(r, 8 * lane, DM); v4u a[8]; float s = 0.f;
#pragma unroll
        for (int j = 0; j < 8; ++j) a[j] = *(const GAS v4u*)(xr + (size_t)j * 131072);
        float vv[8][8];
#pragma unroll
        for (int j = 0; j < 8; ++j) { unpack8(a[j], vv[j]);
#pragma unroll
            for (int e = 0; e < 8; ++e) s += vv[j][e] * vv[j][e]; }
        s = wave_sum(s);
        const float rstd_r = 1.0f / sqrtf(s * (1.0f / DM) + EPS);
        if (lane == 0) rstd[r] = rstd_r;
        { const float ms = quant_row8w(vv, q8, r, lane); if (lane == 0) rs8[r] = ms * rstd_r; }
    }
}
__device__ __forceinline__ void final_norm(const bf16* hres  , int row_off, const bf16* delta, const float* gain, float* dst, int nrows, int gw, int ngw, int lane) {
    for (int r = gw; r < nrows; r += ngw) {
        const bf16* xr = hres + pg8::tix(r + row_off, 8 * lane, DM); const GAS v4u* dr = (const GAS v4u*)(delta + (size_t)r * DM) + lane; GAS f32x4* o = (GAS f32x4*)(dst + (size_t)r * DM) + 2 * lane;
        v4u a[8], d[8]; float s = 0.f;
#pragma unroll
        for (int j = 0; j < 8; ++j) { a[j] = *(const GAS v4u*)(xr + (size_t)j * 131072); d[j] = dr[64 * j]; }
        float v[8][8];
#pragma unroll
        for (int j = 0; j < 8; ++j) { float fa[8], fd[8]; unpack8(a[j], fa); unpack8(d[j], fd);
#pragma unroll
            for (int e = 0; e < 8; ++e) { v[j][e] = fa[e] + fd[e]; s += v[j][e] * v[j][e]; } }
        const float rstd = 1.0f / sqrtf(wave_sum(s) * (1.0f / DM) + EPS);
#pragma unroll
        for (int j = 0; j < 8; ++j) { const f32x4 g0 = *((const GAS f32x4*)gain + 2 * lane + 128 * j), g1 = *((const GAS f32x4*)gain + 2 * lane + 128 * j + 1);
            o[128 * j] = (f32x4){v[j][0], v[j][1], v[j][2], v[j][3]} * rstd * g0; o[128 * j + 1] = (f32x4){v[j][4], v[j][5], v[j][6], v[j][7]} * rstd * g1; }
    }
}
__device__ __forceinline__ v4u pack8f(const float (&f)[8]) { v4u w; w.x = pk2(f[0], f[1]); w.y = pk2(f[2], f[3]); w.z = pk2(f[4], f[5]); w.w = pk2(f[6], f[7]); return w; }
__device__ __forceinline__ void conv_a_phase(const bf16* bg, const bf16* cv, const float* cw  , bf16* ain, int gtid, int nthr) {
    for (int idx = gtid; idx < 256 * (LTOK / 8); idx += nthr) {
        const int c0 = (idx & 255) * 8, t0 = (idx >> 8) * 8;
        v4u rc[10], rb[8];
#pragma unroll
        for (int i = 0; i < 10; ++i) { int t = t0 - 1 + i; t = t < 0 ? 0 : (t < LTOK ? t : LTOK - 1); rc[i] = *(const GAS v4u*)(cv + (size_t)t * DC + c0); }
#pragma unroll
        for (int i = 0; i < 8; ++i) rb[i] = *(const GAS v4u*)(bg + (size_t)(t0 + i) * DC + c0);
        float w0[8], w1[8], w2[8];
#pragma unroll
        for (int h = 0; h < 2; ++h) { const f32x4 a0 = *(const GAS f32x4*)(cw + c0 + 4 * h), a1 = *(const GAS f32x4*)(cw + 2048 + c0 + 4 * h), a2 = *(const GAS f32x4*)(cw + 4096 + c0 + 4 * h);
#pragma unroll
            for (int e = 0; e < 4; ++e) { w0[4 * h + e] = a0[e]; w1[4 * h + e] = a1[e]; w2[4 * h + e] = a2[e]; } }
        const v4u z4 = (v4u){0u, 0u, 0u, 0u};
        float pv[8], cu[8], nx[8];
        unpack8(t0 > 0 ? rc[0] : z4, pv);
        unpack8(rc[1], cu);
#pragma unroll
        for (int tt = 0; tt < 8; ++tt) { const int t = t0 + tt;
            unpack8((t + 1 < LTOK) ? rc[tt + 2] : z4, nx);
            float b[8], o[8]; unpack8(rb[tt], b);
#pragma unroll
            for (int j = 0; j < 8; ++j) { o[j] = b[j] * (w0[j] * pv[j] + w1[j] * cu[j] + w2[j] * nx[j]); pv[j] = cu[j]; cu[j] = nx[j]; }
            *(GAS v4u*)(ain + pg8::tix(t, c0, DC)) = pack8f(o); }
    }
}
__device__ __forceinline__ void conv_edge_phase(const float* zedge, const float* ztail, const float* cw  , bf16* act, int gtid, int nthr) {
    for (int idx = gtid; idx < 144 * 1536; idx += nthr) {
        const int cgi = idx % 1536, it = idx / 1536, c0 = cgi * 8, zg = (c0 >> 7) * 256 + (c0 & 127);
        int row; const float *pz, *cz, *nz; bool hp = true, hn = true;
        if (it < 128) { const int pm = it >> 1, wh = it & 1; row = pm * 256 + (wh ? 255 : 0);
            cz = zedge + (size_t)(pm * 4 + (wh ? 3 : 0)) * 24576;
            pz = wh ? zedge + (size_t)(pm * 4 + 2) * 24576 : zedge + (size_t)((pm > 0 ? pm - 1 : 0) * 4 + 3) * 24576; hp = wh || pm > 0;
            nz = wh ? (pm < 63 ? zedge + (size_t)((pm + 1) * 4) * 24576 : ztail) : zedge + (size_t)(pm * 4 + 1) * 24576;
        } else { const int i = it - 128; row = MG + i; cz = ztail + (size_t)i * 24576;
            pz = i > 0 ? ztail + (size_t)(i - 1) * 24576 : zedge + (size_t)(63 * 4 + 3) * 24576;
            nz = ztail + (size_t)(i < 15 ? i + 1 : 15) * 24576; hn = i < 15; }
        pz += zg; cz += zg; nz += zg;
        float o[8];
#pragma unroll
        for (int q = 0; q < 2; ++q) {
            const f32x4 z4 = (f32x4){0.f, 0.f, 0.f, 0.f};
            const f32x4 pg = hp ? *(const GAS f32x4*)(pz + 4 * q) : z4, pv = hp ? *(const GAS f32x4*)(pz + 128 + 4 * q) : z4;
            const f32x4 cg = *(const GAS f32x4*)(cz + 4 * q), cv = *(const GAS f32x4*)(cz + 128 + 4 * q);
            const f32x4 ng = hn ? *(const GAS f32x4*)(nz + 4 * q) : z4, nv = hn ? *(const GAS f32x4*)(nz + 128 + 4 * q) : z4;
            const f32x4 g0 = *(const GAS f32x4*)(cw + c0 + 4 * q), g1 = *(const GAS f32x4*)(cw + 24576 + c0 + 4 * q), g2 = *(const GAS f32x4*)(cw + 49152 + c0 + 4 * q);
            const f32x4 v0 = *(const GAS f32x4*)(cw + DFF + c0 + 4 * q), v1 = *(const GAS f32x4*)(cw + 24576 + DFF + c0 + 4 * q), v2 = *(const GAS f32x4*)(cw + 49152 + DFF + c0 + 4 * q);
            const f32x4 a = g0 * pg + g1 * cg + g2 * ng, b = v0 * pv + v1 * cv + v2 * nv;
#pragma unroll
            for (int j = 0; j < 4; ++j) o[4 * q + j] = pg8::gelu_t(a[j]) * b[j];
        }
        *(GAS v4u*)(act + pg8::tix(row, c0, DFF)) = pack8f(o);
    }
}

__device__ __forceinline__ f32x2 cmulf(f32x2 a, f32x2 b) { return (f32x2){a.x * b.x - a.y * b.y, a.x * b.y + a.y * b.x}; }
__device__ __forceinline__ void scan_pass1_reg(int layer, const bf16* u, const f32x2* abar, const bf16* BBt, f32x2* E, int wave, int lane) {
    const int dir = wave & 1, hh = lane >> 5, pl = lane & 31;
    for (int pi0 = (int)blockIdx.x * 4; pi0 < NG * NSEG; pi0 += (int)gridDim.x * 4) {
        const int pi = pi0 + (wave >> 1), g = pi & 63, seg = pi >> 6, ldg = (layer * 2 + dir) * NG + g;
        bf16x8 bbf[4];
#pragma unroll
        for (int nb = 0; nb < 4; ++nb) bbf[nb] = *(const GAS bf16x8*)(BBt + ((size_t)ldg * 128 + 32 * nb + pl) * 16 + 8 * hh);
        f32x2 w[2][16], a32[2];
#pragma unroll
        for (int b = 0; b < 2; ++b) {
            const f32x2 a = abar[ldg * 64 + pl + 32 * b];
            f32x2 P[33]; P[0] = (f32x2){1.f, 0.f};
#pragma unroll
            for (int k = 1; k <= 32; ++k) P[k] = cmulf(P[k - 1], a);
            a32[b] = P[32];
            const bool up4 = dir ? (hh == 1) : (hh == 0);
            const f32x2 F = up4 ? P[4] : (f32x2){1.f, 0.f};
#pragma unroll
            for (int i = 0; i < 16; ++i) { const int base = (i & 3) + 8 * (i >> 2); const f32x2 pw = dir ? P[base] : P[27 - base]; w[b][i] = cmulf(pw, F); }
        }
        f32x2 S[2] = {(f32x2){0.f, 0.f}, (f32x2){0.f, 0.f}};
        int nv = (LTOK - seg * SEGLEN + CHT - 1) / CHT; nv = nv > NCH ? NCH : nv; nv = __builtin_amdgcn_readfirstlane(nv);
        const bf16* ubase = u + (size_t)g * 16 + 8 * hh;
        constexpr int PF1 = 4;
        bf16x8 cur[PF1], nxt[PF1];
#pragma unroll
        for (int k = 0; k < PF1; ++k) { const int cc = k < nv ? k : nv - 1; int tl = seg * SEGLEN + (dir ? nv - 1 - cc : cc) * CHT + pl; tl = tl < LTOK ? tl : LTOK - 1; cur[k] = *(const GAS bf16x8*)(ubase + (size_t)tl * DSS); }
        for (int cb = 0; cb < nv; cb += PF1) {
#pragma unroll
            for (int k = 0; k < PF1; ++k) { const int cn = cb + PF1 + k, cc = cn < nv ? cn : nv - 1; int tl = seg * SEGLEN + (dir ? nv - 1 - cc : cc) * CHT + pl; tl = tl < LTOK ? tl : LTOK - 1; nxt[k] = *(const GAS bf16x8*)(ubase + (size_t)tl * DSS); }
#pragma unroll
            for (int k = 0; k < PF1; ++k) { const int ci = cb + k; if (ci < nv) {
                const int tlk = seg * SEGLEN + (dir ? nv - 1 - ci : ci) * CHT + pl;
                const bf16x8 uf = tlk < LTOK ? cur[k] : (bf16x8){0, 0, 0, 0, 0, 0, 0, 0};
                const f32x16 z16 = (f32x16){0.f, 0.f, 0.f, 0.f, 0.f, 0.f, 0.f, 0.f, 0.f, 0.f, 0.f, 0.f, 0.f, 0.f, 0.f, 0.f};
#pragma unroll
                for (int b = 0; b < 2; ++b) {
                    const f32x16 xr = __builtin_amdgcn_mfma_f32_32x32x16_bf16(uf, bbf[b], z16, 0, 0, 0);
                    const f32x16 xi = __builtin_amdgcn_mfma_f32_32x32x16_bf16(uf, bbf[b + 2], z16, 0, 0, 0);
                    float er = 0.f, ei = 0.f;
#pragma unroll
                    for (int i = 0; i < 16; ++i) { er += w[b][i].x * xr[i] - w[b][i].y * xi[i]; ei += w[b][i].x * xi[i] + w[b][i].y * xr[i]; }
                    er += __shfl_xor(er, 32); ei += __shfl_xor(ei, 32);
                    const f32x2 s = S[b]; S[b] = (f32x2){a32[b].x * s.x - a32[b].y * s.y + er, a32[b].x * s.y + a32[b].y * s.x + ei};
                }
            } }
#pragma unroll
            for (int k = 0; k < PF1; ++k) cur[k] = nxt[k];
        }
        if (hh == 0) { f32x2* Ep = E + ((size_t)(dir * NG + g) * NSEG + seg) * 64 + pl; Ep[0] = S[0]; Ep[32] = S[1]; }
    }
}

template <bool PASS2>
__device__ __forceinline__ void scan_pass(LAS unsigned char* lds, int layer, const bf16* u, const f32x2* abar, const f32x2* aseg, const bf16* BBt, const bf16* CCt, f32x2* E,
                                          float* yf, float* yb, const float* Dv, bf16* sout, int wave, int lane, int tid) {
    LAS unsigned char* xb = lds + wave * XBUF;
    const int dir = wave & 1;
    float* ybuf = dir ? yb : yf;
    for (int pi0 = (int)blockIdx.x * 4; pi0 < NG * NSEG; pi0 += (int)gridDim.x * 4) {
        const int pi = pi0 + (wave >> 1), g = pi & 63, seg = pi >> 6, ldg = (layer * 2 + dir) * NG + g;
        const f32x2 a = abar[ldg * 64 + lane]; const float nay = -a.y;
        bf16x8 bbf[4];
#pragma unroll
        for (int nb = 0; nb < 4; ++nb) bbf[nb] = *(const GAS bf16x8*)(BBt + ((size_t)ldg * 128 + 32 * nb + (lane & 31)) * 16 + 8 * (lane >> 5));
        bf16x8 ccf[4];
        float sr = 0.f, si = 0.f;
        if (PASS2) {
#pragma unroll
            for (int ks = 0; ks < 4; ++ks) ccf[ks] = *(const GAS bf16x8*)(CCt + ((size_t)ldg * 16 + (lane & 15)) * 128 + 32 * ks + 8 * (lane >> 4));
            const f32x2 as = aseg[ldg * 64 + lane]; const f32x2* Eb = E + ((size_t)(dir * NG + g) * NSEG) * 64 + lane;
            if (dir == 0) { for (int s2 = 0; s2 < seg; ++s2) { const f32x2 e = Eb[s2 * 64]; const float nr = as.x * sr - as.y * si + e.x, ni = as.x * si + as.y * sr + e.y; sr = nr; si = ni; } }
            else { for (int s2 = NSEG - 1; s2 > seg; --s2) { const f32x2 e = Eb[s2 * 64]; const float nr = as.x * sr - as.y * si + e.x, ni = as.x * si + as.y * sr + e.y; sr = nr; si = ni; } }
        }
        int nv = (LTOK - seg * SEGLEN + CHT - 1) / CHT; nv = nv > NCH ? NCH : nv; nv = __builtin_amdgcn_readfirstlane(nv);
        const bf16* ubase = u + (size_t)g * 16 + 8 * (lane >> 5);
        constexpr int PF2 = 2;
        bf16x8 cur[PF2], nxt[PF2];
#pragma unroll
        for (int k = 0; k < PF2; ++k) { const int cc = k < nv ? k : nv - 1; int tl = seg * SEGLEN + (dir ? nv - 1 - cc : cc) * CHT + (lane & 31); tl = tl < LTOK ? tl : LTOK - 1; cur[k] = *(const GAS bf16x8*)(ubase + (size_t)tl * DSS); }
        __builtin_amdgcn_s_waitcnt(0x0F70);
        for (int cb = 0; cb < nv; cb += PF2) {
#pragma unroll
          for (int k = 0; k < PF2; ++k) { const int cn = cb + PF2 + k, cc = cn < nv ? cn : nv - 1; int tl = seg * SEGLEN + (dir ? nv - 1 - cc : cc) * CHT + (lane & 31); tl = tl < LTOK ? tl : LTOK - 1; nxt[k] = *(const GAS bf16x8*)(ubase + (size_t)tl * DSS); }
#pragma unroll
          for (int k = 0; k < PF2; ++k) { const int ci = cb + k; if (ci < nv) {
            const int c = dir ? (nv - 1 - ci) : ci; const int t0 = __builtin_amdgcn_readfirstlane(seg * SEGLEN + c * CHT);
            const bf16x8 uf = (t0 + (lane & 31)) < LTOK ? cur[k] : (bf16x8){0, 0, 0, 0, 0, 0, 0, 0};
            const f32x16 z16 = (f32x16){0.f, 0.f, 0.f, 0.f, 0.f, 0.f, 0.f, 0.f, 0.f, 0.f, 0.f, 0.f, 0.f, 0.f, 0.f, 0.f};
#pragma unroll
            for (int b = 0; b < 2; ++b) {
                const f32x16 xr = __builtin_amdgcn_mfma_f32_32x32x16_bf16(uf, bbf[b], z16, 0, 0, 0);
                const f32x16 xi = __builtin_amdgcn_mfma_f32_32x32x16_bf16(uf, bbf[b + 2], z16, 0, 0, 0);
                LAS unsigned char* wp = xb + (4 * (lane >> 5)) * XROW + (32 * b + (lane & 31)) * 8;
#pragma unroll
                for (int i = 0; i < 16; ++i) { LAS float* q = (LAS float*)(wp + ((i & 3) + 8 * (i >> 2)) * XROW); q[0] = xr[i]; q[1] = xi[i]; }
            }
            LDS_WAIT();
            f32x2 xs[CHT];
#pragma unroll
            for (int j = 0; j < CHT; ++j) xs[j] = *(const LAS f32x2*)(xb + j * XROW + lane * 8);
            if (dir == 0) {
#pragma unroll
                for (int j = 0; j < CHT; ++j) { const float t1 = fma_s(a.x, sr, xs[j].x), t2 = fma_s(a.x, si, xs[j].y); const float nr = fma_s(nay, si, t1), ni = fma_s(a.y, sr, t2); sr = nr; si = ni; if (PASS2) { xs[j].x = sr; xs[j].y = si; } }
            } else {
#pragma unroll
                for (int j = CHT - 1; j >= 0; --j) { const float t1 = fma_s(a.x, sr, xs[j].x), t2 = fma_s(a.x, si, xs[j].y); const float nr = fma_s(nay, si, t1), ni = fma_s(a.y, sr, t2); sr = nr; si = ni; if (PASS2) { xs[j].x = sr; xs[j].y = si; } }
            }
            if (PASS2) {
#pragma unroll
                for (int j = 0; j < CHT; ++j) *(LAS unsigned*)(xb + j * XROW + 4 * lane) = pk2(xs[j].x, xs[j].y);
                LDS_WAIT();
#pragma unroll
                for (int mb = 0; mb < 2; ++mb) {
                    f32x4 y = (f32x4){0.f, 0.f, 0.f, 0.f};
#pragma unroll
                    for (int ks = 0; ks < 4; ++ks) { const bf16x8 af = *(const LAS bf16x8*)(xb + (16 * mb + (lane & 15)) * XROW + (32 * ks + 8 * (lane >> 4)) * 2);
                        y = __builtin_amdgcn_mfma_f32_16x16x32_bf16(ccf[ks], af, y, 0, 0, 0); }
                    { const int tok = t0 + 16 * mb + (lane & 15); *(GAS f32x4*)(ybuf + (size_t)tok * DSS + g * 16 + 4 * (lane >> 4)) = y; }
                }
                LDS_WAIT();
            }
          } }
#pragma unroll
          for (int k = 0; k < PF2; ++k) cur[k] = nxt[k];
        }
        if (!PASS2) E[((size_t)(dir * NG + g) * NSEG + seg) * 64 + lane] = (f32x2){sr, si};
        if (PASS2) {
            VM_WAIT(); __syncthreads();
            const int g0 = pi0 & 63, sg = pi0 >> 6, cq = tid & 15, tb = sg * SEGLEN;
            const int te = (tb + SEGLEN < LTOK) ? tb + SEGLEN : LTOK;
            const f32x4 dv = *(const GAS f32x4*)(Dv + g0 * 16 + 4 * cq);
            for (int t0 = tb + (tid >> 4); t0 < te; t0 += 128) {
                f32x4 a1[4], a2[4]; v2u uu[4];
#pragma unroll
                for (int q = 0; q < 4; ++q) { const int t = t0 + 32 * q, tc = t < te ? t : te - 1; const size_t off = (size_t)tc * DSS + g0 * 16 + 4 * cq;
                    a1[q] = *(const GAS f32x4*)(yf + off); a2[q] = *(const GAS f32x4*)(yb + off); uu[q] = *(const GAS v2u*)(u + off); }
#pragma unroll
                for (int q = 0; q < 4; ++q) { const int t = t0 + 32 * q;
                    if (t < te) {
                        const float v0 = a1[q].x + a2[q].x + dv.x * bf_lo(uu[q].x), v1 = a1[q].y + a2[q].y + dv.y * bf_hi(uu[q].x), v2 = a1[q].z + a2[q].z + dv.z * bf_lo(uu[q].y), v3 = a1[q].w + a2[q].w + dv.w * bf_hi(uu[q].y);
                        v2u w; w.x = pk2(pg8::gelu_t(v0), pg8::gelu_t(v1)); w.y = pk2(pg8::gelu_t(v2), pg8::gelu_t(v3));
                        *(GAS v2u*)(sout + pg8::tix(t, g0 * 16 + 4 * cq, DSS)) = w; } }
            }
            __syncthreads();
        }
    }
}

struct Args { const float* in[21]; float* out; unsigned char* ws; int ph_lo, ph_hi; };
__global__ void __launch_bounds__(NWAVES * 64, 2) mk_fwd(Args args) {
    extern __shared__ __attribute__((aligned(16))) unsigned char lds_raw[];
    LAS unsigned char* lds = (LAS unsigned char*)lds_raw;
    const int G = gridDim.x, bx = blockIdx.x, ngw = G * NWAVES, nthr = G * NWAVES * 64;
#define SITE_IDS() int tid = threadIdx.x; asm volatile("" : "+v"(tid)); const int lane = tid & 63, wave = __builtin_amdgcn_readfirstlane(tid >> 6), gw = bx * NWAVES + wave, gtid = bx * (NWAVES * 64) + tid; (void)lane; (void)wave; (void)gw; (void)gtid
    unsigned char* ws = args.ws;
    volatile LAS unsigned* MISC = (volatile LAS unsigned*)(lds + LDSCTL_OFF);
    for (int i = threadIdx.x; i < (LDS_BYTES - LDSCTL_OFF) / 4; i += NWAVES * 64) MISC[i] = 0u;
    __syncthreads();
    const int lo = args.ph_lo, hi = args.ph_hi;
    XcdBarrier bar; bar.bar = (unsigned*)(ws + WS_CTL) + 4096; bar.x = 0; bar.st = nullptr;
    if (hi - lo > 1) bar = xcd_barrier_post((unsigned*)(ws + WS_CTL) + 4096, MISC + 8);
#ifndef SITE_MASK
#define SITE_MASK 0xFFFF
#endif
#define EN(s) ((SITE_MASK >> (s)) & 1)
#define IN(k) (lo <= (k) && (k) < hi)
#define SEAM(k) do { if (IN((k) + 1)) xcd_barrier(bar); } while (0)

    const float* x = args.in[0]; const float* meta = args.in[1];
    signed char* hb8 = (signed char*)(ws + WS_HB8); signed char* wg8 = (signed char*)(ws + WS_WG8); float* rs8b = (float*)(ws + WS_RS8); float* cs8b = (float*)(ws + WS_CS8); float* csub = (float*)(ws + WS_RSTD + 1 * MiB);
    bf16* hb = (bf16*)(ws + WS_H);
    bf16* bgb = (bf16*)(ws + WS_R + R_BG); bf16* cvb = (bf16*)(ws + WS_R + R_CV); bf16* ub = (bf16*)(ws + WS_R + R_U); bf16* gab = (bf16*)(ws + WS_R + R_GA); bf16* gbb = (bf16*)(ws + WS_R + R_GB);
    bf16* ainb = (bf16*)(ws + WS_R + R_AIN); bf16* sb = (bf16*)(ws + WS_R + R_S); bf16* mb = (bf16*)(ws + WS_R + R_M); float* yfb = (float*)(ws + WS_R + R_YF); float* ybb = (float*)(ws + WS_R + R_YB);
    bf16* m1b = (bf16*)(ws + WS_R);
    bf16* dlt = (bf16*)(ws + WS_R + 650 * MiB);     float* rstdb = (float*)(ws + WS_RSTD);
    float* zedge = (float*)(ws + WS_R); float* ztail = (float*)(ws + WS_R + 32 * MiB); bf16* actb = (bf16*)(ws + WS_R + 64 * MiB);
    f32x2* abar = (f32x2*)(ws + WS_ABAR); f32x2* aseg = (f32x2*)(ws + WS_ASEG); bf16* BBt = (bf16*)(ws + WS_BBT); bf16* CCt = (bf16*)(ws + WS_CCT); f32x2* Eb = (f32x2*)(ws + WS_E);

    if (EN(0) && IN(0)) { SITE_IDS();
        LAS float* scr = (LAS float*)(lds + wave * 16640);
        for (int l = 0; l < 2; ++l) {
            unsigned char* wl = ws + WS_W + (size_t)l * W_LAYER;
            convert_matrix(args.in[3] + (size_t)l * DM * NIN, args.in[2] + l * DM, DM, NIN, (bf16*)(wl + W_IN), 1, scr, gw, ngw, lane, 7168);
            convert_matrix(args.in[5] + (size_t)l * DC * DM, nullptr, DC, DM, (bf16*)(wl + W_A), 0, scr, gw, ngw, lane);
            convert_matrix(args.in[14] + (size_t)l * DSS * 2 * DM, nullptr, DSS, 2 * DM, (bf16*)(wl + W_GLU), 2, scr, gw, ngw, lane);
            convert_matrix(args.in[15] + (size_t)l * DM * DM, nullptr, DM, DM, (bf16*)(wl + W_OUT), 0, scr, gw, ngw, lane);
            convert_matrix(args.in[19] + (size_t)l * DFF * DM, nullptr, DFF, DM, (bf16*)(wl + W_DOWN), 0, scr, gw, ngw, lane);
        }
        __syncthreads();
        for (int t = bx; t < 512 + 1536; t += G) {
            if (t < 512) { const int ly = t >> 8, cbk = t & 255;
                weights_i8(lds, args.in[3] + (size_t)ly * DM * NIN, NIN, args.in[2] + ly * DM, wg8 + (size_t)ly * (32 * MiB), cs8b + ly * 8192, 7168 + 32 * cbk, 32 * cbk, wave, lane, tid, -1.44269504089f); }
            else { const int u = t - 512, ly = u / 768, cbk = u % 768;
                weights_i8(lds, args.in[17] + (size_t)ly * DM * 2 * DFF, 2 * DFF, args.in[16] + ly * DM, (signed char*)(ws + WS_W + (size_t)ly * W_LAYER + W_UP), csub + ly * 24576, 32 * cbk, dest_row(2, 2 * DFF, 32 * cbk), wave, lane, tid); }
        }
        if (gtid < 2 * 2 * NG * 64) scan_params(gtid, args.in[6], args.in[7], args.in[8], args.in[9], args.in[10], args.in[11], args.in[12], abar, aseg, BBt, CCt);
        for (int r = gw; r < LTOK; r += ngw) {
            const GAS f32x4* xr = (const GAS f32x4*)(r < NMETA ? meta + (size_t)r * DM : x + (size_t)(r - NMETA) * DM) + 2 * lane;
            float s = 0.f; float vv[8][8];
#pragma unroll
            for (int j = 0; j < 8; ++j) { const f32x4 v0 = xr[128 * j], v1 = xr[128 * j + 1];
                vv[j][0] = v0.x; vv[j][1] = v0.y; vv[j][2] = v0.z; vv[j][3] = v0.w; vv[j][4] = v1.x; vv[j][5] = v1.y; vv[j][6] = v1.z; vv[j][7] = v1.w; }
#pragma unroll
            for (int j = 0; j < 8; ++j) {
#pragma unroll
                for (int e = 0; e < 8; ++e) s += vv[j][e] * vv[j][e];
                v4u w; w.x = pk2(vv[j][0], vv[j][1]); w.y = pk2(vv[j][2], vv[j][3]); w.z = pk2(vv[j][4], vv[j][5]); w.w = pk2(vv[j][6], vv[j][7]);
                *(GAS v4u*)(hb + pg8::tix(r, 8 * lane + 512 * j, DM)) = w; }
            s = wave_sum(s);
            const float rstd_r = 1.0f / sqrtf(s * (1.0f / DM) + EPS);
            if (lane == 0) rstdb[r] = rstd_r;
            { const float ms = quant_row8w(vv, hb8, r, lane); if (lane == 0) rs8b[r] = ms * rstd_r; }
        }
        SEAM(0);
    }
    for (int l = 0; l < 2; ++l) {
        const int pb = 1 + 11 * l;
        unsigned char* wl = ws + WS_W + (size_t)l * W_LAYER;
        if (EN(1) && IN(pb + 0) && l > 0) { SITE_IDS(); stat_phase(hb, rstdb, hb8, rs8b, LTOK, gw, ngw, lane); SEAM(pb + 0); }
        if (EN(2) && IN(pb + 1)) {
            pg8::Gemm g{hb, (const bf16*)(wl + W_IN), MG, 7168, DM}; pg8::StaticOrder S; S.init(MG, 7168, G, bx);
            pg8::EpiIn E{bgb, cvb, ub, gab, gbb, rstdb};
            pg8::gemm_phase<pg8::EpiIn, pg8::StaticOrder, true, true, true, WTILED>(lds, g, S, E);
            { pg8::Gemm g8{(const bf16*)hb8, (const bf16*)(wg8 + (size_t)l * (32 * MiB)), MG, 8192, 2048}; pg8::StaticOrder S8; S8.init(MG, 8192, G, bx);
              pg8::EpiGate8 E8{pg8::EpiIn{bgb, cvb, ub, gab, gbb, rs8b}, cs8b + l * 8192};
              pg8::gemm_phase<pg8::EpiGate8, pg8::StaticOrder, true, true, true, true, true>(lds, g8, S8, E8); }
            pg8::tail_gemm<decltype(E), WTILED>(lds, hb, (const bf16*)(wl + W_IN), 7168, DM, MG, E);
            { pg8::EpiGate8 E8{pg8::EpiIn{bgb, cvb, ub, gab, gbb, rs8b}, cs8b + l * 8192}; pg8::tail_gemm<decltype(E8), true, true>(lds, (const bf16*)hb8, (const bf16*)(wg8 + (size_t)l * (32 * MiB)), 8192, 2048, MG, E8); }
            SEAM(pb + 1);
        }
        if (EN(3) && IN(pb + 2)) { SITE_IDS();
            scan_pass1_reg(l, ub, abar, BBt, Eb, wave, lane);
            conv_a_phase(bgb, cvb, args.in[4] + l * 3 * DC, ainb, gtid, nthr);
            SEAM(pb + 2);
        }
        if (EN(4) && IN(pb + 3)) { SITE_IDS();
            scan_pass<true>(lds, l, ub, abar, aseg, BBt, CCt, Eb, yfb, ybb, args.in[13] + l * DSS, sb, wave, lane, tid);
        }
        if (EN(5) && IN(pb + 3)) {
            pg8::Gemm g{ainb, (const bf16*)(wl + W_A), MG, DM, DC}; pg8::StaticOrder S; S.init(MG, DM, G, bx);
            pg8::EpiMulGate E{gab, m1b};
            pg8::gemm_phase<pg8::EpiMulGate, pg8::StaticOrder, true, true, true, WTILED>(lds, g, S, E);
            pg8::tail_gemm<decltype(E), WTILED>(lds, ainb, (const bf16*)(wl + W_A), DM, DC, MG, E);
            SEAM(pb + 4);
        }
        if (EN(6) && IN(pb + 5)) {
            pg8::Gemm g{sb, (const bf16*)(wl + W_GLU), MG, 2 * DM, DSS}; pg8::StaticOrder S; S.init(MG, 2 * DM, G, bx);
            pg8::EpiGlu E{gbb, m1b, mb};
            pg8::gemm_phase<pg8::EpiGlu, pg8::StaticOrder, true, true, true, WTILED>(lds, g, S, E);
            pg8::tail_gemm<decltype(E), WTILED>(lds, sb, (const bf16*)(wl + W_GLU), 2 * DM, DSS, MG, E);
            SEAM(pb + 5);
        }
        if (EN(7) && IN(pb + 6)) {
            pg8::Gemm g{mb, (const bf16*)(wl + W_OUT), MG, DM, DM}; pg8::StaticOrder S; S.init(MG, DM, G, bx);
            pg8::EpiResid E{hb, dlt, true};
            pg8::gemm_phase<pg8::EpiResid, pg8::StaticOrder, true, true, true, WTILED>(lds, g, S, E);
            pg8::tail_gemm<decltype(E), WTILED>(lds, mb, (const bf16*)(wl + W_OUT), DM, DM, MG, E);
            SEAM(pb + 6);
        }
        if (EN(8) && IN(pb + 7)) { SITE_IDS(); stat_phase(hb, rstdb, hb8, rs8b, LTOK, gw, ngw, lane); SEAM(pb + 7); }
        if (EN(9) && IN(pb + 8)) {
            unsigned char* wsl = ws; asm volatile("" : "+s"(wsl));
            const bf16* a8 = (const bf16*)(wsl + WS_HB8); const bf16* w8 = (const bf16*)(wsl + WS_W + (size_t)l * W_LAYER + W_UP);
            pg8::Gemm g{a8, w8, MG, 2 * DFF, 2048}; pg8::StaticOrder S; S.init(MG, 2 * DFF, G, bx);
            pg8::EpiUp8 E{pg8::EpiUpConv{args.in[18] + (size_t)l * 3 * 2 * DFF, (bf16*)(wsl + WS_R + 64 * MiB), (float*)(wsl + WS_R), (LAS float*)(lds + pg8::STAGE_BYTES), (float*)(wsl + WS_R + 32 * MiB), (const float*)(wsl + WS_RS8), (const float*)(wsl + WS_RSTD + 1 * MiB) + l * 24576}};
            pg8::gemm_phase<pg8::EpiUp8, pg8::StaticOrder, true, true, true, true, true>(lds, g, S, E);
            pg8::tail_gemm<decltype(E), true, true>(lds, a8, w8, 2 * DFF, 2048, MG, E);
            SEAM(pb + 8);
        }
        if (EN(10) && IN(pb + 9)) { SITE_IDS(); conv_edge_phase(zedge, ztail, args.in[18] + (size_t)l * 3 * 2 * DFF, actb, gtid, nthr); SEAM(pb + 9); }
        if (EN(11) && IN(pb + 10)) {
            pg8::Gemm g{actb, (const bf16*)(wl + W_DOWN), MG, DM, DFF}; pg8::StaticOrder S; S.init(MG, DM, G, bx);
            pg8::EpiResid E{hb, dlt, l == 0};
            pg8::gemm_phase<pg8::EpiResid, pg8::StaticOrder, true, true, true, WTILED>(lds, g, S, E);
            pg8::tail_gemm<decltype(E), WTILED>(lds, actb, (const bf16*)(wl + W_DOWN), DM, DFF, MG, E);
            SEAM(pb + 10);
        }
    }
    if (EN(12) && IN(23)) { SITE_IDS(); final_norm(hb, NMETA, dlt + (size_t)NMETA * DM, args.in[20], args.out, SEQ, gw, ngw, lane); }
#undef IN
#undef SEAM
}

extern "C" void kernel_launch(void* const* d_in, const int* in_sizes, int n_in, void* d_out, int out_size, void* d_ws, size_t ws_size, hipStream_t stream) {
    static int grid = 0;
    if (grid == 0) {
        if (n_in != 21 || out_size != SEQ * DM || ws_size < WS_END) { fprintf(stderr, "kernel_launch: unexpected shapes: n_in %d out %d ws %zu (need %zu)\n", n_in, out_size, ws_size, (size_t)WS_END); grid = -1; return; }
        int dev = 0, cus = 0, per_cu = 0;
        if (hipGetDevice(&dev) != hipSuccess || hipDeviceGetAttribute(&cus, hipDeviceAttributeMultiprocessorCount, dev) != hipSuccess) { grid = -1; return; }
        if (hipFuncSetAttribute((const void*)mk_fwd, hipFuncAttributeMaxDynamicSharedMemorySize, LDS_BYTES) != hipSuccess) { fprintf(stderr, "kernel_launch: hipFuncSetAttribute failed\n"); grid = -1; return; }
        if (hipOccupancyMaxActiveBlocksPerMultiprocessor(&per_cu, (const void*)mk_fwd, NWAVES * 64, LDS_BYTES) != hipSuccess || per_cu < 1) { fprintf(stderr, "kernel_launch: occupancy query says %d\n", per_cu); }
        (void)hipGetLastError();
        grid = cus;
    }
    if (grid < 0) return;
    if (hipMemsetAsync((char*)d_ws + WS_CTL, 0, CTL_ZERO_BYTES, stream) != hipSuccess) return;
    Args a{};
    for (int i = 0; i < 21; ++i) a.in[i] = (const float*)d_in[i];
    a.out = (float*)d_out; a.ws = (unsigned char*)d_ws;
#if MK_N_LAUNCHES == 1
    a.ph_lo = 0; a.ph_hi = NPH;
    hipLaunchKernelGGL(mk_fwd, dim3(grid), dim3(NWAVES * 64), LDS_BYTES, stream, a);
#else
    for (int p = 0; p < NPH; ++p) { a.ph_lo = p; a.ph_hi = p + 1; hipLaunchKernelGGL(mk_fwd, dim3(grid), dim3(NWAVES * 64), LDS_BYTES, stream, a); }
#endif
}
```

```cpp
#include <hip/hip_runtime.h>
#include <cstdio>
#include <cstdint>
namespace pg8 {
#define PG8_LAS __attribute__((address_space(3)))
typedef unsigned short bf16_t;
typedef short bf16x8 __attribute__((ext_vector_type(8)));
typedef float f32x4 __attribute__((ext_vector_type(4)));
typedef unsigned u32x4 __attribute__((ext_vector_type(4)));
typedef int i32x4 __attribute__((ext_vector_type(4)));
constexpr int BM = 256, BK = 64, HALF = 128, HTB = HALF * BK * 2  , STAGE_BYTES = 8 * HTB, NXCD = 8, WGM = 4;

__host__ __device__ __forceinline__ int lds_byte(int r, int c) { const int st = (r >> 4) * 2 + (c >> 5), rr = r & 15, cc = c & 31, ob = rr * 64 + cc * 2; return st * 1024 + (ob ^ (((ob >> 9) & 1) << 5)); }
__host__ __device__ __forceinline__ void stage_rc(int b, int& R, int& C) { const int st = b / 1024, sb = b % 1024, swz = sb ^ (((sb >> 9) & 1) << 5); R = (st >> 1) * 16 + swz / 64; C = (st & 1) * 32 + (swz % 64) / 2; }
__host__ __device__ __forceinline__ int perm32(int rho) { const int n = rho >> 4, i = rho & 15; return 8 * (i >> 2) + 4 * n + (i & 3); }

struct Unit { int pm, pn; };
struct Gemm { const bf16_t* A; const bf16_t* Bt; int M, N, K; };

struct StaticOrder {
    int nM, nN, nwg, G, c;
    __host__ __device__ void init(int M, int N, int G_, int c_) { nM = M / BM; nN = N / BM; nwg = nM * nN; G = G_; c = c_; }
    __host__ __device__ bool next(int i, Unit& u) const {
        const long L = (long)i * G + c; if (L >= nwg) return false;
        int wgid = (int)L; { const int q = nwg / NXCD, r = nwg % NXCD, xcd = wgid % NXCD, off = wgid / NXCD; wgid = (xcd < r ? xcd * (q + 1) : r * (q + 1) + (xcd - r) * q) + off; }
        const int nig = WGM * nN, gid = wgid / nig, fm = gid * WGM, gsz = (nM - fm) < WGM ? (nM - fm) : WGM;
        u.pm = fm + ((wgid % nig) % gsz); u.pn = (wgid % nig) / gsz; return true;
    }
    __device__ __forceinline__ void a_ready(const Unit&) const {}
    __device__ __forceinline__ void done(const Unit&) const {}
};

__device__ __forceinline__ unsigned cvt_pk_bf16(float lo, float hi) { unsigned r; asm volatile("v_cvt_pk_bf16_f32 %0, %1, %2" : "=v"(r) : "v"(lo), "v"(hi)); return r; }
typedef float f32x2 __attribute__((ext_vector_type(2)));
__device__ __forceinline__ f32x2 gelu_pk(f32x2 v) {
    const f32x2 av = __builtin_elementwise_abs(v), d = av * 0.2316418882f + 1.0f;
    f32x2 t; t.x = __builtin_amdgcn_rcpf(d.x); t.y = __builtin_amdgcn_rcpf(d.y);
    f32x2 q = t * 0.5307027145f + (-0.7265760135f); q = q * t + 0.7107068705f; q = q * t + (-0.142248368f); q = q * t + 0.127414796f; q = q * t;
    const f32x2 s = (v * v) * (-0.72134752044f);
    f32x2 e; e.x = __builtin_amdgcn_exp2f(s.x); e.y = __builtin_amdgcn_exp2f(s.y);
    const f32x2 m = v * (q * e), r = v - m;
    f32x2 o; o.x = v.x < 0.f ? m.x : r.x; o.y = v.y < 0.f ? m.y : r.y; return o;
}

template <int ACT  > struct EpiBf16 {
    static constexpr bool PERM = true, AFTER_DRAIN = false; static_assert(ACT == 0 || ACT == 1, "EpiBf16: ACT is 0 (none) or 1 (gelu_pk)");
    bf16_t* O; int ldc; const float* bias; int split_cols; size_t split_stride; float scale0;
    __device__ __forceinline__ void operator()(const f32x4 (&acc)[2][2][4][2], const Unit& u, int wr, int wc, int fr, int fq) const {
        const int row0 = u.pm * BM + wr * 64 + fr; int colt = u.pn * BM; bf16_t* base = O;
        float sc = 1.f; if (split_cols) { const int t = colt / split_cols; base += (size_t)t * split_stride; colt -= t * split_cols; if (t == 0) sc = scale0; }
        const int col0 = colt + wc * 32 + 8 * fq, bcol0 = u.pn * BM + wc * 32 + 8 * fq;
        f32x4 bv[2][2];
#pragma unroll
        for (int bj = 0; bj < 2; ++bj)
#pragma unroll
            for (int n = 0; n < 2; ++n) bv[bj][n] = bias ? *(const f32x4*)(bias + bcol0 + bj * HALF + 4 * n) : (f32x4){0.f, 0.f, 0.f, 0.f};
#pragma unroll
        for (int ai = 0; ai < 2; ++ai)
#pragma unroll
            for (int m = 0; m < 4; ++m) { bf16_t* rowp = base + (size_t)(row0 + ai * HALF + m * 16) * ldc + col0;
#pragma unroll
                for (int bj = 0; bj < 2; ++bj) { f32x4 v0 = acc[ai][bj][m][0] + bv[bj][0], v1 = acc[ai][bj][m][1] + bv[bj][1];
                    if (ACT == 1) { f32x2 a = gelu_pk((f32x2){v0[0], v0[1]}), b = gelu_pk((f32x2){v0[2], v0[3]}), c = gelu_pk((f32x2){v1[0], v1[1]}), d = gelu_pk((f32x2){v1[2], v1[3]});
                        v0 = (f32x4){a.x, a.y, b.x, b.y}; v1 = (f32x4){c.x, c.y, d.x, d.y}; }
                    v0 = v0 * sc; v1 = v1 * sc; u32x4 w; w.x = cvt_pk_bf16(v0[0], v0[1]); w.y = cvt_pk_bf16(v0[2], v0[3]); w.z = cvt_pk_bf16(v1[0], v1[1]); w.w = cvt_pk_bf16(v1[2], v1[3]);
                    *(u32x4*)(rowp + bj * HALF) = w; } }
    }
};
__host__ __device__ __forceinline__ size_t tix(int r, int c, int K) { return ((size_t)(r >> 8) * (size_t)(K >> 6) + (size_t)(c >> 6)) * 16384 + (size_t)((r & 255) * 64 + (c & 63)); }
__device__ __forceinline__ float sigm(float x) { return __builtin_amdgcn_rcpf(1.0f + __builtin_amdgcn_exp2f(-1.44269504089f * x)); }
__device__ __forceinline__ float sigm_pre(float t) { return __builtin_amdgcn_rcpf(1.0f + __builtin_amdgcn_exp2f(t)); }
__device__ __forceinline__ float gelu_t(float x) { const float u = x * __builtin_fmaf(-0.10294324f, x * x, -2.30220815f); return x * __builtin_amdgcn_rcpf(1.0f + __builtin_amdgcn_exp2f(u)); }
__device__ __forceinline__ bf16_t f2bf_s(float f) { unsigned u = __float_as_uint(f); return (bf16_t)((u + 0x7fffu + ((u >> 16) & 1u)) >> 16); }
__device__ __forceinline__ float bf2f_s(bf16_t b) { return __uint_as_float(((unsigned)b) << 16); }
__device__ __forceinline__ f32x4 bflo(unsigned a, unsigned b) { return (f32x4){__uint_as_float(a << 16), __uint_as_float(a & 0xffff0000u), __uint_as_float(b << 16), __uint_as_float(b & 0xffff0000u)}; }
__device__ __forceinline__ u32x4 pack8(f32x4 v0, f32x4 v1) { u32x4 w; w.x = cvt_pk_bf16(v0[0], v0[1]); w.y = cvt_pk_bf16(v0[2], v0[3]); w.z = cvt_pk_bf16(v1[0], v1[1]); w.w = cvt_pk_bf16(v1[2], v1[3]); return w; }

__device__ __forceinline__ void scale_rows(f32x4 (&acc)[2][2][4][2], const float* rstd, int row0) {
#pragma unroll
    for (int ai = 0; ai < 2; ++ai)
#pragma unroll
        for (int m = 0; m < 4; ++m) { const float rs = rstd[row0 + ai * HALF + m * 16];
#pragma unroll
            for (int bj = 0; bj < 2; ++bj)
#pragma unroll
                for (int n = 0; n < 2; ++n) acc[ai][bj][m][n] = acc[ai][bj][m][n] * rs; }
}

struct EpiIn {
    static constexpr bool PERM = true, AFTER_DRAIN = false;
    bf16_t *bg, *cv, *u, *ga, *gb; const float* rstd;
    __device__ __forceinline__ void operator()(f32x4 (&acc)[2][2][4][2], const Unit& un, int wr, int wc, int fr, int fq) const {
        const int pn = un.pn; const int row0 = un.pm * BM + wr * 64 + fr; const int cb = wc * 32 + 8 * fq;
        scale_rows(acc, rstd, row0);
        if (pn >= 8 && pn < 24) {
            bf16_t* base = cv + (size_t)row0 * 2048 + (pn - 8) * 128 + cb;
#pragma unroll
            for (int ai = 0; ai < 2; ++ai)
#pragma unroll
                for (int m = 0; m < 4; ++m) { bf16_t* rowp = base + (size_t)(ai * HALF + m * 16) * 2048;
                    *(u32x4*)rowp = pack8(acc[ai][0][m][0] * acc[ai][1][m][0], acc[ai][0][m][1] * acc[ai][1][m][1]); }
        } else {
            bf16_t* base; int ld; bool sg;
            if (pn < 8) { base = bg + pn * 256; ld = 2048; sg = false; }
            else if (pn < 28) { base = u + (pn - 24) * 256; ld = 1024; sg = false; }
            else if (pn < 44) { base = ga + (pn - 28) * 256; ld = 4096; sg = true; }
            else { base = gb + (pn - 44) * 256; ld = 4096; sg = true; }
            base += (size_t)row0 * ld + cb;
#pragma unroll
            for (int ai = 0; ai < 2; ++ai)
#pragma unroll
                for (int m = 0; m < 4; ++m) { bf16_t* rowp = base + (size_t)(ai * HALF + m * 16) * ld;
#pragma unroll
                    for (int bj = 0; bj < 2; ++bj) { f32x4 v0 = acc[ai][bj][m][0], v1 = acc[ai][bj][m][1];
                        if (sg) {
#pragma unroll
                            for (int j = 0; j < 4; ++j) { v0[j] = sigm_pre(v0[j]); v1[j] = sigm_pre(v1[j]); } }
                        *(u32x4*)(rowp + bj * HALF) = pack8(v0, v1); } }
        }
    }
    __device__ __forceinline__ void tail(int row, int pn, int c, float v0, float v1) const {
        { const float rs = rstd[row]; v0 *= rs; v1 *= rs; }
        if (pn >= 8 && pn < 24) { cv[(size_t)row * 2048 + (pn - 8) * 128 + c] = f2bf_s(v0 * v1); return; }
        bf16_t* base; int ld; bool sg;
        if (pn < 8) { base = bg + pn * 256; ld = 2048; sg = false; }
        else if (pn < 28) { base = u + (pn - 24) * 256; ld = 1024; sg = false; }
        else if (pn < 44) { base = ga + (pn - 28) * 256; ld = 4096; sg = true; }
        else { base = gb + (pn - 44) * 256; ld = 4096; sg = true; }
        if (sg) { v0 = sigm_pre(v0); v1 = sigm_pre(v1); }
        base[(size_t)row * ld + c] = f2bf_s(v0); base[(size_t)row * ld + 128 + c] = f2bf_s(v1);
    }
};
struct EpiGate8 {
    static constexpr bool PERM = true, AFTER_DRAIN = false;
    EpiIn e; const float* colscale;
    __device__ __forceinline__ void operator()(f32x4 (&acc)[2][2][4][2], const Unit& un, int wr, int wc, int fr, int fq) const {
        const int cb = wc * 32 + 8 * fq;
#pragma unroll
        for (int bj = 0; bj < 2; ++bj)
#pragma unroll
            for (int n = 0; n < 2; ++n) { const f32x4 cs = *(const f32x4*)(colscale + un.pn * 256 + bj * HALF + cb + 4 * n);
#pragma unroll
                for (int ai = 0; ai < 2; ++ai)
#pragma unroll
                    for (int m = 0; m < 4; ++m) { const i32x4 iv = __builtin_bit_cast(i32x4, acc[ai][bj][m][n]); acc[ai][bj][m][n] = (f32x4){(float)iv[0], (float)iv[1], (float)iv[2], (float)iv[3]} * cs; } }
        Unit u2 = un; u2.pn += 28; e(acc, u2, wr, wc, fr, fq);
    }
    __device__ __forceinline__ void tail(int row, int pn, int c, float v0, float v1) const { e.tail(row, pn + 28, c, v0 * colscale[pn * 256 + c], v1 * colscale[pn * 256 + 128 + c]); }
};
struct EpiMulGate {
    static constexpr bool PERM = true, AFTER_DRAIN = false;
    const bf16_t* ga; bf16_t* m1;
    __device__ __forceinline__ void operator()(const f32x4 (&acc)[2][2][4][2], const Unit& un, int wr, int wc, int fr, int fq) const {
        const unsigned off0 = ((unsigned)(un.pm * BM + wr * 64 + fr) * 4096u + (unsigned)(un.pn * 256 + wc * 32 + 8 * fq)) * 2u;
        u32x4 g[2][4][2];
#pragma unroll
        for (int ai = 0; ai < 2; ++ai)
#pragma unroll
            for (int m = 0; m < 4; ++m)
#pragma unroll
                for (int bj = 0; bj < 2; ++bj) g[ai][m][bj] = *(const u32x4*)((const char*)ga + (size_t)(off0 + (unsigned)((ai * HALF + m * 16) * 8192 + bj * 256)));
#pragma unroll
        for (int ai = 0; ai < 2; ++ai)
#pragma unroll
            for (int m = 0; m < 4; ++m)
#pragma unroll
                for (int bj = 0; bj < 2; ++bj) { const u32x4 gg = g[ai][m][bj];
                    *(u32x4*)((char*)m1 + (size_t)(off0 + (unsigned)((ai * HALF + m * 16) * 8192 + bj * 256))) = pack8(acc[ai][bj][m][0] * bflo(gg.x, gg.y), acc[ai][bj][m][1] * bflo(gg.z, gg.w)); }
    }
    __device__ __forceinline__ void tail(int row, int pn, int c, float v0, float v1) const {
        const size_t o = (size_t)row * 4096 + pn * 256 + c;
        m1[o] = f2bf_s(v0 * bf2f_s(ga[o])); m1[o + 128] = f2bf_s(v1 * bf2f_s(ga[o + 128]));
    }
};
struct EpiGlu {
    static constexpr bool PERM = true, AFTER_DRAIN = false;
    const bf16_t* gb; const bf16_t* m1; bf16_t* mm;
    __device__ __forceinline__ void operator()(const f32x4 (&acc)[2][2][4][2], const Unit& un, int wr, int wc, int fr, int fq) const {
        const unsigned off0 = ((unsigned)(un.pm * BM + wr * 64 + fr) * 4096u + (unsigned)(un.pn * 128 + wc * 32 + 8 * fq)) * 2u;
        const size_t moff0 = (((size_t)un.pm * 64 + (size_t)(un.pn * 2 + (wc >> 1))) * 16384 + (size_t)((wr * 64 + fr) * 64 + (wc & 1) * 32 + 8 * fq)) * 2;
        u32x4 g[2][4], o[2][4];
#pragma unroll
        for (int ai = 0; ai < 2; ++ai)
#pragma unroll
            for (int m = 0; m < 4; ++m) { const size_t off = (size_t)(off0 + (unsigned)((ai * HALF + m * 16) * 8192));
                g[ai][m] = *(const u32x4*)((const char*)gb + off); o[ai][m] = *(const u32x4*)((const char*)m1 + off); }
#pragma unroll
        for (int ai = 0; ai < 2; ++ai)
#pragma unroll
            for (int m = 0; m < 4; ++m) { const size_t off = (size_t)(off0 + (unsigned)((ai * HALF + m * 16) * 8192));
                f32x4 y0 = acc[ai][0][m][0], y1 = acc[ai][0][m][1]; const f32x4 t0 = acc[ai][1][m][0], t1 = acc[ai][1][m][1];
#pragma unroll
                for (int j = 0; j < 4; ++j) { y0[j] *= sigm_pre(t0[j]); y1[j] *= sigm_pre(t1[j]); }
                const u32x4 gg = g[ai][m], oo = o[ai][m];
                *(u32x4*)((char*)mm + moff0 + (size_t)((ai * HALF + m * 16) * 128)) = pack8(bflo(oo.x, oo.y) + bflo(gg.x, gg.y) * y0, bflo(oo.z, oo.w) + bflo(gg.z, gg.w) * y1); }
    }
    __device__ __forceinline__ void tail(int row, int pn, int c, float v0, float v1) const {
        const size_t o = (size_t)row * 4096 + pn * 128 + c;
        mm[tix(row, pn * 128 + c, 4096)] = f2bf_s(bf2f_s(m1[o]) + bf2f_s(gb[o]) * v0 * sigm_pre(v1));
    }
};
struct EpiStoreDelta {
    static constexpr bool PERM = true, AFTER_DRAIN = false;
    bf16_t* dl;
    __device__ __forceinline__ void operator()(const f32x4 (&acc)[2][2][4][2], const Unit& un, int wr, int wc, int fr, int fq) const {
        const unsigned off0 = ((unsigned)(un.pm * BM + wr * 64 + fr) * 4096u + (unsigned)(un.pn * BM + wc * 32 + 8 * fq)) * 2u;
#pragma unroll
        for (int ai = 0; ai < 2; ++ai)
#pragma unroll
            for (int m = 0; m < 4; ++m)
#pragma unroll
                for (int bj = 0; bj < 2; ++bj) *(u32x4*)((char*)dl + (size_t)(off0 + (unsigned)((ai * HALF + m * 16) * 8192 + bj * 256))) = pack8(acc[ai][bj][m][0], acc[ai][bj][m][1]);
    }
    __device__ __forceinline__ void tail(int row, int pn, int c, float v0, float v1) const {
        const size_t o = (size_t)row * 4096 + pn * 256 + c; dl[o] = f2bf_s(v0); dl[o + 128] = f2bf_s(v1);
    }
};
struct EpiResid {
    static constexpr bool PERM = true, AFTER_DRAIN = false;
    bf16_t* hres; bf16_t* dl; bool add;
    __device__ __forceinline__ void operator()(const f32x4 (&acc)[2][2][4][2], const Unit& un, int wr, int wc, int fr, int fq) const {
        if (add) {
            const unsigned off0 = (((unsigned)un.pm * 64u + (unsigned)(un.pn * 4 + (wc >> 1))) * 16384u + (unsigned)((wr * 64 + fr) * 64 + (wc & 1) * 32 + 8 * fq)) * 2u;
            u32x4 h[2][4][2];
#pragma unroll
            for (int ai = 0; ai < 2; ++ai)
#pragma unroll
                for (int m = 0; m < 4; ++m)
#pragma unroll
                    for (int bj = 0; bj < 2; ++bj) h[ai][m][bj] = *(const u32x4*)((const char*)hres + (size_t)(off0 + (unsigned)((ai * HALF + m * 16) * 128 + bj * 65536)));
#pragma unroll
            for (int ai = 0; ai < 2; ++ai)
#pragma unroll
                for (int m = 0; m < 4; ++m)
#pragma unroll
                    for (int bj = 0; bj < 2; ++bj) { const u32x4 hh = h[ai][m][bj];
                        *(u32x4*)((char*)hres + (size_t)(off0 + (unsigned)((ai * HALF + m * 16) * 128 + bj * 65536))) = pack8(acc[ai][bj][m][0] + bflo(hh.x, hh.y), acc[ai][bj][m][1] + bflo(hh.z, hh.w)); }
        } else {
            const unsigned off0 = ((unsigned)(un.pm * BM + wr * 64 + fr) * 4096u + (unsigned)(un.pn * BM + wc * 32 + 8 * fq)) * 2u;
#pragma unroll
            for (int ai = 0; ai < 2; ++ai)
#pragma unroll
                for (int m = 0; m < 4; ++m)
#pragma unroll
                    for (int bj = 0; bj < 2; ++bj) *(u32x4*)((char*)dl + (size_t)(off0 + (unsigned)((ai * HALF + m * 16) * 8192 + bj * 256))) = pack8(acc[ai][bj][m][0], acc[ai][bj][m][1]);
        }
    }
    __device__ __forceinline__ void tail(int row, int pn, int c, float v0, float v1) const {
        if (add) { const size_t i0 = tix(row, pn * 256 + c, 4096), i1 = tix(row, pn * 256 + 128 + c, 4096); hres[i0] = f2bf_s(bf2f_s(hres[i0]) + v0); hres[i1] = f2bf_s(bf2f_s(hres[i1]) + v1); }
        else { const size_t o = (size_t)row * 4096 + pn * 256 + c; dl[o] = f2bf_s(v0); dl[o + 128] = f2bf_s(v1); }
    }
};
template <int N> __device__ __forceinline__ float dpp_ror(float v) { return __builtin_bit_cast(float, __builtin_amdgcn_mov_dpp(__builtin_bit_cast(int, v), 0x120 + N, 0xf, 0xf, true)); }
struct EpiUpConv {
    static constexpr bool PERM = true, AFTER_DRAIN = false;
    const float* cw; bf16_t* act; float* zedge; PG8_LAS float* xch;
    __device__ __forceinline__ void operator()(f32x4 (&acc)[2][2][4][2], const Unit& un, int wr, int wc, int fr, int fq) const {
        const int cb = wc * 32 + 8 * fq;
        scale_rows(acc, rstd, un.pm * BM + wr * 64 + fr);
        const int lprev = (fq << 4) | ((fr + 15) & 15), lnext = (fq << 4) | ((fr + 1) & 15);
#pragma unroll
        for (int ai = 0; ai < 2; ++ai) { const int b = 2 * ai + wr;
            if (fr == 0) {
#pragma unroll
                for (int bj = 0; bj < 2; ++bj)
#pragma unroll
                    for (int n = 0; n < 2; ++n) *(PG8_LAS f32x4*)(xch + ((b * 2 + 0) * 2 + bj) * 128 + cb + 4 * n) = acc[ai][bj][0][n]; }
            if (fr == 15) {
#pragma unroll
                for (int bj = 0; bj < 2; ++bj)
#pragma unroll
                    for (int n = 0; n < 2; ++n) *(PG8_LAS f32x4*)(xch + ((b * 2 + 1) * 2 + bj) * 128 + cb + 4 * n) = acc[ai][bj][3][n]; } }
        if (wr == 0 && fr < 2) { const unsigned zo = ((unsigned)(un.pm * 4 + fr) * 24576u + (unsigned)(un.pn * 256 + cb)) * 4u;
#pragma unroll
            for (int bj = 0; bj < 2; ++bj)
#pragma unroll
                for (int n = 0; n < 2; ++n) *(f32x4*)((char*)zedge + (size_t)(zo + (unsigned)(bj * 512 + 16 * n))) = acc[0][bj][0][n]; }
        if (wr == 1 && fr >= 14) { const unsigned zo = ((unsigned)(un.pm * 4 + 2 + (fr - 14)) * 24576u + (unsigned)(un.pn * 256 + cb)) * 4u;
#pragma unroll
            for (int bj = 0; bj < 2; ++bj)
#pragma unroll
                for (int n = 0; n < 2; ++n) *(f32x4*)((char*)zedge + (size_t)(zo + (unsigned)(bj * 512 + 16 * n))) = acc[1][bj][3][n]; }
        asm volatile("s_waitcnt lgkmcnt(0)" ::: "memory"); __builtin_amdgcn_s_barrier(); asm volatile("" ::: "memory");
        const int ch0 = un.pn * 128 + cb; const unsigned wo = (unsigned)ch0 * 4u;
        const unsigned ao0 = (((unsigned)un.pm * 192u + (unsigned)(un.pn * 2 + (wc >> 1))) * 16384u + (unsigned)((64 * wr + fr) * 64 + (wc & 1) * 32 + 8 * fq)) * 2u;
#pragma unroll
        for (int ai = 0; ai < 2; ++ai) { const int b = 2 * ai + wr;
            const PG8_LAS float* hpp = xch + (((b > 0 ? b - 1 : 0) * 2 + 1) * 2) * 128 + cb;
            const PG8_LAS float* hnp = xch + (((b < 3 ? b + 1 : 3) * 2 + 0) * 2) * 128 + cb;
            unsigned pkw[4][4];
#pragma unroll
            for (int nj = 0; nj < 4; ++nj) { const int n = nj >> 1, jp = nj & 1;
                float o[4][2];
                f32x2 wg[3], wv[3];
#pragma unroll
                for (int k = 0; k < 3; ++k) { wg[k] = *(const f32x2*)((const char*)(cw + k * 24576) + (size_t)wo + 8 * nj); wv[k] = *(const f32x2*)((const char*)(cw + k * 24576 + 12288) + (size_t)wo + 8 * nj); }
#pragma unroll
                for (int jj = 0; jj < 2; ++jj) { const int j = 2 * jp + jj;
                    float cg[4], cv[4];
#pragma unroll
                    for (int bj = 0; bj < 2; ++bj) {
                        float P[4], Nx[4];
#pragma unroll
                        for (int m = 0; m < 4; ++m) { P[m] = dpp_ror<1>(acc[ai][bj][m][n][j]); Nx[m] = dpp_ror<15>(acc[ai][bj][m][n][j]); }
                        const float hp = (b > 0) ? hpp[bj * 128 + 4 * n + j] : 0.f, hn = (b < 3) ? hnp[bj * 128 + 4 * n + j] : 0.f;
                        const float w0 = bj ? wv[0][jj] : wg[0][jj], w1 = bj ? wv[1][jj] : wg[1][jj], w2 = bj ? wv[2][jj] : wg[2][jj];
#pragma unroll
                        for (int m = 0; m < 4; ++m) {
                            const float up = (fr > 0) ? P[m] : (m > 0 ? P[m > 0 ? m - 1 : 0] : hp);
                            const float dn = (fr < 15) ? Nx[m] : (m < 3 ? Nx[m < 3 ? m + 1 : 3] : hn);
                            const float r = w0 * up + w1 * acc[ai][bj][m][n][j] + w2 * dn;
                            if (bj == 0) cg[m] = r; else cv[m] = r; }
                    }
#pragma unroll
                    for (int m = 0; m < 4; ++m) o[m][jj] = gelu_t(cg[m]) * cv[m];
                    __builtin_amdgcn_sched_barrier(0);
                }
#pragma unroll
                for (int m = 0; m < 4; ++m) pkw[m][nj] = cvt_pk_bf16(o[m][0], o[m][1]);
            }
#pragma unroll
            for (int m = 0; m < 4; ++m) { const int tr = 128 * ai + 64 * wr + 16 * m + fr;
                if (tr != 0 && tr != 255) *(u32x4*)((char*)act + (size_t)(ao0 + (unsigned)((128 * ai + 16 * m) * 128))) = (u32x4){pkw[m][0], pkw[m][1], pkw[m][2], pkw[m][3]}; }
            asm volatile("" ::: "memory");
        }
    }
    float* ztail;
    const float* rstd; const float* colscale;
    __device__ __forceinline__ void tail(int row, int pn, int c, float v0, float v1) const {
        { const float rs = rstd[row]; v0 *= rs; v1 *= rs; }
        if (colscale) { v0 *= colscale[pn * 256 + c]; v1 *= colscale[pn * 256 + 128 + c]; }
        float* z = ztail + (size_t)(row - 16384) * 24576 + pn * 256 + c; z[0] = v0; z[128] = v1;
    }
};

struct EpiUp8 {
    static constexpr bool PERM = true, AFTER_DRAIN = false;
    EpiUpConv e;
    __device__ __forceinline__ void operator()(f32x4 (&acc)[2][2][4][2], const Unit& un, int wr, int wc, int fr_, int fq_) const {
        int fr = fr_, fq = fq_; asm volatile("" : "+v"(fr), "+v"(fq));
        const int cb = wc * 32 + 8 * fq;
#pragma unroll
        for (int bj = 0; bj < 2; ++bj)
#pragma unroll
            for (int n = 0; n < 2; ++n) { const f32x4 cs = *(const f32x4*)(e.colscale + un.pn * 256 + bj * HALF + cb + 4 * n);
#pragma unroll
                for (int ai = 0; ai < 2; ++ai)
#pragma unroll
                    for (int m = 0; m < 4; ++m) { const i32x4 iv = __builtin_bit_cast(i32x4, acc[ai][bj][m][n]); acc[ai][bj][m][n] = (f32x4){(float)iv[0], (float)iv[1], (float)iv[2], (float)iv[3]} * cs; } }
        e(acc, un, wr, wc, fr, fq);
    }
    __device__ __forceinline__ void tail(int row, int pn, int c, float v0, float v1) const { e.tail(row, pn, c, v0, v1); }
};

template <class Epi, bool TB = false, bool I8 = false>
__device__ __forceinline__ void tail_gemm(PG8_LAS unsigned char* lds, const bf16_t* A  , const bf16_t* Bt, int N, int K, int row0, const Epi& E) {
    int tid_ = threadIdx.x; asm volatile("" : "+v"(tid_));
    const int tid = tid_, wid = __builtin_amdgcn_readfirstlane(tid >> 6), lane = tid & 63, r16 = lane & 15, q = lane >> 4;
    const int nitems = (N >> 8) * 8, kw = K >> 3, nks = kw >> 5;
    PG8_LAS f32x4* red = (PG8_LAS f32x4*)lds;
    for (int item = blockIdx.x; item < nitems; item += gridDim.x) {
        const int pn = item >> 3, s8 = item & 7;
        const bf16_t* ap = A + tix(row0 + r16, wid * kw, K) + 8 * q;
        const bf16_t* b0 = TB ? Bt + ((size_t)pn * (K >> 6) + ((wid * kw) >> 6)) * 16384 + (s8 * 16 + r16) * 64 + 8 * q : Bt + (size_t)(pn * 256 + s8 * 16 + r16) * K + wid * kw + 8 * q;
        const bf16_t* b1 = b0 + (TB ? (size_t)128 * 64 : (size_t)128 * K);
        f32x4 c0 = (f32x4){0.f, 0.f, 0.f, 0.f}, c1 = (f32x4){0.f, 0.f, 0.f, 0.f};
        int ks = 0;
        for (; ks + 8 <= nks; ks += 8) {
            bf16x8 a[8], x0[8], x1[8];
#pragma unroll
            for (int i = 0; i < 8; ++i) { a[i] = *(const bf16x8*)(ap + ((ks + i) >> 1) * 16384 + ((ks + i) & 1) * 32); const int ko = TB ? ((ks + i) >> 1) * 16384 + ((ks + i) & 1) * 32 : (ks + i) * 32; x0[i] = *(const bf16x8*)(b0 + ko); x1[i] = *(const bf16x8*)(b1 + ko); }
#pragma unroll
            for (int i = 0; i < 8; ++i) { if constexpr (I8) { c0 = __builtin_bit_cast(f32x4, __builtin_amdgcn_mfma_i32_16x16x64_i8(__builtin_bit_cast(i32x4, a[i]), __builtin_bit_cast(i32x4, x0[i]), __builtin_bit_cast(i32x4, c0), 0, 0, 0)); c1 = __builtin_bit_cast(f32x4, __builtin_amdgcn_mfma_i32_16x16x64_i8(__builtin_bit_cast(i32x4, a[i]), __builtin_bit_cast(i32x4, x1[i]), __builtin_bit_cast(i32x4, c1), 0, 0, 0)); } else { c0 = __builtin_amdgcn_mfma_f32_16x16x32_bf16(a[i], x0[i], c0, 0, 0, 0); c1 = __builtin_amdgcn_mfma_f32_16x16x32_bf16(a[i], x1[i], c1, 0, 0, 0); } }
        }
        for (; ks < nks; ks += 4) {
            bf16x8 a[4], x0[4], x1[4];
#pragma unroll
            for (int i = 0; i < 4; ++i) { a[i] = *(const bf16x8*)(ap + ((ks + i) >> 1) * 16384 + ((ks + i) & 1) * 32); const int ko = TB ? ((ks + i) >> 1) * 16384 + ((ks + i) & 1) * 32 : (ks + i) * 32; x0[i] = *(const bf16x8*)(b0 + ko); x1[i] = *(const bf16x8*)(b1 + ko); }
#pragma unroll
            for (int i = 0; i < 4; ++i) { if constexpr (I8) { c0 = __builtin_bit_cast(f32x4, __builtin_amdgcn_mfma_i32_16x16x64_i8(__builtin_bit_cast(i32x4, a[i]), __builtin_bit_cast(i32x4, x0[i]), __builtin_bit_cast(i32x4, c0), 0, 0, 0)); c1 = __builtin_bit_cast(f32x4, __builtin_amdgcn_mfma_i32_16x16x64_i8(__builtin_bit_cast(i32x4, a[i]), __builtin_bit_cast(i32x4, x1[i]), __builtin_bit_cast(i32x4, c1), 0, 0, 0)); } else { c0 = __builtin_amdgcn_mfma_f32_16x16x32_bf16(a[i], x0[i], c0, 0, 0, 0); c1 = __builtin_amdgcn_mfma_f32_16x16x32_bf16(a[i], x1[i], c1, 0, 0, 0); } }
        }
        if constexpr (I8) { const i32x4 i0 = __builtin_bit_cast(i32x4, c0), i1 = __builtin_bit_cast(i32x4, c1); c0 = (f32x4){(float)i0[0], (float)i0[1], (float)i0[2], (float)i0[3]}; c1 = (f32x4){(float)i1[0], (float)i1[1], (float)i1[2], (float)i1[3]}; }
        red[(wid * 2 + 0) * 64 + lane] = c0; red[(wid * 2 + 1) * 64 + lane] = c1;
        asm volatile("s_waitcnt lgkmcnt(0)" ::: "memory"); __builtin_amdgcn_s_barrier(); asm volatile("" ::: "memory");
        if (tid < 256) {
            const int row = tid >> 4, col = tid & 15, sl = col + 16 * (row >> 2), el = row & 3; float v0 = 0.f, v1 = 0.f;
#pragma unroll
            for (int w = 0; w < 8; ++w) { v0 += ((const PG8_LAS float*)(red + (w * 2 + 0) * 64 + sl))[el]; v1 += ((const PG8_LAS float*)(red + (w * 2 + 1) * 64 + sl))[el]; }
            E.tail(row0 + row, pn, s8 * 16 + col, v0, v1);
        }
        asm volatile("s_waitcnt lgkmcnt(0)" ::: "memory"); __builtin_amdgcn_s_barrier(); asm volatile("" ::: "memory");
    }
}
template <class Epi, class Sched, bool ALIGN_EPI = false, bool SP2 = false, bool TA = false, bool TB = false, bool I8 = false>
__device__ __forceinline__ void gemm_phase(PG8_LAS unsigned char* lds, const Gemm g, const Sched& S, const Epi& E) {
    int tid_ = threadIdx.x; asm volatile("" : "+v"(tid_));
    const int tid = tid_, wid = __builtin_amdgcn_readfirstlane(tid >> 6), lane = tid & 63, wr = wid >> 2, wc = wid & 3, fr = lane & 15, fq = lane >> 4;
    const int K = g.K, nt = K / BK;
    unsigned voffA[2], voffB[2];
#pragma unroll
    for (int i = 0; i < 2; ++i) { int R, C; stage_rc(tid * 16 + i * 8192, R, C); const int Rb = Epi::PERM ? ((R & ~31) + perm32(R & 31)) : R;
        voffA[i] = (unsigned)(R * (TA ? 64 : K) + C) * 2u; voffB[i] = (unsigned)(Rb * (TB ? 64 : K) + C) * 2u; }
    const size_t kstepA = TA ? (size_t)(BM * BK * 2) : (size_t)(BK * 2), kstepB = TB ? (size_t)(BM * BK * 2) : (size_t)(BK * 2);
    const size_t hstepA = TA ? (size_t)(HALF * BK * 2) : (size_t)HALF * K * 2, hstepB = TB ? (size_t)(HALF * BK * 2) : (size_t)HALF * K * 2;
    const size_t tstep = (size_t)BM * K * 2;
    const unsigned ldsw = (unsigned)wid * 1024u;
    const int aoff = lds_byte(wr * 64 + fr, fq * 8), boff = lds_byte(wc * 32 + fr, fq * 8);
#define PG8_SA(b, h) (((b) * 2 + (h)) * HTB)
#define PG8_SB(b, h) ((4 + (b) * 2 + (h)) * HTB)
#define PG8_STAGE(bufoff, gbase, voff) do { _Pragma("unroll") for (int _i = 0; _i < 2; ++_i) \
        __builtin_amdgcn_global_load_lds((const unsigned*)((const char*)(gbase) + (voff)[_i]), (PG8_LAS unsigned*)(lds + (bufoff) + ldsw + _i * 8192), 16, 0, 0); } while (0)
#define PG8_LDA(dst, b, h) do { _Pragma("unroll") for (int m = 0; m < 4; ++m) _Pragma("unroll") for (int k = 0; k < 2; ++k) dst[m][k] = *(const PG8_LAS bf16x8*)(lds + PG8_SA(b, h) + aoff + m * 2048 + k * 1024); } while (0)
#define PG8_LDB(dst, b, h) do { _Pragma("unroll") for (int n = 0; n < 2; ++n) _Pragma("unroll") for (int k = 0; k < 2; ++k) dst[n][k] = *(const PG8_LAS bf16x8*)(lds + PG8_SB(b, h) + boff + n * 2048 + k * 1024); } while (0)
#define PG8_MMA(ai, bj, At, Bt) do { __builtin_amdgcn_s_setprio(1); _Pragma("unroll") for (int m = 0; m < 4; ++m) _Pragma("unroll") for (int n = 0; n < 2; ++n) _Pragma("unroll") for (int k = 0; k < 2; ++k) \
        { if constexpr (I8) acc[ai][bj][m][n] = __builtin_bit_cast(f32x4, __builtin_amdgcn_mfma_i32_16x16x64_i8(__builtin_bit_cast(i32x4, Bt[n][k]), __builtin_bit_cast(i32x4, At[m][k]), __builtin_bit_cast(i32x4, acc[ai][bj][m][n]), 0, 0, 0)); \
          else acc[ai][bj][m][n] = __builtin_amdgcn_mfma_f32_16x16x32_bf16(Bt[n][k], At[m][k], acc[ai][bj][m][n], 0, 0, 0); } __builtin_amdgcn_s_setprio(0); } while (0)
#define PG8_WAIT_V(n) asm volatile("s_waitcnt vmcnt(" #n ")" ::: "memory")
#define PG8_WAIT_L(n) asm volatile("s_waitcnt lgkmcnt(" #n ")" ::: "memory")
#define PG8_BAR __builtin_amdgcn_s_barrier()
#define PG8_SCHED __builtin_amdgcn_sched_barrier(0)
    Unit cur, nxt; int ui = 0;
    if (!S.next(0, cur)) return;
    f32x4 acc[2][2][4][2];
#pragma unroll
    for (int a = 0; a < 2; ++a)
#pragma unroll
        for (int b = 0; b < 2; ++b)
#pragma unroll
            for (int m = 0; m < 4; ++m)
#pragma unroll
                for (int n = 0; n < 2; ++n) acc[a][b][m][n] = (f32x4){0.f, 0.f, 0.f, 0.f};
    bf16x8 At[4][2], B0[2][2], B1[2][2];
    const char* cA = (const char*)g.A + (size_t)cur.pm * tstep; const char* cB = (const char*)g.Bt + (size_t)cur.pn * tstep;
    S.a_ready(cur);
    if constexpr (SP2) {
        PG8_STAGE(PG8_SB(0, 0), cB, voffB); PG8_STAGE(PG8_SB(0, 1), cB + hstepB, voffB); PG8_STAGE(PG8_SA(0, 0), cA, voffA); PG8_STAGE(PG8_SA(0, 1), cA + hstepA, voffA);
        if (wr == 1) PG8_BAR;
        PG8_WAIT_V(2); PG8_BAR;
        PG8_STAGE(PG8_SB(1, 0), cB + kstepB, voffB); PG8_STAGE(PG8_SA(1, 0), cA + kstepA, voffA); PG8_STAGE(PG8_SB(1, 1), cB + hstepB + kstepB, voffB);
        PG8_WAIT_V(6); PG8_BAR;
    } else {
        PG8_STAGE(PG8_SB(0, 0), cB, voffB); PG8_STAGE(PG8_SA(0, 0), cA, voffA); PG8_STAGE(PG8_SB(0, 1), cB + hstepB, voffB); PG8_STAGE(PG8_SA(0, 1), cA + hstepA, voffA);
        if (wr == 1) PG8_BAR;
        PG8_WAIT_V(4); PG8_BAR;
        PG8_STAGE(PG8_SB(1, 0), cB + kstepB, voffB); PG8_STAGE(PG8_SA(1, 0), cA + kstepA, voffA); PG8_STAGE(PG8_SB(1, 1), cB + hstepB + kstepB, voffB);
        PG8_WAIT_V(6); PG8_BAR;
    }
    for (;;) {
        const bool has_next = S.next(ui + 1, nxt);
        const char* nA = has_next ? (const char*)g.A + (size_t)nxt.pm * tstep : cA; const char* nB = has_next ? (const char*)g.Bt + (size_t)nxt.pn * tstep : cB;
        for (int t = 0; t < nt; t += 2) {
            const bool last = (t == nt - 2);
            const char* a1 = cA + (size_t)(t + 1) * kstepA;
            const char* a2 = last ? nA : cA + (size_t)(t + 2) * kstepA; const char* b2 = last ? nB : cB + (size_t)(t + 2) * kstepB;
            const char* a3 = a2 + kstepA; const char* b3 = b2 + kstepB;
            if (last && has_next) S.a_ready(nxt);
            if constexpr (SP2) {
            PG8_LDB(B0, 0, 0); PG8_LDB(B1, 0, 1); PG8_SCHED; PG8_LDA(At, 0, 0); PG8_STAGE(PG8_SA(1, 1), a1 + hstepA, voffA);
            PG8_WAIT_V(8); PG8_WAIT_L(0); PG8_BAR; PG8_MMA(0, 0, At, B0); PG8_MMA(0, 1, At, B1); PG8_BAR; PG8_SCHED;
            PG8_LDA(At, 0, 1); PG8_STAGE(PG8_SB(0, 0), b2, voffB); PG8_STAGE(PG8_SB(0, 1), b2 + hstepB, voffB); PG8_STAGE(PG8_SA(0, 0), a2, voffA);
            PG8_WAIT_V(8); PG8_WAIT_L(0); PG8_BAR; PG8_MMA(1, 0, At, B0); PG8_MMA(1, 1, At, B1); PG8_BAR; PG8_SCHED;
            PG8_LDB(B0, 1, 0); PG8_LDB(B1, 1, 1); PG8_SCHED; PG8_LDA(At, 1, 0); PG8_STAGE(PG8_SA(0, 1), a2 + hstepA, voffA);
            PG8_WAIT_V(8); PG8_WAIT_L(0); PG8_BAR; PG8_MMA(0, 0, At, B0); PG8_MMA(0, 1, At, B1); PG8_BAR; PG8_SCHED;
            PG8_LDA(At, 1, 1); PG8_STAGE(PG8_SB(1, 0), b3, voffB); PG8_STAGE(PG8_SB(1, 1), b3 + hstepB, voffB); PG8_STAGE(PG8_SA(1, 0), a3, voffA);
            PG8_WAIT_V(8); PG8_WAIT_L(0); PG8_BAR; PG8_MMA(1, 0, At, B0); PG8_MMA(1, 1, At, B1); PG8_BAR; PG8_SCHED;
            } else {
            PG8_LDB(B0, 0, 0); PG8_SCHED; PG8_LDA(At, 0, 0); PG8_STAGE(PG8_SA(1, 1), a1 + hstepA, voffA);
            PG8_WAIT_L(8); PG8_BAR; PG8_WAIT_L(0); PG8_MMA(0, 0, At, B0); PG8_BAR; PG8_SCHED;
            PG8_LDB(B1, 0, 1); PG8_STAGE(PG8_SB(0, 0), b2, voffB);
            PG8_BAR; PG8_WAIT_L(0); PG8_MMA(0, 1, At, B1); PG8_BAR;
            PG8_LDA(At, 0, 1); PG8_STAGE(PG8_SA(0, 0), a2, voffA);
            PG8_BAR; PG8_WAIT_L(0); PG8_MMA(1, 0, At, B0); PG8_BAR; PG8_SCHED;
            PG8_STAGE(PG8_SB(0, 1), b2 + hstepB, voffB);
            PG8_WAIT_V(6); PG8_BAR; PG8_MMA(1, 1, At, B1); PG8_BAR;
            PG8_LDB(B0, 1, 0); PG8_SCHED; PG8_LDA(At, 1, 0); PG8_STAGE(PG8_SA(0, 1), a2 + hstepA, voffA);
            PG8_WAIT_L(8); PG8_BAR; PG8_WAIT_L(0); PG8_MMA(0, 0, At, B0); PG8_BAR; PG8_SCHED;
            PG8_LDB(B1, 1, 1); PG8_STAGE(PG8_SB(1, 0), b3, voffB);
            PG8_BAR; PG8_WAIT_L(0); PG8_MMA(0, 1, At, B1); PG8_BAR;
            PG8_LDA(At, 1, 1); PG8_STAGE(PG8_SA(1, 0), a3, voffA);
            PG8_BAR; PG8_WAIT_L(0); PG8_MMA(1, 0, At, B0); PG8_BAR; PG8_SCHED;
            PG8_STAGE(PG8_SB(1, 1), b3 + hstepB, voffB);
            PG8_WAIT_V(6); PG8_BAR; PG8_MMA(1, 1, At, B1); PG8_BAR;
            }
        }
        if constexpr (ALIGN_EPI) { if (wr == 0) PG8_BAR; }
        if constexpr (I8) asm volatile("s_nop 15\n\ts_nop 15\n\ts_nop 15\n\ts_nop 15" ::: "memory");
        if constexpr (!Epi::AFTER_DRAIN) { E(acc, cur, wr, wc, fr, fq); S.done(cur); }
        if (!has_next) break;
#pragma unroll
        for (int a = 0; a < 2; ++a)
#pragma unroll
            for (int b = 0; b < 2; ++b)
#pragma unroll
                for (int m = 0; m < 4; ++m)
#pragma unroll
                    for (int n = 0; n < 2; ++n) acc[a][b][m][n] = (f32x4){0.f, 0.f, 0.f, 0.f};
        cur = nxt; cA = nA; cB = nB; ++ui;
        if constexpr (ALIGN_EPI) { if (wr == 1) PG8_BAR; }
    }
    PG8_WAIT_V(0);
    if constexpr (!ALIGN_EPI) { if (wr == 0) PG8_BAR; }
    PG8_BAR;
    if constexpr (Epi::AFTER_DRAIN) { E.fused(acc, cur, wr, wc, fr, fq, lds, wid, lane); S.done(cur); }
#undef PG8_SA
#undef PG8_SB
#undef PG8_STAGE
#undef PG8_LDA
#undef PG8_LDB
#undef PG8_MMA
#undef PG8_WAIT_V
#undef PG8_WAIT_L
#undef PG8_BAR
#undef PG8_SCHED
}
}

#ifndef MK_N_LAUNCHES
#define MK_N_LAUNCHES 1
#endif
constexpr int NWAVES = 8;
constexpr int DM = 4096, SEQ = 16384, NMETA = 16, LTOK = SEQ + NMETA, MP = 16640, MG = 16384;
constexpr int DC = 2048, DSS = 1024, NG = 64, DFF = 12288, NIN = 15360;
constexpr float EPS = 1e-6f;
#ifndef MK_WTILED
#define MK_WTILED 1
#endif
constexpr bool WTILED = MK_WTILED;
constexpr int NPH = 24;
constexpr int NSEG = 16, SEGLEN = 1056, CHT = 32, NCH = SEGLEN / CHT, XROW = 528, XBUF = CHT * XROW;

constexpr size_t MiB = 1u << 20;
constexpr size_t WS_CTL = 0, CTL_ZERO_BYTES = 1 * MiB;
constexpr size_t WS_RSTD = 6 * MiB;
constexpr size_t WS_RS8 = WS_RSTD + 128 * 1024;
constexpr size_t WS_CS8 = WS_RSTD + 256 * 1024;
constexpr size_t WS_ABAR = 1 * MiB;
constexpr size_t WS_ASEG = WS_ABAR + 256 * 1024;
constexpr size_t WS_BBT = 2 * MiB;
constexpr size_t WS_CCT = 3 * MiB;
constexpr size_t WS_E = 4 * MiB;
constexpr size_t WS_W = 8 * MiB;
constexpr size_t W_IN = 0, W_A = 120 * MiB, W_GLU = 136 * MiB, W_OUT = 152 * MiB, W_UP = 184 * MiB, W_DOWN = 376 * MiB, W_LAYER = 472 * MiB;
constexpr size_t WS_HRES = WS_W + 2 * W_LAYER;
constexpr size_t WS_HB8 = WS_HRES;
constexpr size_t WS_WG8 = WS_HRES + 128 * MiB;
constexpr size_t WS_H = WS_HRES + 260 * MiB;
constexpr size_t WS_R = WS_H + 130 * MiB;
constexpr size_t R_BG = 0, R_CV = 65 * MiB, R_U = 130 * MiB, R_GA = 130 * MiB + 32 * MiB + MiB / 2, R_GB = R_GA + 130 * MiB, R_AIN = R_GB + 130 * MiB, R_S = R_AIN + 65 * MiB,
                 R_M = R_S + 32 * MiB + MiB / 2, R_YF = R_M + 130 * MiB, R_YB = R_YF + 65 * MiB, R_END = R_YB + 65 * MiB;
static_assert(R_END == 780 * MiB, "overlay map");
constexpr size_t WS_ACT = WS_R + 780 * MiB;
constexpr size_t WS_DLT = WS_ACT + 390 * MiB;
constexpr size_t WS_END = WS_DLT + 260 * MiB;
static_assert((size_t)MP * 24576 * 2 == 780 * MiB && (size_t)MP * 4096 * 4 == 260 * MiB && (size_t)MP * 12288 * 2 == 390 * MiB, "sizes");

constexpr int LDS_BYTES = 147456, LDSCTL_OFF = 146944;
static_assert(NWAVES * XBUF <= LDSCTL_OFF && NWAVES * 16640 <= LDSCTL_OFF && 131072 + 8192 <= LDSCTL_OFF, "LDS map");

#define GAS __attribute__((address_space(1)))
#define LAS __attribute__((address_space(3)))
typedef unsigned short bf16;
typedef unsigned v4u __attribute__((ext_vector_type(4)));
typedef unsigned v2u __attribute__((ext_vector_type(2)));
typedef float f32x4 __attribute__((ext_vector_type(4)));
typedef float f32x2 __attribute__((ext_vector_type(2)));
typedef float f32x16 __attribute__((ext_vector_type(16)));
typedef short bf16x8 __attribute__((ext_vector_type(8)));
#define LDS_WAIT() asm volatile("s_waitcnt lgkmcnt(0)" ::: "memory")
#define VM_WAIT() asm volatile("s_waitcnt vmcnt(0)" ::: "memory")
__device__ __forceinline__ unsigned pk2(float lo, float hi) { return pg8::cvt_pk_bf16(lo, hi); }
__device__ __forceinline__ float bf_lo(unsigned w) { return __uint_as_float(w << 16); }
__device__ __forceinline__ float bf_hi(unsigned w) { return __uint_as_float(w & 0xffff0000u); }
__device__ __forceinline__ void unpack8(v4u w, float (&f)[8]) { f[0] = bf_lo(w.x); f[1] = bf_hi(w.x); f[2] = bf_lo(w.y); f[3] = bf_hi(w.y); f[4] = bf_lo(w.z); f[5] = bf_hi(w.z); f[6] = bf_lo(w.w); f[7] = bf_hi(w.w); }
__device__ __forceinline__ unsigned short f2bf1(float f) { unsigned u = __float_as_uint(f); return (unsigned short)((u + 0x7fffu + ((u >> 16) & 1u)) >> 16); }
__device__ __forceinline__ float fma_s(float a, float b, float c) { float r; asm("v_fma_f32 %0, %1, %2, %3" : "=v"(r) : "v"(a), "v"(b), "v"(c)); return r; }
__device__ __forceinline__ float wave_sum(float v) {
#pragma unroll
    for (int o = 1; o < 64; o <<= 1) v += __shfl_xor(v, o);
    return v;
}

#define XB_TMO      128
#define XB_XCNT(j)  (256  + 64 * (j))
#define XB_XSUB(j)  (1280 + 64 * (j))
#define XB_XGEN(j)  (2304 + 64 * (j))
#define XB_TOP      3328
#define XB_TOPGEN   3392
#define XCD_BAR_WORDS 3456
#define XB_SPIN_CAP (1u << 18)

__device__ __forceinline__ unsigned xb_ld(unsigned* p)              { return __hip_atomic_load(p, __ATOMIC_RELAXED, __HIP_MEMORY_SCOPE_AGENT); }
__device__ __forceinline__ unsigned xb_add(unsigned* p, unsigned v) { return __hip_atomic_fetch_add(p, v, __ATOMIC_RELAXED, __HIP_MEMORY_SCOPE_AGENT); }
__device__ __forceinline__ unsigned xb_xcc_id() { return (unsigned)__builtin_amdgcn_s_getreg((3 << 11) | 20) & 0xFu; }
#define XB_SPIN(cond, bar) do { unsigned _sp = 0; while (cond) { __builtin_amdgcn_s_sleep(1); \
    if ((++_sp & 255u) == 0u) { if (xb_ld(&(bar)[XB_TMO])) break; if (_sp > XB_SPIN_CAP) { atomicAdd(&(bar)[XB_TMO], 1u); break; } } } } while (0)

struct XcdBarrier {
    unsigned* bar; unsigned x;
    volatile LAS unsigned* st;
};

__device__ __forceinline__ XcdBarrier xcd_barrier_post(unsigned* bar, volatile LAS unsigned* st) {
    XcdBarrier b; b.bar = bar; b.x = xb_xcc_id(); b.st = st;
    if (threadIdx.x == 0) (void)xb_add(&bar[XB_XCNT(b.x)], 1u);
    return b;
}
__device__ __forceinline__ void xcd_barrier_complete(unsigned* bar, unsigned x, unsigned& nloc, unsigned& nx) {
    const unsigned G = gridDim.x * gridDim.y * gridDim.z;
    unsigned sum, cnt, mine, sp = 0u;
    for (;;) {
        sum = 0u; cnt = 0u; mine = 0u;
#pragma unroll
        for (unsigned j = 0; j < 16; ++j) { const unsigned c = xb_ld(&bar[XB_XCNT(j)]); sum += c; cnt += (c > 0u) ? 1u : 0u; mine = (j == x) ? c : mine; }
        if (sum == G) break;
        __builtin_amdgcn_s_sleep(1);
        if ((++sp & 255u) == 0u) { if (xb_ld(&bar[XB_TMO])) break; if (sp > XB_SPIN_CAP) { atomicAdd(&bar[XB_TMO], 1u); break; } }
    }
    nloc = mine > 0u ? mine : 1u; nx = cnt > 0u ? cnt : 1u;
}

__device__ __forceinline__ void xcd_barrier(const XcdBarrier& b) {
    asm volatile("s_waitcnt vmcnt(0)" ::: "memory");
    __syncthreads();
    if (threadIdx.x == 0) {
        unsigned* bar = b.bar;
        __builtin_amdgcn_s_waitcnt(0);
        unsigned nloc = b.st[0], nx = b.st[1];
        if (nloc == 0u) { xcd_barrier_complete(bar, b.x, nloc, nx); b.st[0] = nloc; b.st[1] = nx; }
        const unsigned old = xb_add(&bar[XB_XSUB(b.x)], 1u);
        const unsigned gen = old / nloc;
        if (old + 1u == (gen + 1u) * nloc) {
            __builtin_amdgcn_fence(__ATOMIC_RELEASE, "agent");
            asm volatile("s_waitcnt vmcnt(0)" ::: "memory");
            const unsigned og = xb_add(&bar[XB_TOP], 1u);
            const unsigned tg = og / nx;
            if (og + 1u == (tg + 1u) * nx) xb_add(&bar[XB_TOPGEN], 1u);
            else XB_SPIN(xb_ld(&bar[XB_TOPGEN]) == tg, bar);
            __builtin_amdgcn_fence(__ATOMIC_ACQUIRE, "agent");
            xb_add(&bar[XB_XGEN(b.x)], 1u);
            asm volatile("s_waitcnt vmcnt(0)" ::: "memory");
        } else {
            XB_SPIN(xb_ld(&bar[XB_XGEN(b.x)]) == gen, bar);
            __builtin_amdgcn_fence(__ATOMIC_ACQUIRE, "agent");
            asm volatile("s_waitcnt vmcnt(0)" ::: "memory");
        }
    }
    __syncthreads();
}


__device__ __forceinline__ int dest_row(int mode, int N, int n) {
    if (mode == 1) {
        if (n < 2048 || n >= 6144) return n;
        if (n < 4096) { const int c = n - 2048; return 2048 + (c >> 7) * 256 + (c & 127); }
        const int c = n - 4096; return 2048 + (c >> 7) * 256 + 128 + (c & 127);
    }
    if (mode == 2) {
        const int h = N >> 1; if (n < h) return (n >> 7) * 256 + (n & 127);
        const int c = n - h; return (c >> 7) * 256 + 128 + (c & 127);
    }
    return n;
}
__device__ __forceinline__ void convert_matrix(const float* W, const float* kgain  , int K, int N, bf16* WT, int mode, LAS float* scr, int gw, int ngw, int lane, int ncols = 0  ) {
    const int nblk = (ncols ? ncols : N) >> 6, nitems = (K >> 6) * nblk;
    for (int it = gw; it < nitems; it += ngw) {
        const int kb = it / nblk, nb = it - kb * nblk, k0 = kb << 6, n0 = nb << 6;
        const int nn = 4 * (lane & 15), kq = lane >> 4;
        f32x4 v[16];
#pragma unroll
        for (int i = 0; i < 16; ++i) { v[i] = *(const GAS f32x4*)(W + (size_t)(k0 + 4 * i + kq) * N + n0 + nn); if (kgain) v[i] = v[i] * kgain[k0 + 4 * i + kq]; }
        if (mode == 2 && n0 >= (N >> 1)) {
#pragma unroll
            for (int i = 0; i < 16; ++i) v[i] = v[i] * -1.44269504089f; }
#pragma unroll
        for (int i = 0; i < 16; ++i) { const int kk = 4 * i + kq;
            scr[(nn + 0) * 65 + kk] = v[i].x; scr[(nn + 1) * 65 + kk] = v[i].y; scr[(nn + 2) * 65 + kk] = v[i].z; scr[(nn + 3) * 65 + kk] = v[i].w; }
        LDS_WAIT();
        const int drow = dest_row(mode, N, n0); const int c = lane & 7;
#pragma unroll
        for (int jr = 0; jr < 8; ++jr) { const int n = 8 * jr + (lane >> 3); const LAS float* s = scr + n * 65 + 8 * c;
            v4u o; o.x = pk2(s[0], s[1]); o.y = pk2(s[2], s[3]); o.z = pk2(s[4], s[5]); o.w = pk2(s[6], s[7]);
            if (WTILED) *(GAS v4u*)(WT + ((size_t)((drow + n) >> 8) * (K >> 6) + kb) * 16384 + ((drow + n) & 255) * 64 + 8 * c) = o;
            else *(GAS v4u*)(WT + (size_t)(drow + n) * K + k0 + 8 * c) = o; }
        LDS_WAIT();
    }
}
__device__ __forceinline__ void sincos_d(double x, double& s, double& c) {
    const double k = rint(x * 0.15915494309189535); double r = fma(-k, 6.283185307179586, x); r = fma(-k, 2.4492935982947064e-16, r);
    const double r2 = r * r; double ss = 1.0, cc = 1.0;
#pragma unroll
    for (int n = 17; n >= 1; --n) { ss = 1.0 - ss * r2 / (double)((2 * n) * (2 * n + 1)); cc = 1.0 - cc * r2 / (double)((2 * n - 1) * (2 * n)); }
    s = r * ss; c = cc;
}
__device__ __forceinline__ void scan_params(int idx, const float* lre_, const float* lim_, const float* lst_, const float* bre_, const float* bim_, const float* cre_, const float* cim_,
                                            f32x2* abar, f32x2* aseg, bf16* BBt, bf16* CCt) {
    const int p = idx & 63, ldg = idx >> 6;
    const double lre = (double)lre_[idx], lim = (double)lim_[idx], dt = exp((double)lst_[ldg]);
    const double mag = exp(lre * dt), ang = lim * dt; double sn, cs; sincos_d(ang, sn, cs);
    const double ar = mag * cs, ai = mag * sn, nr = ar - 1.0, ni = ai, den = lre * lre + lim * lim;
    const double fre = (nr * lre + ni * lim) / den, fim = (ni * lre - nr * lim) / den;
    abar[idx] = (f32x2){(float)ar, (float)ai};
    { const double magn = exp(lre * dt * (double)SEGLEN); double s2, c2; sincos_d(ang * (double)SEGLEN, s2, c2); aseg[idx] = (f32x2){(float)(magn * c2), (float)(magn * s2)}; }
    for (int h = 0; h < 16; ++h) {
        const double br = (double)bre_[(size_t)idx * 16 + h], bi = (double)bim_[(size_t)idx * 16 + h];
        BBt[((size_t)ldg * 128 + p) * 16 + h] = f2bf1((float)(fre * br - fim * bi));
        BBt[((size_t)ldg * 128 + 64 + p) * 16 + h] = f2bf1((float)(fre * bi + fim * br));
        const float cr = cre_[((size_t)ldg * 16 + h) * 64 + p], ci = cim_[((size_t)ldg * 16 + h) * 64 + p];
        CCt[((size_t)ldg * 16 + h) * 128 + 2 * p] = f2bf1(cr);
        CCt[((size_t)ldg * 16 + h) * 128 + 2 * p + 1] = f2bf1(-ci);
    }
}
__device__ __forceinline__ float quant_row8(const f32x4 (&v)[16], signed char* q8, int r, int lane) {
    float mx = 0.f;
#pragma unroll
    for (int j = 0; j < 16; ++j) mx = fmaxf(fmaxf(mx, fmaxf(fabsf(v[j].x), fabsf(v[j].y))), fmaxf(fabsf(v[j].z), fabsf(v[j].w)));
#pragma unroll
    for (int o = 1; o < 64; o <<= 1) mx = fmaxf(mx, __shfl_xor(mx, o));
    mx = fmaxf(mx, 1e-20f); const float sc = 127.0f / mx;
    signed char* rowp = q8 + ((size_t)(r >> 8) * 32 + (lane >> 5)) * 32768 + (size_t)((r & 255) * 128 + 4 * (lane & 31));
#pragma unroll
    for (int j = 0; j < 16; ++j) { const int a = (int)rintf(v[j].x * sc), b = (int)rintf(v[j].y * sc), c = (int)rintf(v[j].z * sc), d = (int)rintf(v[j].w * sc);
        *(GAS unsigned*)(rowp + (size_t)j * 65536) = (unsigned)(a & 255) | ((unsigned)(b & 255) << 8) | ((unsigned)(c & 255) << 16) | ((unsigned)d << 24); }
    return mx * (1.0f / 127.0f);
}
__device__ __forceinline__ float quant_row8w(const float (&v)[8][8], signed char* q8, int r, int lane) {
    float mx = 0.f;
#pragma unroll
    for (int j = 0; j < 8; ++j)
#pragma unroll
        for (int e = 0; e < 8; ++e) mx = fmaxf(mx, fabsf(v[j][e]));
#pragma unroll
    for (int o = 1; o < 64; o <<= 1) mx = fmaxf(mx, __shfl_xor(mx, o));
    mx = fmaxf(mx, 1e-20f); const float sc = 127.0f / mx;
    signed char* rowp = q8 + ((size_t)(r >> 8) * 32 + (lane >> 4)) * 32768 + (size_t)((r & 255) * 128 + 8 * (lane & 15));
#pragma unroll
    for (int j = 0; j < 8; ++j) { v2u w;
        { const int a = (int)rintf(v[j][0] * sc), b = (int)rintf(v[j][1] * sc), c = (int)rintf(v[j][2] * sc), d = (int)rintf(v[j][3] * sc); w.x = (unsigned)(a & 255) | ((unsigned)(b & 255) << 8) | ((unsigned)(c & 255) << 16) | ((unsigned)d << 24); }
        { const int a = (int)rintf(v[j][4] * sc), b = (int)rintf(v[j][5] * sc), c = (int)rintf(v[j][6] * sc), d = (int)rintf(v[j][7] * sc); w.y = (unsigned)(a & 255) | ((unsigned)(b & 255) << 8) | ((unsigned)(c & 255) << 16) | ((unsigned)d << 24); }
        *(GAS v2u*)(rowp + (size_t)j * 4 * 32768) = w; }
    return mx * (1.0f / 127.0f);
}
__device__ __forceinline__ float quant_row8x(const float (&v)[4][16], signed char* q8, int r, int lane) {
    float mx = 0.f;
#pragma unroll
    for (int j = 0; j < 4; ++j)
#pragma unroll
        for (int e = 0; e < 16; ++e) mx = fmaxf(mx, fabsf(v[j][e]));
#pragma unroll
    for (int o = 1; o < 64; o <<= 1) mx = fmaxf(mx, __shfl_xor(mx, o));
    mx = fmaxf(mx, 1e-20f); const float sc = 127.0f / mx;
    signed char* rowp = q8 + ((size_t)(r >> 8) * 32 + (lane >> 3)) * 32768 + (size_t)((r & 255) * 128 + 16 * (lane & 7));
#pragma unroll
    for (int j = 0; j < 4; ++j) { v4u w;
#pragma unroll
        for (int q = 0; q < 4; ++q) { const int a = (int)rintf(v[j][4 * q] * sc), b = (int)rintf(v[j][4 * q + 1] * sc), c = (int)rintf(v[j][4 * q + 2] * sc), d = (int)rintf(v[j][4 * q + 3] * sc);
            w[q] = (unsigned)(a & 255) | ((unsigned)(b & 255) << 8) | ((unsigned)(c & 255) << 16) | ((unsigned)d << 24); }
        *(GAS v4u*)(rowp + (size_t)j * 8 * 32768) = w; }
    return mx * (1.0f / 127.0f);
}
__device__ __forceinline__ void weights_i8(LAS unsigned char* lds, const float* Win  , int ldw, const float* kgain, signed char* W8, float* cscale, int n0  , int d0  , int wave, int lane, int tid, float csmul = 1.0f  ) {
    LAS float* cmx = (LAS float*)lds;
    const int cq = lane & 7, kq = lane >> 3;
    const float* src = Win + (size_t)(wave * 512 + 16 * kq) * ldw + n0 + 4 * cq;
    const float* gp = kgain + wave * 512 + 16 * kq;
    unsigned pk[16][8];
    f32x4 mx = {0.f, 0.f, 0.f, 0.f};
#pragma unroll
    for (int s = 0; s < 16; ++s) {
        f32x4 v[4];
        const f32x4 g4 = *(const GAS f32x4*)(gp + 128 * (s >> 2) + 4 * (s & 3));
#pragma unroll
        for (int r = 0; r < 4; ++r) v[r] = *(const GAS f32x4*)(src + (size_t)(128 * (s >> 2) + 4 * (s & 3) + r) * ldw) * g4[r];
#pragma unroll
        for (int j = 0; j < 4; ++j) { pk[s][2 * j] = pk2(v[0][j], v[1][j]); pk[s][2 * j + 1] = pk2(v[2][j], v[3][j]);
            mx[j] = fmaxf(fmaxf(mx[j], fmaxf(fabsf(v[0][j]), fabsf(v[1][j]))), fmaxf(fabsf(v[2][j]), fabsf(v[3][j]))); }
    }
#pragma unroll
    for (int j = 0; j < 4; ++j) { mx[j] = fmaxf(mx[j], __shfl_xor(mx[j], 8)); mx[j] = fmaxf(mx[j], __shfl_xor(mx[j], 16)); mx[j] = fmaxf(mx[j], __shfl_xor(mx[j], 32)); }
    if (lane < 8) *(LAS f32x4*)(cmx + wave * 32 + 4 * cq) = mx;
    __syncthreads();
    f32x4 t = {1e-20f, 1e-20f, 1e-20f, 1e-20f};
#pragma unroll
    for (int w = 0; w < 8; ++w) { const f32x4 o = *(const LAS f32x4*)(cmx + w * 32 + 4 * cq); t[0] = fmaxf(t[0], o[0]); t[1] = fmaxf(t[1], o[1]); t[2] = fmaxf(t[2], o[2]); t[3] = fmaxf(t[3], o[3]); }
    if (tid < 8) *(GAS f32x4*)(cscale + d0 + 4 * cq) = t * ((1.0f / 127.0f) * csmul);
    float sc[4];
#pragma unroll
    for (int j = 0; j < 4; ++j) sc[j] = 127.0f / t[j];
#pragma unroll
    for (int j = 0; j < 4; ++j) { const int col = d0 + 4 * cq + j;
        signed char* dst = W8 + ((size_t)(col >> 8) * 32 + wave * 4) * 32768 + (size_t)((col & 255) * 128 + 16 * kq);
#pragma unroll
        for (int st = 0; st < 4; ++st) { v4u o;
#pragma unroll
            for (int q = 0; q < 4; ++q) { const unsigned w0 = pk[4 * st + q][2 * j], w1 = pk[4 * st + q][2 * j + 1];
                const int a = (int)fminf(fmaxf(rintf(bf_lo(w0) * sc[j]), -127.f), 127.f), b = (int)fminf(fmaxf(rintf(bf_hi(w0) * sc[j]), -127.f), 127.f);
                const int c = (int)fminf(fmaxf(rintf(bf_lo(w1) * sc[j]), -127.f), 127.f), d = (int)fminf(fmaxf(rintf(bf_hi(w1) * sc[j]), -127.f), 127.f);
                o[q] = (unsigned)(a & 255) | ((unsigned)(b & 255) << 8) | ((unsigned)(c & 255) << 16) | ((unsigned)d << 24); }
            *(GAS v4u*)(dst + (size_t)st * 32768) = o; } }
    __syncthreads();
}
__device__ __forceinline__ void resid_phase(bf16* hres, const bf16* delta, float* rstd, signed char* q8  , float* rs8, int nrows, int gw, int ngw, int lane) {
    for (int r = gw; r < nrows; r += ngw) {
        bf16* xr = hres + pg8::tix(r, 4 * lane, DM);
        const GAS v2u* dr = (const GAS v2u*)(delta + (size_t)r * DM) + lane; v2u a[16], d[16]; float s = 0.f;
#pragma unroll
        for (int j = 0; j < 16; ++j) { a[j] = *(const GAS v2u*)(xr + (size_t)j * 65536); d[j] = dr[64 * j]; }
        f32x4 vv[16];
#pragma unroll
        for (int j = 0; j < 16; ++j) { const float v0 = bf_lo(a[j].x) + bf_lo(d[j].x), v1 = bf_hi(a[j].x) + bf_hi(d[j].x), v2 = bf_lo(a[j].y) + bf_lo(d[j].y), v3 = bf_hi(a[j].y) + bf_hi(d[j].y);
            s += (v0 * v0 + v1 * v1) + (v2 * v2 + v3 * v3); v2u w; w.x = pk2(v0, v1); w.y = pk2(v2, v3); *(GAS v2u*)(xr + (size_t)j * 65536) = w; vv[j] = (f32x4){v0, v1, v2, v3}; }
        s = wave_sum(s);
        const float rstd_r = 1.0f / sqrtf(s * (1.0f / DM) + EPS);
        if (lane == 0) rstd[r] = rstd_r;
        if (q8) { const float ms = quant_row8(vv, q8, r, lane); if (lane == 0) rs8[r] = ms * rstd_r; }
    }
}
__device__ __forceinline__ void stat_phase(const bf16* hres, float* rstd, signed char* q8, float* rs8, int nrows, int gw, int ngw, int lane) {
    for (int r = gw; r < nrows; r += ngw) {
        const bf16* xr = hres + pg8::tix(r, 16 * lane, DM); v4u a[4][2]; float s = 0.f;
#pragma unroll
        for (int j = 0; j < 4; ++j) { a[j][0] = *(const GAS v4u*)(xr + (size_t)j * 262144); a[j][1] = *(const GAS v4u*)(xr + (size_t)j * 262144 + 8); }
        float vv[4][16];
#pragma unroll
        for (int j = 0; j < 4; ++j) { float f0[8], f1[8]; unpack8(a[j][0], f0); unpack8(a[j][1], f1);
#pragma unroll
            for (int e = 0; e < 8; ++e) { vv[j][e] = f0[e]; vv[j][8 + e] = f1[e]; s += f0[e] * f0[e] + f1[e] * f1[e]; } }
        s = wave_sum(s);
        const float rstd_r = 1.0f / sqrtf(s * (1.0f / DM) + EPS);
        if (lane == 0) rstd[r] = rstd_r;
        { const float ms = quant_row8x(vv, q8, r, lane); if (lane == 0) rs8[r] = ms * rstd_r; }
    }
}
__device__ __forceinline__ void final_norm(const bf16* hres  , int row_off, const bf16* delta, const float* gain, float* dst, int nrows, int gw, int ngw, int lane) {
    for (int r = gw; r < nrows; r += ngw) {
        const bf16* xr = hres + pg8::tix(r + row_off, 8 * lane, DM); const GAS v4u* dr = (const GAS v4u*)(delta + (size_t)r * DM) + lane; GAS f32x4* o = (GAS f32x4*)(dst + (size_t)r * DM) + 2 * lane;
        v4u a[8], d[8]; float s = 0.f;
#pragma unroll
        for (int j = 0; j < 8; ++j) { a[j] = *(const GAS v4u*)(xr + (size_t)j * 131072); d[j] = dr[64 * j]; }
        float v[8][8];
#pragma unroll
        for (int j = 0; j < 8; ++j) { float fa[8], fd[8]; unpack8(a[j], fa); unpack8(d[j], fd);
#pragma unroll
            for (int e = 0; e < 8; ++e) { v[j][e] = fa[e] + fd[e]; s += v[j][e] * v[j][e]; } }
        const float rstd = 1.0f / sqrtf(wave_sum(s) * (1.0f / DM) + EPS);
#pragma unroll
        for (int j = 0; j < 8; ++j) { const f32x4 g0 = *((const GAS f32x4*)gain + 2 * lane + 128 * j), g1 = *((const GAS f32x4*)gain + 2 * lane + 128 * j + 1);
            o[128 * j] = (f32x4){v[j][0], v[j][1], v[j][2], v[j][3]} * rstd * g0; o[128 * j + 1] = (f32x4){v[j][4], v[j][5], v[j][6], v[j][7]} * rstd * g1; }
    }
}
__device__ __forceinline__ v4u pack8f(const float (&f)[8]) { v4u w; w.x = pk2(f[0], f[1]); w.y = pk2(f[2], f[3]); w.z = pk2(f[4], f[5]); w.w = pk2(f[6], f[7]); return w; }
__device__ __forceinline__ void conv_a_phase(const bf16* bg, const bf16* cv, const float* cw  , bf16* ain, int gtid, int nthr) {
    for (int idx = gtid; idx < 256 * (LTOK / 8); idx += nthr) {
        const int c0 = (idx & 255) * 8, t0 = (idx >> 8) * 8;
        v4u rc[10], rb[8];
#pragma unroll
        for (int i = 0; i < 10; ++i) { int t = t0 - 1 + i; t = t < 0 ? 0 : (t < LTOK ? t : LTOK - 1); rc[i] = *(const GAS v4u*)(cv + (size_t)t * DC + c0); }
#pragma unroll
        for (int i = 0; i < 8; ++i) rb[i] = *(const GAS v4u*)(bg + (size_t)(t0 + i) * DC + c0);
        float w0[8], w1[8], w2[8];
#pragma unroll
        for (int h = 0; h < 2; ++h) { const f32x4 a0 = *(const GAS f32x4*)(cw + c0 + 4 * h), a1 = *(const GAS f32x4*)(cw + 2048 + c0 + 4 * h), a2 = *(const GAS f32x4*)(cw + 4096 + c0 + 4 * h);
#pragma unroll
            for (int e = 0; e < 4; ++e) { w0[4 * h + e] = a0[e]; w1[4 * h + e] = a1[e]; w2[4 * h + e] = a2[e]; } }
        const v4u z4 = (v4u){0u, 0u, 0u, 0u};
        float pv[8], cu[8], nx[8];
        unpack8(t0 > 0 ? rc[0] : z4, pv);
        unpack8(rc[1], cu);
#pragma unroll
        for (int tt = 0; tt < 8; ++tt) { const int t = t0 + tt;
            unpack8((t + 1 < LTOK) ? rc[tt + 2] : z4, nx);
            float b[8], o[8]; unpack8(rb[tt], b);
#pragma unroll
            for (int j = 0; j < 8; ++j) { o[j] = b[j] * (w0[j] * pv[j] + w1[j] * cu[j] + w2[j] * nx[j]); pv[j] = cu[j]; cu[j] = nx[j]; }
            *(GAS v4u*)(ain + pg8::tix(t, c0, DC)) = pack8f(o); }
    }
}
__device__ __forceinline__ void conv_edge_phase(const float* zedge, const float* ztail, const float* cw  , bf16* act, int gtid, int nthr) {
    for (int idx = gtid; idx < 144 * 1536; idx += nthr) {
        const int cgi = idx % 1536, it = idx / 1536, c0 = cgi * 8, zg = (c0 >> 7) * 256 + (c0 & 127);
        int row; const float *pz, *cz, *nz; bool hp = true, hn = true;
        if (it < 128) { const int pm = it >> 1, wh = it & 1; row = pm * 256 + (wh ? 255 : 0);
            cz = zedge + (size_t)(pm * 4 + (wh ? 3 : 0)) * 24576;
            pz = wh ? zedge + (size_t)(pm * 4 + 2) * 24576 : zedge + (size_t)((pm > 0 ? pm - 1 : 0) * 4 + 3) * 24576; hp = wh || pm > 0;
            nz = wh ? (pm < 63 ? zedge + (size_t)((pm + 1) * 4) * 24576 : ztail) : zedge + (size_t)(pm * 4 + 1) * 24576;
        } else { const int i = it - 128; row = MG + i; cz = ztail + (size_t)i * 24576;
            pz = i > 0 ? ztail + (size_t)(i - 1) * 24576 : zedge + (size_t)(63 * 4 + 3) * 24576;
            nz = ztail + (size_t)(i < 15 ? i + 1 : 15) * 24576; hn = i < 15; }
        pz += zg; cz += zg; nz += zg;
        float o[8];
#pragma unroll
        for (int q = 0; q < 2; ++q) {
            const f32x4 z4 = (f32x4){0.f, 0.f, 0.f, 0.f};
            const f32x4 pg = hp ? *(const GAS f32x4*)(pz + 4 * q) : z4, pv = hp ? *(const GAS f32x4*)(pz + 128 + 4 * q) : z4;
            const f32x4 cg = *(const GAS f32x4*)(cz + 4 * q), cv = *(const GAS f32x4*)(cz + 128 + 4 * q);
            const f32x4 ng = hn ? *(const GAS f32x4*)(nz + 4 * q) : z4, nv = hn ? *(const GAS f32x4*)(nz + 128 + 4 * q) : z4;
            const f32x4 g0 = *(const GAS f32x4*)(cw + c0 + 4 * q), g1 = *(const GAS f32x4*)(cw + 24576 + c0 + 4 * q), g2 = *(const GAS f32x4*)(cw + 49152 + c0 + 4 * q);
            const f32x4 v0 = *(const GAS f32x4*)(cw + DFF + c0 + 4 * q), v1 = *(const GAS f32x4*)(cw + 24576 + DFF + c0 + 4 * q), v2 = *(const GAS f32x4*)(cw + 49152 + DFF + c0 + 4 * q);
            const f32x4 a = g0 * pg + g1 * cg + g2 * ng, b = v0 * pv + v1 * cv + v2 * nv;
#pragma unroll
            for (int j = 0; j < 4; ++j) o[4 * q + j] = pg8::gelu_t(a[j]) * b[j];
        }
        *(GAS v4u*)(act + pg8::tix(row, c0, DFF)) = pack8f(o);
    }
}

__device__ __forceinline__ f32x2 cmulf(f32x2 a, f32x2 b) { return (f32x2){a.x * b.x - a.y * b.y, a.x * b.y + a.y * b.x}; }
__device__ __forceinline__ void scan_pass1_reg(int layer, const bf16* u, const f32x2* abar, const bf16* BBt, f32x2* E, int wave, int lane) {
    const int dir = wave & 1, hh = lane >> 5, pl = lane & 31;
    for (int pi0 = (int)blockIdx.x * 4; pi0 < NG * NSEG; pi0 += (int)gridDim.x * 4) {
        const int pi = pi0 + (wave >> 1), g = pi & 63, seg = pi >> 6, ldg = (layer * 2 + dir) * NG + g;
        bf16x8 bbf[4];
#pragma unroll
        for (int nb = 0; nb < 4; ++nb) bbf[nb] = *(const GAS bf16x8*)(BBt + ((size_t)ldg * 128 + 32 * nb + pl) * 16 + 8 * hh);
        f32x2 w[2][16], a32[2];
#pragma unroll
        for (int b = 0; b < 2; ++b) {
            const f32x2 a = abar[ldg * 64 + pl + 32 * b];
            f32x2 P[33]; P[0] = (f32x2){1.f, 0.f};
#pragma unroll
            for (int k = 1; k <= 32; ++k) P[k] = cmulf(P[k - 1], a);
            a32[b] = P[32];
            const bool up4 = dir ? (hh == 1) : (hh == 0);
            const f32x2 F = up4 ? P[4] : (f32x2){1.f, 0.f};
#pragma unroll
            for (int i = 0; i < 16; ++i) { const int base = (i & 3) + 8 * (i >> 2); const f32x2 pw = dir ? P[base] : P[27 - base]; w[b][i] = cmulf(pw, F); }
        }
        f32x2 S[2] = {(f32x2){0.f, 0.f}, (f32x2){0.f, 0.f}};
        int nv = (LTOK - seg * SEGLEN + CHT - 1) / CHT; nv = nv > NCH ? NCH : nv; nv = __builtin_amdgcn_readfirstlane(nv);
        const bf16* ubase = u + (size_t)g * 16 + 8 * hh;
        constexpr int PF1 = 4;
        bf16x8 cur[PF1], nxt[PF1];
#pragma unroll
        for (int k = 0; k < PF1; ++k) { const int cc = k < nv ? k : nv - 1; int tl = seg * SEGLEN + (dir ? nv - 1 - cc : cc) * CHT + pl; tl = tl < LTOK ? tl : LTOK - 1; cur[k] = *(const GAS bf16x8*)(ubase + (size_t)tl * DSS); }
        for (int cb = 0; cb < nv; cb += PF1) {
#pragma unroll
            for (int k = 0; k < PF1; ++k) { const int cn = cb + PF1 + k, cc = cn < nv ? cn : nv - 1; int tl = seg * SEGLEN + (dir ? nv - 1 - cc : cc) * CHT + pl; tl = tl < LTOK ? tl : LTOK - 1; nxt[k] = *(const GAS bf16x8*)(ubase + (size_t)tl * DSS); }
#pragma unroll
            for (int k = 0; k < PF1; ++k) { const int ci = cb + k; if (ci < nv) {
                const int tlk = seg * SEGLEN + (dir ? nv - 1 - ci : ci) * CHT + pl;
                const bf16x8 uf = tlk < LTOK ? cur[k] : (bf16x8){0, 0, 0, 0, 0, 0, 0, 0};
                const f32x16 z16 = (f32x16){0.f, 0.f, 0.f, 0.f, 0.f, 0.f, 0.f, 0.f, 0.f, 0.f, 0.f, 0.f, 0.f, 0.f, 0.f, 0.f};
#pragma unroll
                for (int b = 0; b < 2; ++b) {
                    const f32x16 xr = __builtin_amdgcn_mfma_f32_32x32x16_bf16(uf, bbf[b], z16, 0, 0, 0);
                    const f32x16 xi = __builtin_amdgcn_mfma_f32_32x32x16_bf16(uf, bbf[b + 2], z16, 0, 0, 0);
                    float er = 0.f, ei = 0.f;
#pragma unroll
                    for (int i = 0; i < 16; ++i) { er += w[b][i].x * xr[i] - w[b][i].y * xi[i]; ei += w[b][i].x * xi[i] + w[b][i].y * xr[i]; }
                    er += __shfl_xor(er, 32); ei += __shfl_xor(ei, 32);
                    const f32x2 s = S[b]; S[b] = (f32x2){a32[b].x * s.x - a32[b].y * s.y + er, a32[b].x * s.y + a32[b].y * s.x + ei};
                }
            } }
#pragma unroll
            for (int k = 0; k < PF1; ++k) cur[k] = nxt[k];
        }
        if (hh == 0) { f32x2* Ep = E + ((size_t)(dir * NG + g) * NSEG + seg) * 64 + pl; Ep[0] = S[0]; Ep[32] = S[1]; }
    }
}

template <bool PASS2>
__device__ __forceinline__ void scan_pass(LAS unsigned char* lds, int layer, const bf16* u, const f32x2* abar, const f32x2* aseg, const bf16* BBt, const bf16* CCt, f32x2* E,
                                          float* yf, float* yb, const float* Dv, bf16* sout, int wave, int lane, int tid) {
    LAS unsigned char* xb = lds + wave * XBUF;
    const int dir = wave & 1;
    float* ybuf = dir ? yb : yf;
    for (int pi0 = (int)blockIdx.x * 4; pi0 < NG * NSEG; pi0 += (int)gridDim.x * 4) {
        const int pi = pi0 + (wave >> 1), g = pi & 63, seg = pi >> 6, ldg = (layer * 2 + dir) * NG + g;
        const f32x2 a = abar[ldg * 64 + lane]; const float nay = -a.y;
        bf16x8 bbf[4];
#pragma unroll
        for (int nb = 0; nb < 4; ++nb) bbf[nb] = *(const GAS bf16x8*)(BBt + ((size_t)ldg * 128 + 32 * nb + (lane & 31)) * 16 + 8 * (lane >> 5));
        bf16x8 ccf[4];
        float sr = 0.f, si = 0.f;
        if (PASS2) {
#pragma unroll
            for (int ks = 0; ks < 4; ++ks) ccf[ks] = *(const GAS bf16x8*)(CCt + ((size_t)ldg * 16 + (lane & 15)) * 128 + 32 * ks + 8 * (lane >> 4));
            const f32x2 as = aseg[ldg * 64 + lane]; const f32x2* Eb = E + ((size_t)(dir * NG + g) * NSEG) * 64 + lane;
            if (dir == 0) { for (int s2 = 0; s2 < seg; ++s2) { const f32x2 e = Eb[s2 * 64]; const float nr = as.x * sr - as.y * si + e.x, ni = as.x * si + as.y * sr + e.y; sr = nr; si = ni; } }
            else { for (int s2 = NSEG - 1; s2 > seg; --s2) { const f32x2 e = Eb[s2 * 64]; const float nr = as.x * sr - as.y * si + e.x, ni = as.x * si + as.y * sr + e.y; sr = nr; si = ni; } }
        }
        int nv = (LTOK - seg * SEGLEN + CHT - 1) / CHT; nv = nv > NCH ? NCH : nv; nv = __builtin_amdgcn_readfirstlane(nv);
        const bf16* ubase = u + (size_t)g * 16 + 8 * (lane >> 5);
        constexpr int PF2 = 2;
        bf16x8 cur[PF2], nxt[PF2];
#pragma unroll
        for (int k = 0; k < PF2; ++k) { const int cc = k < nv ? k : nv - 1; int tl = seg * SEGLEN + (dir ? nv - 1 - cc : cc) * CHT + (lane & 31); tl = tl < LTOK ? tl : LTOK - 1; cur[k] = *(const GAS bf16x8*)(ubase + (size_t)tl * DSS); }
        __builtin_amdgcn_s_waitcnt(0x0F70);
        for (int cb = 0; cb < nv; cb += PF2) {
#pragma unroll
          for (int k = 0; k < PF2; ++k) { const int cn = cb + PF2 + k, cc = cn < nv ? cn : nv - 1; int tl = seg * SEGLEN + (dir ? nv - 1 - cc : cc) * CHT + (lane & 31); tl = tl < LTOK ? tl : LTOK - 1; nxt[k] = *(const GAS bf16x8*)(ubase + (size_t)tl * DSS); }
#pragma unroll
          for (int k = 0; k < PF2; ++k) { const int ci = cb + k; if (ci < nv) {
            const int c = dir ? (nv - 1 - ci) : ci; const int t0 = __builtin_amdgcn_readfirstlane(seg * SEGLEN + c * CHT);
            const bf16x8 uf = (t0 + (lane & 31)) < LTOK ? cur[k] : (bf16x8){0, 0, 0, 0, 0, 0, 0, 0};
            const f32x16 z16 = (f32x16){0.f, 0.f, 0.f, 0.f, 0.f, 0.f, 0.f, 0.f, 0.f, 0.f, 0.f, 0.f, 0.f, 0.f, 0.f, 0.f};
#pragma unroll
            for (int b = 0; b < 2; ++b) {
                const f32x16 xr = __builtin_amdgcn_mfma_f32_32x32x16_bf16(uf, bbf[b], z16, 0, 0, 0);
                const f32x16 xi = __builtin_amdgcn_mfma_f32_32x32x16_bf16(uf, bbf[b + 2], z16, 0, 0, 0);
                LAS unsigned char* wp = xb + (4 * (lane >> 5)) * XROW + (32 * b + (lane & 31)) * 8;
#pragma unroll
                for (int i = 0; i < 16; ++i) { LAS float* q = (LAS float*)(wp + ((i & 3) + 8 * (i >> 2)) * XROW); q[0] = xr[i]; q[1] = xi[i]; }
            }
            LDS_WAIT();
            f32x2 xs[CHT];
#pragma unroll
            for (int j = 0; j < CHT; ++j) xs[j] = *(const LAS f32x2*)(xb + j * XROW + lane * 8);
            if (dir == 0) {
#pragma unroll
                for (int j = 0; j < CHT; ++j) { const float t1 = fma_s(a.x, sr, xs[j].x), t2 = fma_s(a.x, si, xs[j].y); const float nr = fma_s(nay, si, t1), ni = fma_s(a.y, sr, t2); sr = nr; si = ni; if (PASS2) { xs[j].x = sr; xs[j].y = si; } }
            } else {
#pragma unroll
                for (int j = CHT - 1; j >= 0; --j) { const float t1 = fma_s(a.x, sr, xs[j].x), t2 = fma_s(a.x, si, xs[j].y); const float nr = fma_s(nay, si, t1), ni = fma_s(a.y, sr, t2); sr = nr; si = ni; if (PASS2) { xs[j].x = sr; xs[j].y = si; } }
            }
            if (PASS2) {
#pragma unroll
                for (int j = 0; j < CHT; ++j) *(LAS unsigned*)(xb + j * XROW + 4 * lane) = pk2(xs[j].x, xs[j].y);
                LDS_WAIT();
#pragma unroll
                for (int mb = 0; mb < 2; ++mb) {
                    f32x4 y = (f32x4){0.f, 0.f, 0.f, 0.f};
#pragma unroll
                    for (int ks = 0; ks < 4; ++ks) { const bf16x8 af = *(const LAS bf16x8*)(xb + (16 * mb + (lane & 15)) * XROW + (32 * ks + 8 * (lane >> 4)) * 2);
                        y = __builtin_amdgcn_mfma_f32_16x16x32_bf16(ccf[ks], af, y, 0, 0, 0); }
                    { const int tok = t0 + 16 * mb + (lane & 15); *(GAS f32x4*)(ybuf + (size_t)tok * DSS + g * 16 + 4 * (lane >> 4)) = y; }
                }
                LDS_WAIT();
            }
          } }
#pragma unroll
          for (int k = 0; k < PF2; ++k) cur[k] = nxt[k];
        }
        if (!PASS2) E[((size_t)(dir * NG + g) * NSEG + seg) * 64 + lane] = (f32x2){sr, si};
        if (PASS2) {
            VM_WAIT(); __syncthreads();
            const int g0 = pi0 & 63, sg = pi0 >> 6, cq = tid & 15, tb = sg * SEGLEN;
            const int te = (tb + SEGLEN < LTOK) ? tb + SEGLEN : LTOK;
            const f32x4 dv = *(const GAS f32x4*)(Dv + g0 * 16 + 4 * cq);
            for (int t0 = tb + (tid >> 4); t0 < te; t0 += 128) {
                f32x4 a1[4], a2[4]; v2u uu[4];
#pragma unroll
                for (int q = 0; q < 4; ++q) { const int t = t0 + 32 * q, tc = t < te ? t : te - 1; const size_t off = (size_t)tc * DSS + g0 * 16 + 4 * cq;
                    a1[q] = *(const GAS f32x4*)(yf + off); a2[q] = *(const GAS f32x4*)(yb + off); uu[q] = *(const GAS v2u*)(u + off); }
#pragma unroll
                for (int q = 0; q < 4; ++q) { const int t = t0 + 32 * q;
                    if (t < te) {
                        const float v0 = a1[q].x + a2[q].x + dv.x * bf_lo(uu[q].x), v1 = a1[q].y + a2[q].y + dv.y * bf_hi(uu[q].x), v2 = a1[q].z + a2[q].z + dv.z * bf_lo(uu[q].y), v3 = a1[q].w + a2[q].w + dv.w * bf_hi(uu[q].y);
                        v2u w; w.x = pk2(pg8::gelu_t(v0), pg8::gelu_t(v1)); w.y = pk2(pg8::gelu_t(v2), pg8::gelu_t(v3));
                        *(GAS v2u*)(sout + pg8::tix(t, g0 * 16 + 4 * cq, DSS)) = w; } }
            }
            __syncthreads();
        }
    }
}

struct Args { const float* in[21]; float* out; unsigned char* ws; int ph_lo, ph_hi; };
__global__ void __launch_bounds__(NWAVES * 64, 2) mk_fwd(Args args) {
    extern __shared__ __attribute__((aligned(16))) unsigned char lds_raw[];
    LAS unsigned char* lds = (LAS unsigned char*)lds_raw;
    const int G = gridDim.x, bx = blockIdx.x, ngw = G * NWAVES, nthr = G * NWAVES * 64;
#define SITE_IDS() int tid = threadIdx.x; asm volatile("" : "+v"(tid)); const int lane = tid & 63, wave = __builtin_amdgcn_readfirstlane(tid >> 6), gw = bx * NWAVES + wave, gtid = bx * (NWAVES * 64) + tid; (void)lane; (void)wave; (void)gw; (void)gtid
    unsigned char* ws = args.ws;
    volatile LAS unsigned* MISC = (volatile LAS unsigned*)(lds + LDSCTL_OFF);
    for (int i = threadIdx.x; i < (LDS_BYTES - LDSCTL_OFF) / 4; i += NWAVES * 64) MISC[i] = 0u;
    __syncthreads();
    const int lo = args.ph_lo, hi = args.ph_hi;
    XcdBarrier bar; bar.bar = (unsigned*)(ws + WS_CTL) + 4096; bar.x = 0; bar.st = nullptr;
    if (hi - lo > 1) bar = xcd_barrier_post((unsigned*)(ws + WS_CTL) + 4096, MISC + 8);
#ifndef SITE_MASK
#define SITE_MASK 0xFFFF
#endif
#define EN(s) ((SITE_MASK >> (s)) & 1)
#define IN(k) (lo <= (k) && (k) < hi)
#define SEAM(k) do { if (IN((k) + 1)) xcd_barrier(bar); } while (0)

    const float* x = args.in[0]; const float* meta = args.in[1];
    signed char* hb8 = (signed char*)(ws + WS_HB8); signed char* wg8 = (signed char*)(ws + WS_WG8); float* rs8b = (float*)(ws + WS_RS8); float* cs8b = (float*)(ws + WS_CS8); float* csub = (float*)(ws + WS_RSTD + 1 * MiB);
    bf16* hb = (bf16*)(ws + WS_H);
    bf16* bgb = (bf16*)(ws + WS_R + R_BG); bf16* cvb = (bf16*)(ws + WS_R + R_CV); bf16* ub = (bf16*)(ws + WS_R + R_U); bf16* gab = (bf16*)(ws + WS_R + R_GA); bf16* gbb = (bf16*)(ws + WS_R + R_GB);
    bf16* ainb = (bf16*)(ws + WS_R + R_AIN); bf16* sb = (bf16*)(ws + WS_R + R_S); bf16* mb = (bf16*)(ws + WS_R + R_M); float* yfb = (float*)(ws + WS_R + R_YF); float* ybb = (float*)(ws + WS_R + R_YB);
    bf16* m1b = (bf16*)(ws + WS_R);
    bf16* dlt = (bf16*)(ws + WS_R + 650 * MiB);     float* rstdb = (float*)(ws + WS_RSTD);
    float* zedge = (float*)(ws + WS_R); float* ztail = (float*)(ws + WS_R + 32 * MiB); bf16* actb = (bf16*)(ws + WS_R + 64 * MiB);
    f32x2* abar = (f32x2*)(ws + WS_ABAR); f32x2* aseg = (f32x2*)(ws + WS_ASEG); bf16* BBt = (bf16*)(ws + WS_BBT); bf16* CCt = (bf16*)(ws + WS_CCT); f32x2* Eb = (f32x2*)(ws + WS_E);

    if (EN(0) && IN(0)) { SITE_IDS();
        LAS float* scr = (LAS float*)(lds + wave * 16640);
        for (int l = 0; l < 2; ++l) {
            unsigned char* wl = ws + WS_W + (size_t)l * W_LAYER;
            convert_matrix(args.in[3] + (size_t)l * DM * NIN, args.in[2] + l * DM, DM, NIN, (bf16*)(wl + W_IN), 1, scr, gw, ngw, lane, 7168);
            convert_matrix(args.in[5] + (size_t)l * DC * DM, nullptr, DC, DM, (bf16*)(wl + W_A), 0, scr, gw, ngw, lane);
            convert_matrix(args.in[14] + (size_t)l * DSS * 2 * DM, nullptr, DSS, 2 * DM, (bf16*)(wl + W_GLU), 2, scr, gw, ngw, lane);
            convert_matrix(args.in[15] + (size_t)l * DM * DM, nullptr, DM, DM, (bf16*)(wl + W_OUT), 0, scr, gw, ngw, lane);
            convert_matrix(args.in[19] + (size_t)l * DFF * DM, nullptr, DFF, DM, (bf16*)(wl + W_DOWN), 0, scr, gw, ngw, lane);
        }
        __syncthreads();
        for (int t = bx; t < 512 + 1536; t += G) {
            if (t < 512) { const int ly = t >> 8, cbk = t & 255;
                weights_i8(lds, args.in[3] + (size_t)ly * DM * NIN, NIN, args.in[2] + ly * DM, wg8 + (size_t)ly * (32 * MiB), cs8b + ly * 8192, 7168 + 32 * cbk, 32 * cbk, wave, lane, tid, -1.44269504089f); }
            else { const int u = t - 512, ly = u / 768, cbk = u % 768;
                weights_i8(lds, args.in[17] + (size_t)ly * DM * 2 * DFF, 2 * DFF, args.in[16] + ly * DM, (signed char*)(ws + WS_W + (size_t)ly * W_LAYER + W_UP), csub + ly * 24576, 32 * cbk, dest_row(2, 2 * DFF, 32 * cbk), wave, lane, tid); }
        }
        if (gtid < 2 * 2 * NG * 64) scan_params(gtid, args.in[6], args.in[7], args.in[8], args.in[9], args.in[10], args.in[11], args.in[12], abar, aseg, BBt, CCt);
        for (int r = gw; r < LTOK; r += ngw) {
            const GAS f32x4* xr = (const GAS f32x4*)(r < NMETA ? meta + (size_t)r * DM : x + (size_t)(r - NMETA) * DM) + 2 * lane;
            float s = 0.f; float vv[8][8];
#pragma unroll
            for (int j = 0; j < 8; ++j) { const f32x4 v0 = xr[128 * j], v1 = xr[128 * j + 1];
                vv[j][0] = v0.x; vv[j][1] = v0.y; vv[j][2] = v0.z; vv[j][3] = v0.w; vv[j][4] = v1.x; vv[j][5] = v1.y; vv[j][6] = v1.z; vv[j][7] = v1.w; }
#pragma unroll
            for (int j = 0; j < 8; ++j) {
#pragma unroll
                for (int e = 0; e < 8; ++e) s += vv[j][e] * vv[j][e];
                v4u w; w.x = pk2(vv[j][0], vv[j][1]); w.y = pk2(vv[j][2], vv[j][3]); w.z = pk2(vv[j][4], vv[j][5]); w.w = pk2(vv[j][6], vv[j][7]);
                *(GAS v4u*)(hb + pg8::tix(r, 8 * lane + 512 * j, DM)) = w; }
            s = wave_sum(s);
            const float rstd_r = 1.0f / sqrtf(s * (1.0f / DM) + EPS);
            if (lane == 0) rstdb[r] = rstd_r;
            { const float ms = quant_row8w(vv, hb8, r, lane); if (lane == 0) rs8b[r] = ms * rstd_r; }
        }
        SEAM(0);
    }
    for (int l = 0; l < 2; ++l) {
        const int pb = 1 + 11 * l;
        unsigned char* wl = ws + WS_W + (size_t)l * W_LAYER;
        if (EN(1) && IN(pb + 0) && l > 0) { SITE_IDS(); stat_phase(hb, rstdb, hb8, rs8b, LTOK, gw, ngw, lane); SEAM(pb + 0); }
        if (EN(2) && IN(pb + 1)) {
            pg8::Gemm g{hb, (const bf16*)(wl + W_IN), MG, 7168, DM}; pg8::StaticOrder S; S.init(MG, 7168, G, bx);
            pg8::EpiIn E{bgb, cvb, ub, gab, gbb, rstdb};
            pg8::gemm_phase<pg8::EpiIn, pg8::StaticOrder, true, true, true, WTILED>(lds, g, S, E);
            { pg8::Gemm g8{(const bf16*)hb8, (const bf16*)(wg8 + (size_t)l * (32 * MiB)), MG, 8192, 2048}; pg8::StaticOrder S8; S8.init(MG, 8192, G, bx);
              pg8::EpiGate8 E8{pg8::EpiIn{bgb, cvb, ub, gab, gbb, rs8b}, cs8b + l * 8192};
              pg8::gemm_phase<pg8::EpiGate8, pg8::StaticOrder, true, true, true, true, true>(lds, g8, S8, E8); }
            pg8::tail_gemm<decltype(E), WTILED>(lds, hb, (const bf16*)(wl + W_IN), 7168, DM, MG, E);
            { pg8::EpiGate8 E8{pg8::EpiIn{bgb, cvb, ub, gab, gbb, rs8b}, cs8b + l * 8192}; pg8::tail_gemm<decltype(E8), true, true>(lds, (const bf16*)hb8, (const bf16*)(wg8 + (size_t)l * (32 * MiB)), 8192, 2048, MG, E8); }
            SEAM(pb + 1);
        }
        if (EN(3) && IN(pb + 2)) { SITE_IDS();
            scan_pass1_reg(l, ub, abar, BBt, Eb, wave, lane);
            conv_a_phase(bgb, cvb, args.in[4] + l * 3 * DC, ainb, gtid, nthr);
            SEAM(pb + 2);
        }
        if (EN(4) && IN(pb + 3)) { SITE_IDS();
            scan_pass<true>(lds, l, ub, abar, aseg, BBt, CCt, Eb, yfb, ybb, args.in[13] + l * DSS, sb, wave, lane, tid);
        }
        if (EN(5) && IN(pb + 3)) {
            pg8::Gemm g{ainb, (const bf16*)(wl + W_A), MG, DM, DC}; pg8::StaticOrder S; S.init(MG, DM, G, bx);
            pg8::EpiMulGate E{gab, m1b};
            pg8::gemm_phase<pg8::EpiMulGate, pg8::StaticOrder, true, true, true, WTILED>(lds, g, S, E);
            pg8::tail_gemm<decltype(E), WTILED>(lds, ainb, (const bf16*)(wl + W_A), DM, DC, MG, E);
            SEAM(pb + 4);
        }
        if (EN(6) && IN(pb + 5)) {
            pg8::Gemm g{sb, (const bf16*)(wl + W_GLU), MG, 2 * DM, DSS}; pg8::StaticOrder S; S.init(MG, 2 * DM, G, bx);
            pg8::EpiGlu E{gbb, m1b, mb};
            pg8::gemm_phase<pg8::EpiGlu, pg8::StaticOrder, true, true, true, WTILED>(lds, g, S, E);
            pg8::tail_gemm<decltype(E), WTILED>(lds, sb, (const bf16*)(wl + W_GLU), 2 * DM, DSS, MG, E);
            SEAM(pb + 5);
        }
        if (EN(7) && IN(pb + 6)) {
            pg8::Gemm g{mb, (const bf16*)(wl + W_OUT), MG, DM, DM}; pg8::StaticOrder S; S.init(MG, DM, G, bx);
            pg8::EpiResid E{hb, dlt, true};
            pg8::gemm_phase<pg8::EpiResid, pg8::StaticOrder, true, true, true, WTILED>(lds, g, S, E);
            pg8::tail_gemm<decltype(E), WTILED>(lds, mb, (const bf16*)(wl + W_OUT), DM, DM, MG, E);
            SEAM(pb + 6);
        }
        if (EN(8) && IN(pb + 7)) { SITE_IDS(); stat_phase(hb, rstdb, hb8, rs8b, LTOK, gw, ngw, lane); SEAM(pb + 7); }
        if (EN(9) && IN(pb + 8)) {
            unsigned char* wsl = ws; asm volatile("" : "+s"(wsl));
            const bf16* a8 = (const bf16*)(wsl + WS_HB8); const bf16* w8 = (const bf16*)(wsl + WS_W + (size_t)l * W_LAYER + W_UP);
            pg8::Gemm g{a8, w8, MG, 2 * DFF, 2048}; pg8::StaticOrder S; S.init(MG, 2 * DFF, G, bx);
            pg8::EpiUp8 E{pg8::EpiUpConv{args.in[18] + (size_t)l * 3 * 2 * DFF, (bf16*)(wsl + WS_R + 64 * MiB), (float*)(wsl + WS_R), (LAS float*)(lds + pg8::STAGE_BYTES), (float*)(wsl + WS_R + 32 * MiB), (const float*)(wsl + WS_RS8), (const float*)(wsl + WS_RSTD + 1 * MiB) + l * 24576}};
            pg8::gemm_phase<pg8::EpiUp8, pg8::StaticOrder, true, true, true, true, true>(lds, g, S, E);
            pg8::tail_gemm<decltype(E), true, true>(lds, a8, w8, 2 * DFF, 2048, MG, E);
            SEAM(pb + 8);
        }
        if (EN(10) && IN(pb + 9)) { SITE_IDS(); conv_edge_phase(zedge, ztail, args.in[18] + (size_t)l * 3 * 2 * DFF, actb, gtid, nthr); SEAM(pb + 9); }
        if (EN(11) && IN(pb + 10)) {
            pg8::Gemm g{actb, (const bf16*)(wl + W_DOWN), MG, DM, DFF}; pg8::StaticOrder S; S.init(MG, DM, G, bx);
            pg8::EpiResid E{hb, dlt, l == 0};
            pg8::gemm_phase<pg8::EpiResid, pg8::StaticOrder, true, true, true, WTILED>(lds, g, S, E);
            pg8::tail_gemm<decltype(E), WTILED>(lds, actb, (const bf16*)(wl + W_DOWN), DM, DFF, MG, E);
            SEAM(pb + 10);
        }
    }
    if (EN(12) && IN(23)) { SITE_IDS(); final_norm(hb, NMETA, dlt + (size_t)NMETA * DM, args.in[20], args.out, SEQ, gw, ngw, lane); }
#undef IN
#undef SEAM
}

extern "C" void kernel_launch(void* const* d_in, const int* in_sizes, int n_in, void* d_out, int out_size, void* d_ws, size_t ws_size, hipStream_t stream) {
    static int grid = 0;
    if (grid == 0) {
        if (n_in != 21 || out_size != SEQ * DM || ws_size < WS_END) { fprintf(stderr, "kernel_launch: unexpected shapes: n_in %d out %d ws %zu (need %zu)\n", n_in, out_size, ws_size, (size_t)WS_END); grid = -1; return; }
        int dev = 0, cus = 0, per_cu = 0;
        if (hipGetDevice(&dev) != hipSuccess || hipDeviceGetAttribute(&cus, hipDeviceAttributeMultiprocessorCount, dev) != hipSuccess) { grid = -1; return; }
        if (hipFuncSetAttribute((const void*)mk_fwd, hipFuncAttributeMaxDynamicSharedMemorySize, LDS_BYTES) != hipSuccess) { fprintf(stderr, "kernel_launch: hipFuncSetAttribute failed\n"); grid = -1; return; }
        if (hipOccupancyMaxActiveBlocksPerMultiprocessor(&per_cu, (const void*)mk_fwd, NWAVES * 64, LDS_BYTES) != hipSuccess || per_cu < 1) { fprintf(stderr, "kernel_launch: occupancy query says %d\n", per_cu); }
        (void)hipGetLastError();
        grid = cus;
    }
    if (grid < 0) return;
    if (hipMemsetAsync((char*)d_ws + WS_CTL, 0, CTL_ZERO_BYTES, stream) != hipSuccess) return;
    Args a{};
    for (int i = 0; i < 21; ++i) a.in[i] = (const float*)d_in[i];
    a.out = (float*)d_out; a.ws = (unsigned char*)d_ws;
#if MK_N_LAUNCHES == 1
    a.ph_lo = 0; a.ph_hi = NPH;
    hipLaunchKernelGGL(mk_fwd, dim3(grid), dim3(NWAVES * 64), LDS_BYTES, stream, a);
#else
    for (int p = 0; p < NPH; ++p) { a.ph_lo = p; a.ph_hi = p + 1; hipLaunchKernelGGL(mk_fwd, dim3(grid), dim3(NWAVES * 64), LDS_BYTES, stream, a); }
#endif
}
```

```cpp
#include <hip/hip_runtime.h>
#include <cstdio>
#include <cstdint>
namespace pg8 {
#define PG8_LAS __attribute__((address_space(3)))
typedef unsigned short bf16_t;
typedef short bf16x8 __attribute__((ext_vector_type(8)));
typedef float f32x4 __attribute__((ext_vector_type(4)));
typedef unsigned u32x4 __attribute__((ext_vector_type(4)));
typedef int i32x4 __attribute__((ext_vector_type(4)));
constexpr int BM = 256, BK = 64, HALF = 128, HTB = HALF * BK * 2  , STAGE_BYTES = 8 * HTB, NXCD = 8, WGM = 4;

__host__ __device__ __forceinline__ int lds_byte(int r, int c) { const int st = (r >> 4) * 2 + (c >> 5), rr = r & 15, cc = c & 31, ob = rr * 64 + cc * 2; return st * 1024 + (ob ^ (((ob >> 9) & 1) << 5)); }
__host__ __device__ __forceinline__ void stage_rc(int b, int& R, int& C) { const int st = b / 1024, sb = b % 1024, swz = sb ^ (((sb >> 9) & 1) << 5); R = (st >> 1) * 16 + swz / 64; C = (st & 1) * 32 + (swz % 64) / 2; }
__host__ __device__ __forceinline__ int perm32(int rho) { const int n = rho >> 4, i = rho & 15; return 8 * (i >> 2) + 4 * n + (i & 3); }

struct Unit { int pm, pn; };
struct Gemm { const bf16_t* A; const bf16_t* Bt; int M, N, K; };

struct StaticOrder {
    int nM, nN, nwg, G, c;
    __host__ __device__ void init(int M, int N, int G_, int c_) { nM = M / BM; nN = N / BM; nwg = nM * nN; G = G_; c = c_; }
    __host__ __device__ bool next(int i, Unit& u) const {
        const long L = (long)i * G + c; if (L >= nwg) return false;
        int wgid = (int)L; { const int q = nwg / NXCD, r = nwg % NXCD, xcd = wgid % NXCD, off = wgid / NXCD; wgid = (xcd < r ? xcd * (q + 1) : r * (q + 1) + (xcd - r) * q) + off; }
        const int nig = WGM * nN, gid = wgid / nig, fm = gid * WGM, gsz = (nM - fm) < WGM ? (nM - fm) : WGM;
        u.pm = fm + ((wgid % nig) % gsz); u.pn = (wgid % nig) / gsz; return true;
    }
    __device__ __forceinline__ void a_ready(const Unit&) const {}
    __device__ __forceinline__ void done(const Unit&) const {}
};

__device__ __forceinline__ unsigned cvt_pk_bf16(float lo, float hi) { unsigned r; asm volatile("v_cvt_pk_bf16_f32 %0, %1, %2" : "=v"(r) : "v"(lo), "v"(hi)); return r; }
typedef float f32x2 __attribute__((ext_vector_type(2)));
__device__ __forceinline__ f32x2 gelu_pk(f32x2 v) {
    const f32x2 av = __builtin_elementwise_abs(v), d = av * 0.2316418882f + 1.0f;
    f32x2 t; t.x = __builtin_amdgcn_rcpf(d.x); t.y = __builtin_amdgcn_rcpf(d.y);
    f32x2 q = t * 0.5307027145f + (-0.7265760135f); q = q * t + 0.7107068705f; q = q * t + (-0.142248368f); q = q * t + 0.127414796f; q = q * t;
    const f32x2 s = (v * v) * (-0.72134752044f);
    f32x2 e; e.x = __builtin_amdgcn_exp2f(s.x); e.y = __builtin_amdgcn_exp2f(s.y);
    const f32x2 m = v * (q * e), r = v - m;
    f32x2 o; o.x = v.x < 0.f ? m.x : r.x; o.y = v.y < 0.f ? m.y : r.y; return o;
}

template <int ACT  > struct EpiBf16 {
    static constexpr bool PERM = true, AFTER_DRAIN = false; static_assert(ACT == 0 || ACT == 1, "EpiBf16: ACT is 0 (none) or 1 (gelu_pk)");
    bf16_t* O; int ldc; const float* bias; int split_cols; size_t split_stride; float scale0;
    __device__ __forceinline__ void operator()(const f32x4 (&acc)[2][2][4][2], const Unit& u, int wr, int wc, int fr, int fq) const {
        const int row0 = u.pm * BM + wr * 64 + fr; int colt = u.pn * BM; bf16_t* base = O;
        float sc = 1.f; if (split_cols) { const int t = colt / split_cols; base += (size_t)t * split_stride; colt -= t * split_cols; if (t == 0) sc = scale0; }
        const int col0 = colt + wc * 32 + 8 * fq, bcol0 = u.pn * BM + wc * 32 + 8 * fq;
        f32x4 bv[2][2];
#pragma unroll
        for (int bj = 0; bj < 2; ++bj)
#pragma unroll
            for (int n = 0; n < 2; ++n) bv[bj][n] = bias ? *(const f32x4*)(bias + bcol0 + bj * HALF + 4 * n) : (f32x4){0.f, 0.f, 0.f, 0.f};
#pragma unroll
        for (int ai = 0; ai < 2; ++ai)
#pragma unroll
            for (int m = 0; m < 4; ++m) { bf16_t* rowp = base + (size_t)(row0 + ai * HALF + m * 16) * ldc + col0;
#pragma unroll
                for (int bj = 0; bj < 2; ++bj) { f32x4 v0 = acc[ai][bj][m][0] + bv[bj][0], v1 = acc[ai][bj][m][1] + bv[bj][1];
                    if (ACT == 1) { f32x2 a = gelu_pk((f32x2){v0[0], v0[1]}), b = gelu_pk((f32x2){v0[2], v0[3]}), c = gelu_pk((f32x2){v1[0], v1[1]}), d = gelu_pk((f32x2){v1[2], v1[3]});
                        v0 = (f32x4){a.x, a.y, b.x, b.y}; v1 = (f32x4){c.x, c.y, d.x, d.y}; }
                    v0 = v0 * sc; v1 = v1 * sc; u32x4 w; w.x = cvt_pk_bf16(v0[0], v0[1]); w.y = cvt_pk_bf16(v0[2], v0[3]); w.z = cvt_pk_bf16(v1[0], v1[1]); w.w = cvt_pk_bf16(v1[2], v1[3]);
                    *(u32x4*)(rowp + bj * HALF) = w; } }
    }
};
__host__ __device__ __forceinline__ size_t tix(int r, int c, int K) { return ((size_t)(r >> 8) * (size_t)(K >> 6) + (size_t)(c >> 6)) * 16384 + (size_t)((r & 255) * 64 + (c & 63)); }
__device__ __forceinline__ float sigm(float x) { return __builtin_amdgcn_rcpf(1.0f + __builtin_amdgcn_exp2f(-1.44269504089f * x)); }
__device__ __forceinline__ float sigm_pre(float t) { return __builtin_amdgcn_rcpf(1.0f + __builtin_amdgcn_exp2f(t)); }
__device__ __forceinline__ float gelu_t(float x) { const float u = x * __builtin_fmaf(-0.10294324f, x * x, -2.30220815f); return x * __builtin_amdgcn_rcpf(1.0f + __builtin_amdgcn_exp2f(u)); }
__device__ __forceinline__ bf16_t f2bf_s(float f) { unsigned u = __float_as_uint(f); return (bf16_t)((u + 0x7fffu + ((u >> 16) & 1u)) >> 16); }
__device__ __forceinline__ float bf2f_s(bf16_t b) { return __uint_as_float(((unsigned)b) << 16); }
__device__ __forceinline__ f32x4 bflo(unsigned a, unsigned b) { return (f32x4){__uint_as_float(a << 16), __uint_as_float(a & 0xffff0000u), __uint_as_float(b << 16), __uint_as_float(b & 0xffff0000u)}; }
__device__ __forceinline__ u32x4 pack8(f32x4 v0, f32x4 v1) { u32x4 w; w.x = cvt_pk_bf16(v0[0], v0[1]); w.y = cvt_pk_bf16(v0[2], v0[3]); w.z = cvt_pk_bf16(v1[0], v1[1]); w.w = cvt_pk_bf16(v1[2], v1[3]); return w; }

__device__ __forceinline__ void scale_rows(f32x4 (&acc)[2][2][4][2], const float* rstd, int row0) {
#pragma unroll
    for (int ai = 0; ai < 2; ++ai)
#pragma unroll
        for (int m = 0; m < 4; ++m) { const float rs = rstd[row0 + ai * HALF + m * 16];
#pragma unroll
            for (int bj = 0; bj < 2; ++bj)
#pragma unroll
                for (int n = 0; n < 2; ++n) acc[ai][bj][m][n] = acc[ai][bj][m][n] * rs; }
}

struct EpiIn {
    static constexpr bool PERM = true, AFTER_DRAIN = false;
    bf16_t *bg, *cv, *u, *ga, *gb; const float* rstd;
    __device__ __forceinline__ void operator()(f32x4 (&acc)[2][2][4][2], const Unit& un, int wr, int wc, int fr, int fq) const {
        const int pn = un.pn; const int row0 = un.pm * BM + wr * 64 + fr; const int cb = wc * 32 + 8 * fq;
        scale_rows(acc, rstd, row0);
        if (pn >= 8 && pn < 24) {
            bf16_t* base = cv + (size_t)row0 * 2048 + (pn - 8) * 128 + cb;
#pragma unroll
            for (int ai = 0; ai < 2; ++ai)
#pragma unroll
                for (int m = 0; m < 4; ++m) { bf16_t* rowp = base + (size_t)(ai * HALF + m * 16) * 2048;
                    *(u32x4*)rowp = pack8(acc[ai][0][m][0] * acc[ai][1][m][0], acc[ai][0][m][1] * acc[ai][1][m][1]); }
        } else {
            bf16_t* base; int ld; bool sg;
            if (pn < 8) { base = bg + pn * 256; ld = 2048; sg = false; }
            else if (pn < 28) { base = u + (pn - 24) * 256; ld = 1024; sg = false; }
            else if (pn < 44) { base = ga + (pn - 28) * 256; ld = 4096; sg = true; }
            else { base = gb + (pn - 44) * 256; ld = 4096; sg = true; }
            base += (size_t)row0 * ld + cb;
#pragma unroll
            for (int ai = 0; ai < 2; ++ai)
#pragma unroll
                for (int m = 0; m < 4; ++m) { bf16_t* rowp = base + (size_t)(ai * HALF + m * 16) * ld;
#pragma unroll
                    for (int bj = 0; bj < 2; ++bj) { f32x4 v0 = acc[ai][bj][m][0], v1 = acc[ai][bj][m][1];
                        if (sg) {
#pragma unroll
                            for (int j = 0; j < 4; ++j) { v0[j] = sigm_pre(v0[j]); v1[j] = sigm_pre(v1[j]); } }
                        *(u32x4*)(rowp + bj * HALF) = pack8(v0, v1); } }
        }
    }
    __device__ __forceinline__ void tail(int row, int pn, int c, float v0, float v1) const {
        { const float rs = rstd[row]; v0 *= rs; v1 *= rs; }
        if (pn >= 8 && pn < 24) { cv[(size_t)row * 2048 + (pn - 8) * 128 + c] = f2bf_s(v0 * v1); return; }
        bf16_t* base; int ld; bool sg;
        if (pn < 8) { base = bg + pn * 256; ld = 2048; sg = false; }
        else if (pn < 28) { base = u + (pn - 24) * 256; ld = 1024; sg = false; }
        else if (pn < 44) { base = ga + (pn - 28) * 256; ld = 4096; sg = true; }
        else { base = gb + (pn - 44) * 256; ld = 4096; sg = true; }
        if (sg) { v0 = sigm_pre(v0); v1 = sigm_pre(v1); }
        base[(size_t)row * ld + c] = f2bf_s(v0); base[(size_t)row * ld + 128 + c] = f2bf_s(v1);
    }
};
struct EpiGate8 {
    static constexpr bool PERM = true, AFTER_DRAIN = false;
    EpiIn e; const float* colscale;
    __device__ __forceinline__ void operator()(f32x4 (&acc)[2][2][4][2], const Unit& un, int wr, int wc, int fr, int fq) const {
        const int cb = wc * 32 + 8 * fq;
#pragma unroll
        for (int bj = 0; bj < 2; ++bj)
#pragma unroll
            for (int n = 0; n < 2; ++n) { const f32x4 cs = *(const f32x4*)(colscale + un.pn * 256 + bj * HALF + cb + 4 * n);
#pragma unroll
                for (int ai = 0; ai < 2; ++ai)
#pragma unroll
                    for (int m = 0; m < 4; ++m) { const i32x4 iv = __builtin_bit_cast(i32x4, acc[ai][bj][m][n]); acc[ai][bj][m][n] = (f32x4){(float)iv[0], (float)iv[1], (float)iv[2], (float)iv[3]} * cs; } }
        Unit u2 = un; u2.pn += 28; e(acc, u2, wr, wc, fr, fq);
    }
    __device__ __forceinline__ void tail(int row, int pn, int c, float v0, float v1) const { e.tail(row, pn + 28, c, v0 * colscale[pn * 256 + c], v1 * colscale[pn * 256 + 128 + c]); }
};
struct EpiMulGate {
    static constexpr bool PERM = true, AFTER_DRAIN = false;
    const bf16_t* ga; bf16_t* m1;
    __device__ __forceinline__ void operator()(const f32x4 (&acc)[2][2][4][2], const Unit& un, int wr, int wc, int fr, int fq) const {
        const unsigned off0 = ((unsigned)(un.pm * BM + wr * 64 + fr) * 4096u + (unsigned)(un.pn * 256 + wc * 32 + 8 * fq)) * 2u;
        u32x4 g[2][4][2];
#pragma unroll
        for (int ai = 0; ai < 2; ++ai)
#pragma unroll
            for (int m = 0; m < 4; ++m)
#pragma unroll
                for (int bj = 0; bj < 2; ++bj) g[ai][m][bj] = *(const u32x4*)((const char*)ga + (size_t)(off0 + (unsigned)((ai * HALF + m * 16) * 8192 + bj * 256)));
#pragma unroll
        for (int ai = 0; ai < 2; ++ai)
#pragma unroll
            for (int m = 0; m < 4; ++m)
#pragma unroll
                for (int bj = 0; bj < 2; ++bj) { const u32x4 gg = g[ai][m][bj];
                    *(u32x4*)((char*)m1 + (size_t)(off0 + (unsigned)((ai * HALF + m * 16) * 8192 + bj * 256))) = pack8(acc[ai][bj][m][0] * bflo(gg.x, gg.y), acc[ai][bj][m][1] * bflo(gg.z, gg.w)); }
    }
    __device__ __forceinline__ void tail(int row, int pn, int c, float v0, float v1) const {
        const size_t o = (size_t)row * 4096 + pn * 256 + c;
        m1[o] = f2bf_s(v0 * bf2f_s(ga[o])); m1[o + 128] = f2bf_s(v1 * bf2f_s(ga[o + 128]));
    }
};
struct EpiGlu {
    static constexpr bool PERM = true, AFTER_DRAIN = false;
    const bf16_t* gb; const bf16_t* m1; bf16_t* mm;
    __device__ __forceinline__ void operator()(const f32x4 (&acc)[2][2][4][2], const Unit& un, int wr, int wc, int fr, int fq) const {
        const unsigned off0 = ((unsigned)(un.pm * BM + wr * 64 + fr) * 4096u + (unsigned)(un.pn * 128 + wc * 32 + 8 * fq)) * 2u;
        const size_t moff0 = (((size_t)un.pm * 64 + (size_t)(un.pn * 2 + (wc >> 1))) * 16384 + (size_t)((wr * 64 + fr) * 64 + (wc & 1) * 32 + 8 * fq)) * 2;
        u32x4 g[2][4], o[2][4];
#pragma unroll
        for (int ai = 0; ai < 2; ++ai)
#pragma unroll
            for (int m = 0; m < 4; ++m) { const size_t off = (size_t)(off0 + (unsigned)((ai * HALF + m * 16) * 8192));
                g[ai][m] = *(const u32x4*)((const char*)gb + off); o[ai][m] = *(const u32x4*)((const char*)m1 + off); }
#pragma unroll
        for (int ai = 0; ai < 2; ++ai)
#pragma unroll
            for (int m = 0; m < 4; ++m) { const size_t off = (size_t)(off0 + (unsigned)((ai * HALF + m * 16) * 8192));
                f32x4 y0 = acc[ai][0][m][0], y1 = acc[ai][0][m][1]; const f32x4 t0 = acc[ai][1][m][0], t1 = acc[ai][1][m][1];
#pragma unroll
                for (int j = 0; j < 4; ++j) { y0[j] *= sigm_pre(t0[j]); y1[j] *= sigm_pre(t1[j]); }
                const u32x4 gg = g[ai][m], oo = o[ai][m];
                *(u32x4*)((char*)mm + moff0 + (size_t)((ai * HALF + m * 16) * 128)) = pack8(bflo(oo.x, oo.y) + bflo(gg.x, gg.y) * y0, bflo(oo.z, oo.w) + bflo(gg.z, gg.w) * y1); }
    }
    __device__ __forceinline__ void tail(int row, int pn, int c, float v0, float v1) const {
        const size_t o = (size_t)row * 4096 + pn * 128 + c;
        mm[tix(row, pn * 128 + c, 4096)] = f2bf_s(bf2f_s(m1[o]) + bf2f_s(gb[o]) * v0 * sigm_pre(v1));
    }
};
struct EpiStoreDelta {
    static constexpr bool PERM = true, AFTER_DRAIN = false;
    bf16_t* dl;
    __device__ __forceinline__ void operator()(const f32x4 (&acc)[2][2][4][2], const Unit& un, int wr, int wc, int fr, int fq) const {
        const unsigned off0 = ((unsigned)(un.pm * BM + wr * 64 + fr) * 4096u + (unsigned)(un.pn * BM + wc * 32 + 8 * fq)) * 2u;
#pragma unroll
        for (int ai = 0; ai < 2; ++ai)
#pragma unroll
            for (int m = 0; m < 4; ++m)
#pragma unroll
                for (int bj = 0; bj < 2; ++bj) *(u32x4*)((char*)dl + (size_t)(off0 + (unsigned)((ai * HALF + m * 16) * 8192 + bj * 256))) = pack8(acc[ai][bj][m][0], acc[ai][bj][m][1]);
    }
    __device__ __forceinline__ void tail(int row, int pn, int c, float v0, float v1) const {
        const size_t o = (size_t)row * 4096 + pn * 256 + c; dl[o] = f2bf_s(v0); dl[o + 128] = f2bf_s(v1);
    }
};
struct EpiResid {
    static constexpr bool PERM = true, AFTER_DRAIN = false;
    bf16_t* hres; bf16_t* dl; bool add;
    __device__ __forceinline__ void operator()(const f32x4 (&acc)[2][2][4][2], const Unit& un, int wr, int wc, int fr, int fq) const {
        if (add) {
            const unsigned off0 = (((unsigned)un.pm * 64u + (unsigned)(un.pn * 4 + (wc >> 1))) * 16384u + (unsigned)((wr * 64 + fr) * 64 + (wc & 1) * 32 + 8 * fq)) * 2u;
            u32x4 h[2][4][2];
#pragma unroll
            for (int ai = 0; ai < 2; ++ai)
#pragma unroll
                for (int m = 0; m < 4; ++m)
#pragma unroll
                    for (int bj = 0; bj < 2; ++bj) h[ai][m][bj] = *(const u32x4*)((const char*)hres + (size_t)(off0 + (unsigned)((ai * HALF + m * 16) * 128 + bj * 65536)));
#pragma unroll
            for (int ai = 0; ai < 2; ++ai)
#pragma unroll
                for (int m = 0; m < 4; ++m)
#pragma unroll
                    for (int bj = 0; bj < 2; ++bj) { const u32x4 hh = h[ai][m][bj];
                        *(u32x4*)((char*)hres + (size_t)(off0 + (unsigned)((ai * HALF + m * 16) * 128 + bj * 65536))) = pack8(acc[ai][bj][m][0] + bflo(hh.x, hh.y), acc[ai][bj][m][1] + bflo(hh.z, hh.w)); }
        } else {
            const unsigned off0 = ((unsigned)(un.pm * BM + wr * 64 + fr) * 4096u + (unsigned)(un.pn * BM + wc * 32 + 8 * fq)) * 2u;
#pragma unroll
            for (int ai = 0; ai < 2; ++ai)
#pragma unroll
                for (int m = 0; m < 4; ++m)
#pragma unroll
                    for (int bj = 0; bj < 2; ++bj) *(u32x4*)((char*)dl + (size_t)(off0 + (unsigned)((ai * HALF + m * 16) * 8192 + bj * 256))) = pack8(acc[ai][bj][m][0], acc[ai][bj][m][1]);
        }
    }
    __device__ __forceinline__ void tail(int row, int pn, int c, float v0, float v1) const {
        if (add) { const size_t i0 = tix(row, pn * 256 + c, 4096), i1 = tix(row, pn * 256 + 128 + c, 4096); hres[i0] = f2bf_s(bf2f_s(hres[i0]) + v0); hres[i1] = f2bf_s(bf2f_s(hres[i1]) + v1); }
        else { const size_t o = (size_t)row * 4096 + pn * 256 + c; dl[o] = f2bf_s(v0); dl[o + 128] = f2bf_s(v1); }
    }
};
template <int N> __device__ __forceinline__ float dpp_ror(float v) { return __builtin_bit_cast(float, __builtin_amdgcn_mov_dpp(__builtin_bit_cast(int, v), 0x120 + N, 0xf, 0xf, true)); }
struct EpiUpConv {
    static constexpr bool PERM = true, AFTER_DRAIN = false;
    const float* cw; bf16_t* act; float* zedge; PG8_LAS float* xch;
    __device__ __forceinline__ void operator()(f32x4 (&acc)[2][2][4][2], const Unit& un, int wr, int wc, int fr, int fq) const {
        const int cb = wc * 32 + 8 * fq;
        scale_rows(acc, rstd, un.pm * BM + wr * 64 + fr);
        const int lprev = (fq << 4) | ((fr + 15) & 15), lnext = (fq << 4) | ((fr + 1) & 15);
#pragma unroll
        for (int ai = 0; ai < 2; ++ai) { const int b = 2 * ai + wr;
            if (fr == 0) {
#pragma unroll
                for (int bj = 0; bj < 2; ++bj)
#pragma unroll
                    for (int n = 0; n < 2; ++n) *(PG8_LAS f32x4*)(xch + ((b * 2 + 0) * 2 + bj) * 128 + cb + 4 * n) = acc[ai][bj][0][n]; }
            if (fr == 15) {
#pragma unroll
                for (int bj = 0; bj < 2; ++bj)
#pragma unroll
                    for (int n = 0; n < 2; ++n) *(PG8_LAS f32x4*)(xch + ((b * 2 + 1) * 2 + bj) * 128 + cb + 4 * n) = acc[ai][bj][3][n]; } }
        if (wr == 0 && fr < 2) { const unsigned zo = ((unsigned)(un.pm * 4 + fr) * 24576u + (unsigned)(un.pn * 256 + cb)) * 4u;
#pragma unroll
            for (int bj = 0; bj < 2; ++bj)
#pragma unroll
                for (int n = 0; n < 2; ++n) *(f32x4*)((char*)zedge + (size_t)(zo + (unsigned)(bj * 512 + 16 * n))) = acc[0][bj][0][n]; }
        if (wr == 1 && fr >= 14) { const unsigned zo = ((unsigned)(un.pm * 4 + 2 + (fr - 14)) * 24576u + (unsigned)(un.pn * 256 + cb)) * 4u;
#pragma unroll
            for (int bj = 0; bj < 2; ++bj)
#pragma unroll
                for (int n = 0; n < 2; ++n) *(f32x4*)((char*)zedge + (size_t)(zo + (unsigned)(bj * 512 + 16 * n))) = acc[1][bj][3][n]; }
        asm volatile("s_waitcnt lgkmcnt(0)" ::: "memory"); __builtin_amdgcn_s_barrier(); asm volatile("" ::: "memory");
        const int ch0 = un.pn * 128 + cb; const unsigned wo = (unsigned)ch0 * 4u;
        const unsigned ao0 = (((unsigned)un.pm * 192u + (unsigned)(un.pn * 2 + (wc >> 1))) * 16384u + (unsigned)((64 * wr + fr) * 64 + (wc & 1) * 32 + 8 * fq)) * 2u;
#pragma unroll
        for (int ai = 0; ai < 2; ++ai) { const int b = 2 * ai + wr;
            const PG8_LAS float* hpp = xch + (((b > 0 ? b - 1 : 0) * 2 + 1) * 2) * 128 + cb;
            const PG8_LAS float* hnp = xch + (((b < 3 ? b + 1 : 3) * 2 + 0) * 2) * 128 + cb;
            unsigned pkw[4][4];
#pragma unroll
            for (int nj = 0; nj < 4; ++nj) { const int n = nj >> 1, jp = nj & 1;
                float o[4][2];
                f32x2 wg[3], wv[3];
#pragma unroll
                for (int k = 0; k < 3; ++k) { wg[k] = *(const f32x2*)((const char*)(cw + k * 24576) + (size_t)wo + 8 * nj); wv[k] = *(const f32x2*)((const char*)(cw + k * 24576 + 12288) + (size_t)wo + 8 * nj); }
#pragma unroll
                for (int jj = 0; jj < 2; ++jj) { const int j = 2 * jp + jj;
                    float cg[4], cv[4];
#pragma unroll
                    for (int bj = 0; bj < 2; ++bj) {
                        float P[4], Nx[4];
#pragma unroll
                        for (int m = 0; m < 4; ++m) { P[m] = dpp_ror<1>(acc[ai][bj][m][n][j]); Nx[m] = dpp_ror<15>(acc[ai][bj][m][n][j]); }
                        const float hp = (b > 0) ? hpp[bj * 128 + 4 * n + j] : 0.f, hn = (b < 3) ? hnp[bj * 128 + 4 * n + j] : 0.f;
                        const float w0 = bj ? wv[0][jj] : wg[0][jj], w1 = bj ? wv[1][jj] : wg[1][jj], w2 = bj ? wv[2][jj] : wg[2][jj];
#pragma unroll
                        for (int m = 0; m < 4; ++m) {
                            const float up = (fr > 0) ? P[m] : (m > 0 ? P[m > 0 ? m - 1 : 0] : hp);
                            const float dn = (fr < 15) ? Nx[m] : (m < 3 ? Nx[m < 3 ? m + 1 : 3] : hn);
                            const float r = w0 * up + w1 * acc[ai][bj][m][n][j] + w2 * dn;
                            if (bj == 0) cg[m] = r; else cv[m] = r; }
                    }
#pragma unroll
                    for (int m = 0; m < 4; ++m) o[m][jj] = gelu_t(cg[m]) * cv[m];
                    __builtin_amdgcn_sched_barrier(0);
                }
#pragma unroll
                for (int m = 0; m < 4; ++m) pkw[m][nj] = cvt_pk_bf16(o[m][0], o[m][1]);
            }
#pragma unroll
            for (int m = 0; m < 4; ++m) { const int tr = 128 * ai + 64 * wr + 16 * m + fr;
                if (tr != 0 && tr != 255) *(u32x4*)((char*)act + (size_t)(ao0 + (unsigned)((128 * ai + 16 * m) * 128))) = (u32x4){pkw[m][0], pkw[m][1], pkw[m][2], pkw[m][3]}; }
            asm volatile("" ::: "memory");
        }
    }
    float* ztail;
    const float* rstd; const float* colscale;
    __device__ __forceinline__ void tail(int row, int pn, int c, float v0, float v1) const {
        { const float rs = rstd[row]; v0 *= rs; v1 *= rs; }
        if (colscale) { v0 *= colscale[pn * 256 + c]; v1 *= colscale[pn * 256 + 128 + c]; }
        float* z = ztail + (size_t)(row - 16384) * 24576 + pn * 256 + c; z[0] = v0; z[128] = v1;
    }
};

struct EpiUp8 {
    static constexpr bool PERM = true, AFTER_DRAIN = false;
    EpiUpConv e;
    __device__ __forceinline__ void operator()(f32x4 (&acc)[2][2][4][2], const Unit& un, int wr, int wc, int fr_, int fq_) const {
        int fr = fr_, fq = fq_; asm volatile("" : "+v"(fr), "+v"(fq));
        const int cb = wc * 32 + 8 * fq;
#pragma unroll
        for (int bj = 0; bj < 2; ++bj)
#pragma unroll
            for (int n = 0; n < 2; ++n) { const f32x4 cs = *(const f32x4*)(e.colscale + un.pn * 256 + bj * HALF + cb + 4 * n);
#pragma unroll
                for (int ai = 0; ai < 2; ++ai)
#pragma unroll
                    for (int m = 0; m < 4; ++m) { const i32x4 iv = __builtin_bit_cast(i32x4, acc[ai][bj][m][n]); acc[ai][bj][m][n] = (f32x4){(float)iv[0], (float)iv[1], (float)iv[2], (float)iv[3]} * cs; } }
        e(acc, un, wr, wc, fr, fq);
    }
    __device__ __forceinline__ void tail(int row, int pn, int c, float v0, float v1) const { e.tail(row, pn, c, v0, v1); }
};

template <class Epi, bool TB = false, bool I8 = false>
__device__ __forceinline__ void tail_gemm(PG8_LAS unsigned char* lds, const bf16_t* A  , const bf16_t* Bt, int N, int K, int row0, const Epi& E) {
    int tid_ = threadIdx.x; asm volatile("" : "+v"(tid_));
    const int tid = tid_, wid = __builtin_amdgcn_readfirstlane(tid >> 6), lane = tid & 63, r16 = lane & 15, q = lane >> 4;
    const int nitems = (N >> 8) * 8, kw = K >> 3, nks = kw >> 5;
    PG8_LAS f32x4* red = (PG8_LAS f32x4*)lds;
    for (int item = blockIdx.x; item < nitems; item += gridDim.x) {
        const int pn = item >> 3, s8 = item & 7;
        const bf16_t* ap = A + tix(row0 + r16, wid * kw, K) + 8 * q;
        const bf16_t* b0 = TB ? Bt + ((size_t)pn * (K >> 6) + ((wid * kw) >> 6)) * 16384 + (s8 * 16 + r16) * 64 + 8 * q : Bt + (size_t)(pn * 256 + s8 * 16 + r16) * K + wid * kw + 8 * q;
        const bf16_t* b1 = b0 + (TB ? (size_t)128 * 64 : (size_t)128 * K);
        f32x4 c0 = (f32x4){0.f, 0.f, 0.f, 0.f}, c1 = (f32x4){0.f, 0.f, 0.f, 0.f};
        int ks = 0;
        for (; ks + 8 <= nks; ks += 8) {
            bf16x8 a[8], x0[8], x1[8];
#pragma unroll
            for (int i = 0; i < 8; ++i) { a[i] = *(const bf16x8*)(ap + ((ks + i) >> 1) * 16384 + ((ks + i) & 1) * 32); const int ko = TB ? ((ks + i) >> 1) * 16384 + ((ks + i) & 1) * 32 : (ks + i) * 32; x0[i] = *(const bf16x8*)(b0 + ko); x1[i] = *(const bf16x8*)(b1 + ko); }
#pragma unroll
            for (int i = 0; i < 8; ++i) { if constexpr (I8) { c0 = __builtin_bit_cast(f32x4, __builtin_amdgcn_mfma_i32_16x16x64_i8(__builtin_bit_cast(i32x4, a[i]), __builtin_bit_cast(i32x4, x0[i]), __builtin_bit_cast(i32x4, c0), 0, 0, 0)); c1 = __builtin_bit_cast(f32x4, __builtin_amdgcn_mfma_i32_16x16x64_i8(__builtin_bit_cast(i32x4, a[i]), __builtin_bit_cast(i32x4, x1[i]), __builtin_bit_cast(i32x4, c1), 0, 0, 0)); } else { c0 = __builtin_amdgcn_mfma_f32_16x16x32_bf16(a[i], x0[i], c0, 0, 0, 0); c1 = __builtin_amdgcn_mfma_f32_16x16x32_bf16(a[i], x1[i], c1, 0, 0, 0); } }
        }
        for (; ks < nks; ks += 4) {
            bf16x8 a[4], x0[4], x1[4];
#pragma unroll
            for (int i = 0; i < 4; ++i) { a[i] = *(const bf16x8*)(ap + ((ks + i) >> 1) * 16384 + ((ks + i) & 1) * 32); const int ko = TB ? ((ks + i) >> 1) * 16384 + ((ks + i) & 1) * 32 : (ks + i) * 32; x0[i] = *(const bf16x8*)(b0 + ko); x1[i] = *(const bf16x8*)(b1 + ko); }
#pragma unroll
            for (int i = 0; i < 4; ++i) { if constexpr (I8) { c0 = __builtin_bit_cast(f32x4, __builtin_amdgcn_mfma_i32_16x16x64_i8(__builtin_bit_cast(i32x4, a[i]), __builtin_bit_cast(i32x4, x0[i]), __builtin_bit_cast(i32x4, c0), 0, 0, 0)); c1 = __builtin_bit_cast(f32x4, __builtin_amdgcn_mfma_i32_16x16x64_i8(__builtin_bit_cast(i32x4, a[i]), __builtin_bit_cast(i32x4, x1[i]), __builtin_bit_cast(i32x4, c1), 0, 0, 0)); } else { c0 = __builtin_amdgcn_mfma_f32_16x16x32_bf16(a[i], x0[i], c0, 0, 0, 0); c1 = __builtin_amdgcn_mfma_f32_16x16x32_bf16(a[i], x1[i], c1, 0, 0, 0); } }
        }
        if constexpr (I8) { const i32x4 i0 = __builtin_bit_cast(i32x4, c0), i1 = __builtin_bit_cast(i32x4, c1); c0 = (f32x4){(float)i0[0], (float)i0[1], (float)i0[2], (float)i0[3]}; c1 = (f32x4){(float)i1[0], (float)i1[1], (float)i1[2], (float)i1[3]}; }
        red[(wid * 2 + 0) * 64 + lane] = c0; red[(wid * 2 + 1) * 64 + lane] = c1;
        asm volatile("s_waitcnt lgkmcnt(0)" ::: "memory"); __builtin_amdgcn_s_barrier(); asm volatile("" ::: "memory");
        if (tid < 256) {
            const int row = tid >> 4, col = tid & 15, sl = col + 16 * (row >> 2), el = row & 3; float v0 = 0.f, v1 = 0.f;
#pragma unroll
            for (int w = 0; w < 8; ++w) { v0 += ((const PG8_LAS float*)(red + (w * 2 + 0) * 64 + sl))[el]; v1 += ((const PG8_LAS float*)(red + (w * 2 + 1) * 64 + sl))[el]; }
            E.tail(row0 + row, pn, s8 * 16 + col, v0, v1);
        }
        asm volatile("s_waitcnt lgkmcnt(0)" ::: "memory"); __builtin_amdgcn_s_barrier(); asm volatile("" ::: "memory");
    }
}
template <class Epi, class Sched, bool ALIGN_EPI = false, bool SP2 = false, bool TA = false, bool TB = false, bool I8 = false>
__device__ __forceinline__ void gemm_phase(PG8_LAS unsigned char* lds, const Gemm g, const Sched& S, const Epi& E) {
    int tid_ = threadIdx.x; asm volatile("" : "+v"(tid_));
    const int tid = tid_, wid = __builtin_amdgcn_readfirstlane(tid >> 6), lane = tid & 63, wr = wid >> 2, wc = wid & 3, fr = lane & 15, fq = lane >> 4;
    const int K = g.K, nt = K / BK;
    unsigned voffA[2], voffB[2];
#pragma unroll
    for (int i = 0; i < 2; ++i) { int R, C; stage_rc(tid * 16 + i * 8192, R, C); const int Rb = Epi::PERM ? ((R & ~31) + perm32(R & 31)) : R;
        voffA[i] = (unsigned)(R * (TA ? 64 : K) + C) * 2u; voffB[i] = (unsigned)(Rb * (TB ? 64 : K) + C) * 2u; }
    const size_t kstepA = TA ? (size_t)(BM * BK * 2) : (size_t)(BK * 2), kstepB = TB ? (size_t)(BM * BK * 2) : (size_t)(BK * 2);
    const size_t hstepA = TA ? (size_t)(HALF * BK * 2) : (size_t)HALF * K * 2, hstepB = TB ? (size_t)(HALF * BK * 2) : (size_t)HALF * K * 2;
    const size_t tstep = (size_t)BM * K * 2;
    const unsigned ldsw = (unsigned)wid * 1024u;
    const int aoff = lds_byte(wr * 64 + fr, fq * 8), boff = lds_byte(wc * 32 + fr, fq * 8);
#define PG8_SA(b, h) (((b) * 2 + (h)) * HTB)
#define PG8_SB(b, h) ((4 + (b) * 2 + (h)) * HTB)
#define PG8_STAGE(bufoff, gbase, voff) do { _Pragma("unroll") for (int _i = 0; _i < 2; ++_i) \
        __builtin_amdgcn_global_load_lds((const unsigned*)((const char*)(gbase) + (voff)[_i]), (PG8_LAS unsigned*)(lds + (bufoff) + ldsw + _i * 8192), 16, 0, 0); } while (0)
#define PG8_LDA(dst, b, h) do { _Pragma("unroll") for (int m = 0; m < 4; ++m) _Pragma("unroll") for (int k = 0; k < 2; ++k) dst[m][k] = *(const PG8_LAS bf16x8*)(lds + PG8_SA(b, h) + aoff + m * 2048 + k * 1024); } while (0)
#define PG8_LDB(dst, b, h) do { _Pragma("unroll") for (int n = 0; n < 2; ++n) _Pragma("unroll") for (int k = 0; k < 2; ++k) dst[n][k] = *(const PG8_LAS bf16x8*)(lds + PG8_SB(b, h) + boff + n * 2048 + k * 1024); } while (0)
#define PG8_MMA(ai, bj, At, Bt) do { __builtin_amdgcn_s_setprio(1); _Pragma("unroll") for (int m = 0; m < 4; ++m) _Pragma("unroll") for (int n = 0; n < 2; ++n) _Pragma("unroll") for (int k = 0; k < 2; ++k) \
        { if constexpr (I8) acc[ai][bj][m][n] = __builtin_bit_cast(f32x4, __builtin_amdgcn_mfma_i32_16x16x64_i8(__builtin_bit_cast(i32x4, Bt[n][k]), __builtin_bit_cast(i32x4, At[m][k]), __builtin_bit_cast(i32x4, acc[ai][bj][m][n]), 0, 0, 0)); \
          else acc[ai][bj][m][n] = __builtin_amdgcn_mfma_f32_16x16x32_bf16(Bt[n][k], At[m][k], acc[ai][bj][m][n], 0, 0, 0); } __builtin_amdgcn_s_setprio(0); } while (0)
#define PG8_WAIT_V(n) asm volatile("s_waitcnt vmcnt(" #n ")" ::: "memory")
#define PG8_WAIT_L(n) asm volatile("s_waitcnt lgkmcnt(" #n ")" ::: "memory")
#define PG8_BAR __builtin_amdgcn_s_barrier()
#define PG8_SCHED __builtin_amdgcn_sched_barrier(0)
    Unit cur, nxt; int ui = 0;
    if (!S.next(0, cur)) return;
    f32x4 acc[2][2][4][2];
#pragma unroll
    for (int a = 0; a < 2; ++a)
#pragma unroll
        for (int b = 0; b < 2; ++b)
#pragma unroll
            for (int m = 0; m < 4; ++m)
#pragma unroll
                for (int n = 0; n < 2; ++n) acc[a][b][m][n] = (f32x4){0.f, 0.f, 0.f, 0.f};
    bf16x8 At[4][2], B0[2][2], B1[2][2];
    const char* cA = (const char*)g.A + (size_t)cur.pm * tstep; const char* cB = (const char*)g.Bt + (size_t)cur.pn * tstep;
    S.a_ready(cur);
    if constexpr (SP2) {
        PG8_STAGE(PG8_SB(0, 0), cB, voffB); PG8_STAGE(PG8_SB(0, 1), cB + hstepB, voffB); PG8_STAGE(PG8_SA(0, 0), cA, voffA); PG8_STAGE(PG8_SA(0, 1), cA + hstepA, voffA);
        if (wr == 1) PG8_BAR;
        PG8_WAIT_V(2); PG8_BAR;
        PG8_STAGE(PG8_SB(1, 0), cB + kstepB, voffB); PG8_STAGE(PG8_SA(1, 0), cA + kstepA, voffA); PG8_STAGE(PG8_SB(1, 1), cB + hstepB + kstepB, voffB);
        PG8_WAIT_V(6); PG8_BAR;
    } else {
        PG8_STAGE(PG8_SB(0, 0), cB, voffB); PG8_STAGE(PG8_SA(0, 0), cA, voffA); PG8_STAGE(PG8_SB(0, 1), cB + hstepB, voffB); PG8_STAGE(PG8_SA(0, 1), cA + hstepA, voffA);
        if (wr == 1) PG8_BAR;
        PG8_WAIT_V(4); PG8_BAR;
        PG8_STAGE(PG8_SB(1, 0), cB + kstepB, voffB); PG8_STAGE(PG8_SA(1, 0), cA + kstepA, voffA); PG8_STAGE(PG8_SB(1, 1), cB + hstepB + kstepB, voffB);
        PG8_WAIT_V(6); PG8_BAR;
    }
    for (;;) {
        const bool has_next = S.next(ui + 1, nxt);
        const char* nA = has_next ? (const char*)g.A + (size_t)nxt.pm * tstep : cA; const char* nB = has_next ? (const char*)g.Bt + (size_t)nxt.pn * tstep : cB;
        for (int t = 0; t < nt; t += 2) {
            const bool last = (t == nt - 2);
            const char* a1 = cA + (size_t)(t + 1) * kstepA;
            const char* a2 = last ? nA : cA + (size_t)(t + 2) * kstepA; const char* b2 = last ? nB : cB + (size_t)(t + 2) * kstepB;
            const char* a3 = a2 + kstepA; const char* b3 = b2 + kstepB;
            if (last && has_next) S.a_ready(nxt);
            if constexpr (SP2) {
            PG8_LDB(B0, 0, 0); PG8_LDB(B1, 0, 1); PG8_SCHED; PG8_LDA(At, 0, 0); PG8_STAGE(PG8_SA(1, 1), a1 + hstepA, voffA);
            PG8_WAIT_V(8); PG8_WAIT_L(0); PG8_BAR; PG8_MMA(0, 0, At, B0); PG8_MMA(0, 1, At, B1); PG8_BAR; PG8_SCHED;
            PG8_LDA(At, 0, 1); PG8_STAGE(PG8_SB(0, 0), b2, voffB); PG8_STAGE(PG8_SB(0, 1), b2 + hstepB, voffB); PG8_STAGE(PG8_SA(0, 0), a2, voffA);
            PG8_WAIT_V(8); PG8_WAIT_L(0); PG8_BAR; PG8_MMA(1, 0, At, B0); PG8_MMA(1, 1, At, B1); PG8_BAR; PG8_SCHED;
            PG8_LDB(B0, 1, 0); PG8_LDB(B1, 1, 1); PG8_SCHED; PG8_LDA(At, 1, 0); PG8_STAGE(PG8_SA(0, 1), a2 + hstepA, voffA);
            PG8_WAIT_V(8); PG8_WAIT_L(0); PG8_BAR; PG8_MMA(0, 0, At, B0); PG8_MMA(0, 1, At, B1); PG8_BAR; PG8_SCHED;
            PG8_LDA(At, 1, 1); PG8_STAGE(PG8_SB(1, 0), b3, voffB); PG8_STAGE(PG8_SB(1, 1), b3 + hstepB, voffB); PG8_STAGE(PG8_SA(1, 0), a3, voffA);
            PG8_WAIT_V(8); PG8_WAIT_L(0); PG8_BAR; PG8_MMA(1, 0, At, B0); PG8_MMA(1, 1, At, B1); PG8_BAR; PG8_SCHED;
            } else {
            PG8_LDB(B0, 0, 0); PG8_SCHED; PG8_LDA(At, 0, 0); PG8_STAGE(PG8_SA(1, 1), a1 + hstepA, voffA);
            PG8_WAIT_L(8); PG8_BAR; PG8_WAIT_L(0); PG8_MMA(0, 0, At, B0); PG8_BAR; PG8_SCHED;
            PG8_LDB(B1, 0, 1); PG8_STAGE(PG8_SB(0, 0), b2, voffB);
            PG8_BAR; PG8_WAIT_L(0); PG8_MMA(0, 1, At, B1); PG8_BAR;
            PG8_LDA(At, 0, 1); PG8_STAGE(PG8_SA(0, 0), a2, voffA);
            PG8_BAR; PG8_WAIT_L(0); PG8_MMA(1, 0, At, B0); PG8_BAR; PG8_SCHED;
            PG8_STAGE(PG8_SB(0, 1), b2 + hstepB, voffB);
            PG8_WAIT_V(6); PG8_BAR; PG8_MMA(1, 1, At, B1); PG8_BAR;
            PG8_LDB(B0, 1, 0); PG8_SCHED; PG8_LDA(At, 1, 0); PG8_STAGE(PG8_SA(0, 1), a2 + hstepA, voffA);
            PG8_WAIT_L(8); PG8_BAR; PG8_WAIT_L(0); PG8_MMA(0, 0, At, B0); PG8_BAR; PG8_SCHED;
            PG8_LDB(B1, 1, 1); PG8_STAGE(PG8_SB(1, 0), b3, voffB);
            PG8_BAR; PG8_WAIT_L(0); PG8_MMA(0, 1, At, B1); PG8_BAR;
            PG8_LDA(At, 1, 1); PG8_STAGE(PG8_SA(1, 0), a3, voffA);
            PG8_BAR; PG8_WAIT_L(0); PG8_MMA(1, 0, At, B0); PG8_BAR; PG8_SCHED;
            PG8_STAGE(PG8_SB(1, 1), b3 + hstepB, voffB);
            PG8_WAIT_V(6); PG8_BAR; PG8_MMA(1, 1, At, B1); PG8_BAR;
            }
        }
        if constexpr (ALIGN_EPI) { if (wr == 0) PG8_BAR; }
        if constexpr (I8) asm volatile("s_nop 15\n\ts_nop 15\n\ts_nop 15\n\ts_nop 15" ::: "memory");
        if constexpr (!Epi::AFTER_DRAIN) { E(acc, cur, wr, wc, fr, fq); S.done(cur); }
        if (!has_next) break;
#pragma unroll
        for (int a = 0; a < 2; ++a)
#pragma unroll
            for (int b = 0; b < 2; ++b)
#pragma unroll
                for (int m = 0; m < 4; ++m)
#pragma unroll
                    for (int n = 0; n < 2; ++n) acc[a][b][m][n] = (f32x4){0.f, 0.f, 0.f, 0.f};
        cur = nxt; cA = nA; cB = nB; ++ui;
        if constexpr (ALIGN_EPI) { if (wr == 1) PG8_BAR; }
    }
    PG8_WAIT_V(0);
    if constexpr (!ALIGN_EPI) { if (wr == 0) PG8_BAR; }
    PG8_BAR;
    if constexpr (Epi::AFTER_DRAIN) { E.fused(acc, cur, wr, wc, fr, fq, lds, wid, lane); S.done(cur); }
#undef PG8_SA
#undef PG8_SB
#undef PG8_STAGE
#undef PG8_LDA
#undef PG8_LDB
#undef PG8_MMA
#undef PG8_WAIT_V
#undef PG8_WAIT_L
#undef PG8_BAR
#undef PG8_SCHED
}
}

#ifndef MK_N_LAUNCHES
#define MK_N_LAUNCHES 1
#endif
constexpr int NWAVES = 8;
constexpr int DM = 4096, SEQ = 16384, NMETA = 16, LTOK = SEQ + NMETA, MP = 16640, MG = 16384;
constexpr int DC = 2048, DSS = 1024, NG = 64, DFF = 12288, NIN = 15360;
constexpr float EPS = 1e-6f;
#ifndef MK_WTILED
#define MK_WTILED 1
#endif
constexpr bool WTILED = MK_WTILED;
constexpr int NPH = 24;
constexpr int NSEG = 16, SEGLEN = 1056, CHT = 32, NCH = SEGLEN / CHT, XROW = 528, XBUF = CHT * XROW;

constexpr size_t MiB = 1u << 20;
constexpr size_t WS_CTL = 0, CTL_ZERO_BYTES = 1 * MiB;
constexpr size_t WS_RSTD = 6 * MiB;
constexpr size_t WS_RS8 = WS_RSTD + 128 * 1024;
constexpr size_t WS_CS8 = WS_RSTD + 256 * 1024;
constexpr size_t WS_ABAR = 1 * MiB;
constexpr size_t WS_ASEG = WS_ABAR + 256 * 1024;
constexpr size_t WS_BBT = 2 * MiB;
constexpr size_t WS_CCT = 3 * MiB;
constexpr size_t WS_E = 4 * MiB;
constexpr size_t WS_W = 8 * MiB;
constexpr size_t W_IN = 0, W_A = 120 * MiB, W_GLU = 136 * MiB, W_OUT = 152 * MiB, W_UP = 184 * MiB, W_DOWN = 376 * MiB, W_LAYER = 472 * MiB;
constexpr size_t WS_HRES = WS_W + 2 * W_LAYER;
constexpr size_t WS_HB8 = WS_HRES;
constexpr size_t WS_WG8 = WS_HRES + 128 * MiB;
constexpr size_t WS_H = WS_HRES + 260 * MiB;
constexpr size_t WS_R = WS_H + 130 * MiB;
constexpr size_t R_BG = 0, R_CV = 65 * MiB, R_U = 130 * MiB, R_GA = 130 * MiB + 32 * MiB + MiB / 2, R_GB = R_GA + 130 * MiB, R_AIN = R_GB + 130 * MiB, R_S = R_AIN + 65 * MiB,
                 R_M = R_S + 32 * MiB + MiB / 2, R_YF = R_M + 130 * MiB, R_YB = R_YF + 65 * MiB, R_END = R_YB + 65 * MiB;
static_assert(R_END == 780 * MiB, "overlay map");
constexpr size_t WS_ACT = WS_R + 780 * MiB;
constexpr size_t WS_DLT = WS_ACT + 390 * MiB;
constexpr size_t WS_END = WS_DLT + 260 * MiB;
static_assert((size_t)MP * 24576 * 2 == 780 * MiB && (size_t)MP * 4096 * 4 == 260 * MiB && (size_t)MP * 12288 * 2 == 390 * MiB, "sizes");

constexpr int LDS_BYTES = 147456, LDSCTL_OFF = 146944;
static_assert(NWAVES * XBUF <= LDSCTL_OFF && NWAVES * 16640 <= LDSCTL_OFF && 131072 + 8192 <= LDSCTL_OFF, "LDS map");

#define GAS __attribute__((address_space(1)))
#define LAS __attribute__((address_space(3)))
typedef unsigned short bf16;
typedef unsigned v4u __attribute__((ext_vector_type(4)));
typedef unsigned v2u __attribute__((ext_vector_type(2)));
typedef float f32x4 __attribute__((ext_vector_type(4)));
typedef float f32x2 __attribute__((ext_vector_type(2)));
typedef float f32x16 __attribute__((ext_vector_type(16)));
typedef short bf16x8 __attribute__((ext_vector_type(8)));
#define LDS_WAIT() asm volatile("s_waitcnt lgkmcnt(0)" ::: "memory")
#define VM_WAIT() asm volatile("s_waitcnt vmcnt(0)" ::: "memory")
__device__ __forceinline__ unsigned pk2(float lo, float hi) { return pg8::cvt_pk_bf16(lo, hi); }
__device__ __forceinline__ float bf_lo(unsigned w) { return __uint_as_float(w << 16); }
__device__ __forceinline__ float bf_hi(unsigned w) { return __uint_as_float(w & 0xffff0000u); }
__device__ __forceinline__ void unpack8(v4u w, float (&f)[8]) { f[0] = bf_lo(w.x); f[1] = bf_hi(w.x); f[2] = bf_lo(w.y); f[3] = bf_hi(w.y); f[4] = bf_lo(w.z); f[5] = bf_hi(w.z); f[6] = bf_lo(w.w); f[7] = bf_hi(w.w); }
__device__ __forceinline__ unsigned short f2bf1(float f) { unsigned u = __float_as_uint(f); return (unsigned short)((u + 0x7fffu + ((u >> 16) & 1u)) >> 16); }
__device__ __forceinline__ float fma_s(float a, float b, float c) { float r; asm("v_fma_f32 %0, %1, %2, %3" : "=v"(r) : "v"(a), "v"(b), "v"(c)); return r; }
__device__ __forceinline__ float wave_sum(float v) {
#pragma unroll
    for (int o = 1; o < 64; o <<= 1) v += __shfl_xor(v, o);
    return v;
}

#define XB_TMO      128
#define XB_XCNT(j)  (256  + 64 * (j))
#define XB_XSUB(j)  (1280 + 64 * (j))
#define XB_XGEN(j)  (2304 + 64 * (j))
#define XB_TOP      3328
#define XB_TOPGEN   3392
#define XCD_BAR_WORDS 3456
#define XB_SPIN_CAP (1u << 18)

__device__ __forceinline__ unsigned xb_ld(unsigned* p)              { return __hip_atomic_load(p, __ATOMIC_RELAXED, __HIP_MEMORY_SCOPE_AGENT); }
__device__ __forceinline__ unsigned xb_add(unsigned* p, unsigned v) { return __hip_atomic_fetch_add(p, v, __ATOMIC_RELAXED, __HIP_MEMORY_SCOPE_AGENT); }
__device__ __forceinline__ unsigned xb_xcc_id() { return (unsigned)__builtin_amdgcn_s_getreg((3 << 11) | 20) & 0xFu; }
#define XB_SPIN(cond, bar) do { unsigned _sp = 0; while (cond) { __builtin_amdgcn_s_sleep(1); \
    if ((++_sp & 255u) == 0u) { if (xb_ld(&(bar)[XB_TMO])) break; if (_sp > XB_SPIN_CAP) { atomicAdd(&(bar)[XB_TMO], 1u); break; } } } } while (0)

struct XcdBarrier {
    unsigned* bar; unsigned x;
    volatile LAS unsigned* st;
};

__device__ __forceinline__ XcdBarrier xcd_barrier_post(unsigned* bar, volatile LAS unsigned* st) {
    XcdBarrier b; b.bar = bar; b.x = xb_xcc_id(); b.st = st;
    if (threadIdx.x == 0) (void)xb_add(&bar[XB_XCNT(b.x)], 1u);
    return b;
}
__device__ __forceinline__ void xcd_barrier_complete(unsigned* bar, unsigned x, unsigned& nloc, unsigned& nx) {
    const unsigned G = gridDim.x * gridDim.y * gridDim.z;
    unsigned sum, cnt, mine, sp = 0u;
    for (;;) {
        sum = 0u; cnt = 0u; mine = 0u;
#pragma unroll
        for (unsigned j = 0; j < 16; ++j) { const unsigned c = xb_ld(&bar[XB_XCNT(j)]); sum += c; cnt += (c > 0u) ? 1u : 0u; mine = (j == x) ? c : mine; }
        if (sum == G) break;
        __builtin_amdgcn_s_sleep(1);
        if ((++sp & 255u) == 0u) { if (xb_ld(&bar[XB_TMO])) break; if (sp > XB_SPIN_CAP) { atomicAdd(&bar[XB_TMO], 1u); break; } }
    }
    nloc = mine > 0u ? mine : 1u; nx = cnt > 0u ? cnt : 1u;
}

__device__ __forceinline__ void xcd_barrier(const XcdBarrier& b) {
    asm volatile("s_waitcnt vmcnt(0)" ::: "memory");
    __syncthreads();
    if (threadIdx.x == 0) {
        unsigned* bar = b.bar;
        __builtin_amdgcn_s_waitcnt(0);
        unsigned nloc = b.st[0], nx = b.st[1];
        if (nloc == 0u) { xcd_barrier_complete(bar, b.x, nloc, nx); b.st[0] = nloc; b.st[1] = nx; }
        const unsigned old = xb_add(&bar[XB_XSUB(b.x)], 1u);
        const unsigned gen = old / nloc;
        if (old + 1u == (gen + 1u) * nloc) {
            __builtin_amdgcn_fence(__ATOMIC_RELEASE, "agent");
            asm volatile("s_waitcnt vmcnt(0)" ::: "memory");
            const unsigned og = xb_add(&bar[XB_TOP], 1u);
            const unsigned tg = og / nx;
            if (og + 1u == (tg + 1u) * nx) xb_add(&bar[XB_TOPGEN], 1u);
            else XB_SPIN(xb_ld(&bar[XB_TOPGEN]) == tg, bar);
            __builtin_amdgcn_fence(__ATOMIC_ACQUIRE, "agent");
            xb_add(&bar[XB_XGEN(b.x)], 1u);
            asm volatile("s_waitcnt vmcnt(0)" ::: "memory");
        } else {
            XB_SPIN(xb_ld(&bar[XB_XGEN(b.x)]) == gen, bar);
            __builtin_amdgcn_fence(__ATOMIC_ACQUIRE, "agent");
            asm volatile("s_waitcnt vmcnt(0)" ::: "memory");
        }
    }
    __syncthreads();
}


__device__ __forceinline__ int dest_row(int mode, int N, int n) {
    if (mode == 1) {
        if (n < 2048 || n >= 6144) return n;
        if (n < 4096) { const int c = n - 2048; return 2048 + (c >> 7) * 256 + (c & 127); }
        const int c = n - 4096; return 2048 + (c >> 7) * 256 + 128 + (c & 127);
    }
    if (mode == 2) {
        const int h = N >> 1; if (n < h) return (n >> 7) * 256 + (n & 127);
        const int c = n - h; return (c >> 7) * 256 + 128 + (c & 127);
    }
    return n;
}
__device__ __forceinline__ void convert_matrix(const float* W, const float* kgain  , int K, int N, bf16* WT, int mode, LAS float* scr, int gw, int ngw, int lane, int ncols = 0  ) {
    const int nblk = (ncols ? ncols : N) >> 6, nitems = (K >> 6) * nblk;
    for (int it = gw; it < nitems; it += ngw) {
        const int kb = it / nblk, nb = it - kb * nblk, k0 = kb << 6, n0 = nb << 6;
        const int nn = 4 * (lane & 15), kq = lane >> 4;
        f32x4 v[16];
#pragma unroll
        for (int i = 0; i < 16; ++i) { v[i] = *(const GAS f32x4*)(W + (size_t)(k0 + 4 * i + kq) * N + n0 + nn); if (kgain) v[i] = v[i] * kgain[k0 + 4 * i + kq]; }
        if (mode == 2 && n0 >= (N >> 1)) {
#pragma unroll
            for (int i = 0; i < 16; ++i) v[i] = v[i] * -1.44269504089f; }
#pragma unroll
        for (int i = 0; i < 16; ++i) { const int kk = 4 * i + kq;
            scr[(nn + 0) * 65 + kk] = v[i].x; scr[(nn + 1) * 65 + kk] = v[i].y; scr[(nn + 2) * 65 + kk] = v[i].z; scr[(nn + 3) * 65 + kk] = v[i].w; }
        LDS_WAIT();
        const int drow = dest_row(mode, N, n0); const int c = lane & 7;
#pragma unroll
        for (int jr = 0; jr < 8; ++jr) { const int n = 8 * jr + (lane >> 3); const LAS float* s = scr + n * 65 + 8 * c;
            v4u o; o.x = pk2(s[0], s[1]); o.y = pk2(s[2], s[3]); o.z = pk2(s[4], s[5]); o.w = pk2(s[6], s[7]);
            if (WTILED) *(GAS v4u*)(WT + ((size_t)((drow + n) >> 8) * (K >> 6) + kb) * 16384 + ((drow + n) & 255) * 64 + 8 * c) = o;
            else *(GAS v4u*)(WT + (size_t)(drow + n) * K + k0 + 8 * c) = o; }
        LDS_WAIT();
    }
}
__device__ __forceinline__ void sincos_d(double x, double& s, double& c) {
    const double k = rint(x * 0.15915494309189535); double r = fma(-k, 6.283185307179586, x); r = fma(-k, 2.4492935982947064e-16, r);
    const double r2 = r * r; double ss = 1.0, cc = 1.0;
#pragma unroll
    for (int n = 17; n >= 1; --n) { ss = 1.0 - ss * r2 / (double)((2 * n) * (2 * n + 1)); cc = 1.0 - cc * r2 / (double)((2 * n - 1) * (2 * n)); }
    s = r * ss; c = cc;
}
__device__ __forceinline__ void scan_params(int idx, const float* lre_, const float* lim_, const float* lst_, const float* bre_, const float* bim_, const float* cre_, const float* cim_,
                                            f32x2* abar, f32x2* aseg, bf16* BBt, bf16* CCt) {
    const int p = idx & 63, ldg = idx >> 6;
    const double lre = (double)lre_[idx], lim = (double)lim_[idx], dt = exp((double)lst_[ldg]);
    const double mag = exp(lre * dt), ang = lim * dt; double sn, cs; sincos_d(ang, sn, cs);
    const double ar = mag * cs, ai = mag * sn, nr = ar - 1.0, ni = ai, den = lre * lre + lim * lim;
    const double fre = (nr * lre + ni * lim) / den, fim = (ni * lre - nr * lim) / den;
    abar[idx] = (f32x2){(float)ar, (float)ai};
    { const double magn = exp(lre * dt * (double)SEGLEN); double s2, c2; sincos_d(ang * (double)SEGLEN, s2, c2); aseg[idx] = (f32x2){(float)(magn * c2), (float)(magn * s2)}; }
    for (int h = 0; h < 16; ++h) {
        const double br = (double)bre_[(size_t)idx * 16 + h], bi = (double)bim_[(size_t)idx * 16 + h];
        BBt[((size_t)ldg * 128 + p) * 16 + h] = f2bf1((float)(fre * br - fim * bi));
        BBt[((size_t)ldg * 128 + 64 + p) * 16 + h] = f2bf1((float)(fre * bi + fim * br));
        const float cr = cre_[((size_t)ldg * 16 + h) * 64 + p], ci = cim_[((size_t)ldg * 16 + h) * 64 + p];
        CCt[((size_t)ldg * 16 + h) * 128 + 2 * p] = f2bf1(cr);
        CCt[((size_t)ldg * 16 + h) * 128 + 2 * p + 1] = f2bf1(-ci);
    }
}
__device__ __forceinline__ float quant_row8(const f32x4 (&v)[16], signed char* q8, int r, int lane) {
    float mx = 0.f;
#pragma unroll
    for (int j = 0; j < 16; ++j) mx = fmaxf(fmaxf(mx, fmaxf(fabsf(v[j].x), fabsf(v[j].y))), fmaxf(fabsf(v[j].z), fabsf(v[j].w)));
#pragma unroll
    for (int o = 1; o < 64; o <<= 1) mx = fmaxf(mx, __shfl_xor(mx, o));
    mx = fmaxf(mx, 1e-20f); const float sc = 127.0f / mx;
    signed char* rowp = q8 + ((size_t)(r >> 8) * 32 + (lane >> 5)) * 32768 + (size_t)((r & 255) * 128 + 4 * (lane & 31));
#pragma unroll
    for (int j = 0; j < 16; ++j) { const int a = (int)rintf(v[j].x * sc), b = (int)rintf(v[j].y * sc), c = (int)rintf(v[j].z * sc), d = (int)rintf(v[j].w * sc);
        *(GAS unsigned*)(rowp + (size_t)j * 65536) = (unsigned)(a & 255) | ((unsigned)(b & 255) << 8) | ((unsigned)(c & 255) << 16) | ((unsigned)d << 24); }
    return mx * (1.0f / 127.0f);
}
__device__ __forceinline__ float quant_row8w(const float (&v)[8][8], signed char* q8, int r, int lane) {
    float mx = 0.f;
#pragma unroll
    for (int j = 0; j < 8; ++j)
#pragma unroll
        for (int e = 0; e < 8; ++e) mx = fmaxf(mx, fabsf(v[j][e]));
#pragma unroll
    for (int o = 1; o < 64; o <<= 1) mx = fmaxf(mx, __shfl_xor(mx, o));
    mx = fmaxf(mx, 1e-20f); const float sc = 127.0f / mx;
    signed char* rowp = q8 + ((size_t)(r >> 8) * 32 + (lane >> 4)) * 32768 + (size_t)((r & 255) * 128 + 8 * (lane & 15));
#pragma unroll
    for (int j = 0; j < 8; ++j) { v2u w;
        { const int a = (int)rintf(v[j][0] * sc), b = (int)rintf(v[j][1] * sc), c = (int)rintf(v[j][2] * sc), d = (int)rintf(v[j][3] * sc); w.x = (unsigned)(a & 255) | ((unsigned)(b & 255) << 8) | ((unsigned)(c & 255) << 16) | ((unsigned)d << 24); }
        { const int a = (int)rintf(v[j][4] * sc), b = (int)rintf(v[j][5] * sc), c = (int)rintf(v[j][6] * sc), d = (int)rintf(v[j][7] * sc); w.y = (unsigned)(a & 255) | ((unsigned)(b & 255) << 8) | ((unsigned)(c & 255) << 16) | ((unsigned)d << 24); }
        *(GAS v2u*)(rowp + (size_t)j * 4 * 32768) = w; }
    return mx * (1.0f / 127.0f);
}
__device__ __forceinline__ float quant_row8x(const float (&v)[4][16], signed char* q8, int r, int lane) {
    float mx = 0.f;
#pragma unroll
    for (int j = 0; j < 4; ++j)
#pragma unroll
        for (int e = 0; e < 16; ++e) mx = fmaxf(mx, fabsf(v[j][e]));
#pragma unroll
    for (int o = 1; o < 64; o <<= 1) mx = fmaxf(mx, __shfl_xor(mx, o));
    mx = fmaxf(mx, 1e-20f); const float sc = 127.0f / mx;
    signed char* rowp = q8 + ((size_t)(r >> 8) * 32 + (lane >> 3)) * 32768 + (size_t)((r & 255) * 128 + 16 * (lane & 7));
#pragma unroll
    for (int j = 0; j < 4; ++j) { v4u w;
#pragma unroll
        for (int q = 0; q < 4; ++q) { const int a = (int)rintf(v[j][4 * q] * sc), b = (int)rintf(v[j][4 * q + 1] * sc), c = (int)rintf(v[j][4 * q + 2] * sc), d = (int)rintf(v[j][4 * q + 3] * sc);
            w[q] = (unsigned)(a & 255) | ((unsigned)(b & 255) << 8) | ((unsigned)(c & 255) << 16) | ((unsigned)d << 24); }
        *(GAS v4u*)(rowp + (size_t)j * 8 * 32768) = w; }
    return mx * (1.0f / 127.0f);
}
__device__ __forceinline__ void weights_i8(LAS unsigned char* lds, const float* Win  , int ldw, const float* kgain, signed char* W8, float* cscale, int n0  , int d0  , int wave, int lane, int tid, float csmul = 1.0f  ) {
    LAS float* cmx = (LAS float*)lds;
    const int cq = lane & 7, kq = lane >> 3;
    const float* src = Win + (size_t)(wave * 512 + 16 * kq) * ldw + n0 + 4 * cq;
    const float* gp = kgain + wave * 512 + 16 * kq;
    unsigned pk[16][8];
    f32x4 mx = {0.f, 0.f, 0.f, 0.f};
#pragma unroll
    for (int s = 0; s < 16; ++s) {
        f32x4 v[4];
        const f32x4 g4 = *(const GAS f32x4*)(gp + 128 * (s >> 2) + 4 * (s & 3));
#pragma unroll
        for (int r = 0; r < 4; ++r) v[r] = *(const GAS f32x4*)(src + (size_t)(128 * (s >> 2) + 4 * (s & 3) + r) * ldw) * g4[r];
#pragma unroll
        for (int j = 0; j < 4; ++j) { pk[s][2 * j] = pk2(v[0][j], v[1][j]); pk[s][2 * j + 1] = pk2(v[2][j], v[3][j]);
            mx[j] = fmaxf(fmaxf(mx[j], fmaxf(fabsf(v[0][j]), fabsf(v[1][j]))), fmaxf(fabsf(v[2][j]), fabsf(v[3][j]))); }
    }
#pragma unroll
    for (int j = 0; j < 4; ++j) { mx[j] = fmaxf(mx[j], __shfl_xor(mx[j], 8)); mx[j] = fmaxf(mx[j], __shfl_xor(mx[j], 16)); mx[j] = fmaxf(mx[j], __shfl_xor(mx[j], 32)); }
    if (lane < 8) *(LAS f32x4*)(cmx + wave * 32 + 4 * cq) = mx;
    __syncthreads();
    f32x4 t = {1e-20f, 1e-20f, 1e-20f, 1e-20f};
#pragma unroll
    for (int w = 0; w < 8; ++w) { const f32x4 o = *(const LAS f32x4*)(cmx + w * 32 + 4 * cq); t[0] = fmaxf(t[0], o[0]); t[1] = fmaxf(t[1], o[1]); t[2] = fmaxf(t[2], o[2]); t[3] = fmaxf(t[3], o[3]); }
    if (tid < 8) *(GAS f32x4*)(cscale + d0 + 4 * cq) = t * ((1.0f / 127.0f) * csmul);
    float sc[4];
#pragma unroll
    for (int j = 0; j < 4; ++j) sc[j] = 127.0f / t[j];
#pragma unroll
    for (int j = 0; j < 4; ++j) { const int col = d0 + 4 * cq + j;
        signed char* dst = W8 + ((size_t)(col >> 8) * 32 + wave * 4) * 32768 + (size_t)((col & 255) * 128 + 16 * kq);
#pragma unroll
        for (int st = 0; st < 4; ++st) { v4u o;
#pragma unroll
            for (int q = 0; q < 4; ++q) { const unsigned w0 = pk[4 * st + q][2 * j], w1 = pk[4 * st + q][2 * j + 1];
                const int a = (int)fminf(fmaxf(rintf(bf_lo(w0) * sc[j]), -127.f), 127.f), b = (int)fminf(fmaxf(rintf(bf_hi(w0) * sc[j]), -127.f), 127.f);
                const int c = (int)fminf(fmaxf(rintf(bf_lo(w1) * sc[j]), -127.f), 127.f), d = (int)fminf(fmaxf(rintf(bf_hi(w1) * sc[j]), -127.f), 127.f);
                o[q] = (unsigned)(a & 255) | ((unsigned)(b & 255) << 8) | ((unsigned)(c & 255) << 16) | ((unsigned)d << 24); }
            *(GAS v4u*)(dst + (size_t)st * 32768) = o; } }
    __syncthreads();
}
__device__ __forceinline__ void resid_phase(bf16* hres, const bf16* delta, float* rstd, signed char* q8  , float* rs8, int nrows, int gw, int ngw, int lane) {
    for (int r = gw; r < nrows; r += ngw) {
        bf16* xr = hres + pg8::tix(r, 4 * lane, DM);
        const GAS v2u* dr = (const GAS v2u*)(delta + (size_t)r * DM) + lane; v2u a[16], d[16]; float s = 0.f;
#pragma unroll
        for (int j = 0; j < 16; ++j) { a[j] = *(const GAS v2u*)(xr + (size_t)j * 65536); d[j] = dr[64 * j]; }
        f32x4 vv[16];
#pragma unroll
        for (int j = 0; j < 16; ++j) { const float v0 = bf_lo(a[j].x) + bf_lo(d[j].x), v1 = bf_hi(a[j].x) + bf_hi(d[j].x), v2 = bf_lo(a[j].y) + bf_lo(d[j].y), v3 = bf_hi(a[j].y) + bf_hi(d[j].y);
            s += (v0 * v0 + v1 * v1) + (v2 * v2 + v3 * v3); v2u w; w.x = pk2(v0, v1); w.y = pk2(v2, v3); *(GAS v2u*)(xr + (size_t)j * 65536) = w; vv[j] = (f32x4){v0, v1, v2, v3}; }
        s = wave_sum(s);
        const float rstd_r = 1.0f / sqrtf(s * (1.0f / DM) + EPS);
        if (lane == 0) rstd[r] = rstd_r;
        if (q8) { const float ms = quant_row8(vv, q8, r, lane); if (lane == 0) rs8[r] = ms * rstd_r; }
    }
}
__device__ __forceinline__ void stat_phase(const bf16* hres, float* rstd, signed char* q8, float* rs8, int nrows, int gw, int ngw, int lane) {
    for (int r = gw; r < nrows; r += ngw) {
        const bf16* xr = hres + pg8::tix(r, 16 * lane, DM); v4u a[4][2]; float s = 0.f;
#pragma unroll
        for (int j = 0; j < 4; ++j) { a[j][0] = *(const GAS v4u*)(xr + (size_t)j * 262144); a[j][1] = *(const GAS v4u*)(xr + (size_t)j * 262144 + 8); }
        float vv[4][16];
#pragma unroll
        for (int j = 0; j < 4; ++j) { float f0[8], f1[8]; unpack8(a[j][0], f0); unpack8(a[j][1], f1);
#pragma unroll
            for (int e = 0; e < 8; ++e) { vv[j][e] = f0[e]; vv[j][8 + e] = f1[e]; s += f0[e] * f0[e] + f1[e] * f1[e]; } }
        s = wave_sum(s);
        const float rstd_r = 1.0f / sqrtf(s * (1.0f / DM) + EPS);
        if (lane == 0) rstd[r] = rstd_r;
        { const float ms = quant_row8x(vv, q8, r, lane); if (lane == 0) rs8[r] = ms * rstd_r; }
    }
}
__device__ __forceinline__ void final_norm(const bf16* hres  , int row_off, const bf16* delta, const float* gain, float* dst, int nrows, int gw, int ngw, int lane) {
    for (int r = gw; r < nrows; r += ngw) {
        const bf16* xr = hres + pg8::tix(r + row_off, 8 * lane, DM); const GAS v4u* dr = (const GAS v4u*)(delta + (size_t)r * DM) + lane; GAS f32x4* o = (GAS f32x4*)(dst + (size_t)r * DM) + 2 * lane;
        v4u a[8], d[8]; float s = 0.f;
#pragma unroll
        for (int j = 0; j < 8; ++j) { a[j] = *(const GAS v4u*)(xr + (size_t)j * 131072); d[j] = dr[64 * j]; }
        float v[8][8];
#pragma unroll
        for (int j = 0; j < 8; ++j) { float fa[8], fd[8]; unpack8(a[j], fa); unpack8(d[j], fd);
#pragma unroll
            for (int e = 0; e < 8; ++e) { v[j][e] = fa[e] + fd[e]; s += v[j][e] * v[j][e]; } }
        const float rstd = 1.0f / sqrtf(wave_sum(s) * (1.0f / DM) + EPS);
#pragma unroll
        for (int j = 0; j < 8; ++j) { const f32x4 g0 = *((const GAS f32x4*)gain + 2 * lane + 128 * j), g1 = *((const GAS f32x4*)gain + 2 * lane + 128 * j + 1);
            o[128 * j] = (f32x4){v[j][0], v[j][1], v[j][2], v[j][3]} * rstd * g0; o[128 * j + 1] = (f32x4){v[j][4], v[j][5], v[j][6], v[j][7]} * rstd * g1; }
    }
}
__device__ __forceinline__ v4u pack8f(const float (&f)[8]) { v4u w; w.x = pk2(f[0], f[1]); w.y = pk2(f[2], f[3]); w.z = pk2(f[4], f[5]); w.w = pk2(f[6], f[7]); return w; }
__device__ __forceinline__ void conv_a_phase(const bf16* bg, const bf16* cv, const float* cw  , bf16* ain, int gtid, int nthr) {
    for (int idx = gtid; idx < 256 * (LTOK / 8); idx += nthr) {
        const int c0 = (idx & 255) * 8, t0 = (idx >> 8) * 8;
        v4u rc[10], rb[8];
#pragma unroll
        for (int i = 0; i < 10; ++i) { int t = t0 - 1 + i; t = t < 0 ? 0 : (t < LTOK ? t : LTOK - 1); rc[i] = *(const GAS v4u*)(cv + (size_t)t * DC + c0); }
#pragma unroll
        for (int i = 0; i < 8; ++i) rb[i] = *(const GAS v4u*)(bg + (size_t)(t0 + i) * DC + c0);
        float w0[8], w1[8], w2[8];
#pragma unroll
        for (int h = 0; h < 2; ++h) { const f32x4 a0 = *(const GAS f32x4*)(cw + c0 + 4 * h), a1 = *(const GAS f32x4*)(cw + 2048 + c0 + 4 * h), a2 = *(const GAS f32x4*)(cw + 4096 + c0 + 4 * h);
#pragma unroll
            for (int e = 0; e < 4; ++e) { w0[4 * h + e] = a0[e]; w1[4 * h + e] = a1[e]; w2[4 * h + e] = a2[e]; } }
        const v4u z4 = (v4u){0u, 0u, 0u, 0u};
        float pv[8], cu[8], nx[8];
        unpack8(t0 > 0 ? rc[0] : z4, pv);
        unpack8(rc[1], cu);
#pragma unroll
        for (int tt = 0; tt < 8; ++tt) { const int t = t0 + tt;
            unpack8((t + 1 < LTOK) ? rc[tt + 2] : z4, nx);
            float b[8], o[8]; unpack8(rb[tt], b);
#pragma unroll
            for (int j = 0; j < 8; ++j) { o[j] = b[j] * (w0[j] * pv[j] + w1[j] * cu[j] + w2[j] * nx[j]); pv[j] = cu[j]; cu[j] = nx[j]; }
            *(GAS v4u*)(ain + pg8::tix(t, c0, DC)) = pack8f(o); }
    }
}
__device__ __forceinline__ void conv_edge_phase(const float* zedge, const float* ztail, const float* cw  , bf16* act, int gtid, int nthr) {
    for (int idx = gtid; idx < 144 * 1536; idx += nthr) {
        const int cgi = idx % 1536, it = idx / 1536, c0 = cgi * 8, zg = (c0 >> 7) * 256 + (c0 & 127);
        int row; const float *pz, *cz, *nz; bool hp = true, hn = true;
        if (it < 128) { const int pm = it >> 1, wh = it & 1; row = pm * 256 + (wh ? 255 : 0);
            cz = zedge + (size_t)(pm * 4 + (wh ? 3 : 0)) * 24576;
            pz = wh ? zedge + (size_t)(pm * 4 + 2) * 24576 : zedge + (size_t)((pm > 0 ? pm - 1 : 0) * 4 + 3) * 24576; hp = wh || pm > 0;
            nz = wh ? (pm < 63 ? zedge + (size_t)((pm + 1) * 4) * 24576 : ztail) : zedge + (size_t)(pm * 4 + 1) * 24576;
        } else { const int i = it - 128; row = MG + i; cz = ztail + (size_t)i * 24576;
            pz = i > 0 ? ztail + (size_t)(i - 1) * 24576 : zedge + (size_t)(63 * 4 + 3) * 24576;
            nz = ztail + (size_t)(i < 15 ? i + 1 : 15) * 24576; hn = i < 15; }
        pz += zg; cz += zg; nz += zg;
        float o[8];
#pragma unroll
        for (int q = 0; q < 2; ++q) {
            const f32x4 z4 = (f32x4){0.f, 0.f, 0.f, 0.f};
            const f32x4 pg = hp ? *(const GAS f32x4*)(pz + 4 * q) : z4, pv = hp ? *(const GAS f32x4*)(pz + 128 + 4 * q) : z4;
            const f32x4 cg = *(const GAS f32x4*)(cz + 4 * q), cv = *(const GAS f32x4*)(cz + 128 + 4 * q);
            const f32x4 ng = hn ? *(const GAS f32x4*)(nz + 4 * q) : z4, nv = hn ? *(const GAS f32x4*)(nz + 128 + 4 * q) : z4;
            const f32x4 g0 = *(const GAS f32x4*)(cw + c0 + 4 * q), g1 = *(const GAS f32x4*)(cw + 24576 + c0 + 4 * q), g2 = *(const GAS f32x4*)(cw + 49152 + c0 + 4 * q);
            const f32x4 v0 = *(const GAS f32x4*)(cw + DFF + c0 + 4 * q), v1 = *(const GAS f32x4*)(cw + 24576 + DFF + c0 + 4 * q), v2 = *(const GAS f32x4*)(cw + 49152 + DFF + c0 + 4 * q);
            const f32x4 a = g0 * pg + g1 * cg + g2 * ng, b = v0 * pv + v1 * cv + v2 * nv;
#pragma unroll
            for (int j = 0; j < 4; ++j) o[4 * q + j] = pg8::gelu_t(a[j]) * b[j];
        }
        *(GAS v4u*)(act + pg8::tix(row, c0, DFF)) = pack8f(o);
    }
}

__device__ __forceinline__ f32x2 cmulf(f32x2 a, f32x2 b) { return (f32x2){a.x * b.x - a.y * b.y, a.x * b.y + a.y * b.x}; }
__device__ __forceinline__ void scan_pass1_reg(int layer, const bf16* u, const f32x2* abar, const bf16* BBt, f32x2* E, int wave, int lane) {
    const int dir = wave & 1, hh = lane >> 5, pl = lane & 31;
    for (int pi0 = (int)blockIdx.x * 4; pi0 < NG * NSEG; pi0 += (int)gridDim.x * 4) {
        const int pi = pi0 + (wave >> 1), g = pi & 63, seg = pi >> 6, ldg = (layer * 2 + dir) * NG + g;
        bf16x8 bbf[4];
#pragma unroll
        for (int nb = 0; nb < 4; ++nb) bbf[nb] = *(const GAS bf16x8*)(BBt + ((size_t)ldg * 128 + 32 * nb + pl) * 16 + 8 * hh);
        f32x2 w[2][16], a32[2];
#pragma unroll
        for (int b = 0; b < 2; ++b) {
            const f32x2 a = abar[ldg * 64 + pl + 32 * b];
            f32x2 P[33]; P[0] = (f32x2){1.f, 0.f};
#pragma unroll
            for (int k = 1; k <= 32; ++k) P[k] = cmulf(P[k - 1], a);
            a32[b] = P[32];
            const bool up4 = dir ? (hh == 1) : (hh == 0);
            const f32x2 F = up4 ? P[4] : (f32x2){1.f, 0.f};
#pragma unroll
            for (int i = 0; i < 16; ++i) { const int base = (i & 3) + 8 * (i >> 2); const f32x2 pw = dir ? P[base] : P[27 - base]; w[b][i] = cmulf(pw, F); }
        }
        f32x2 S[2] = {(f32x2){0.f, 0.f}, (f32x2){0.f, 0.f}};
        int nv = (LTOK - seg * SEGLEN + CHT - 1) / CHT; nv = nv > NCH ? NCH : nv; nv = __builtin_amdgcn_readfirstlane(nv);
        const bf16* ubase = u + (size_t)g * 16 + 8 * hh;
        constexpr int PF1 = 4;
        bf16x8 cur[PF1], nxt[PF1];
#pragma unroll
        for (int k = 0; k < PF1; ++k) { const int cc = k < nv ? k : nv - 1; int tl = seg * SEGLEN + (dir ? nv - 1 - cc : cc) * CHT + pl; tl = tl < LTOK ? tl : LTOK - 1; cur[k] = *(const GAS bf16x8*)(ubase + (size_t)tl * DSS); }
        for (int cb = 0; cb < nv; cb += PF1) {
#pragma unroll
            for (int k = 0; k < PF1; ++k) { const int cn = cb + PF1 + k, cc = cn < nv ? cn : nv - 1; int tl = seg * SEGLEN + (dir ? nv - 1 - cc : cc) * CHT + pl; tl = tl < LTOK ? tl : LTOK - 1; nxt[k] = *(const GAS bf16x8*)(ubase + (size_t)tl * DSS); }
#pragma unroll
            for (int k = 0; k < PF1; ++k) { const int ci = cb + k; if (ci < nv) {
                const int tlk = seg * SEGLEN + (dir ? nv - 1 - ci : ci) * CHT + pl;
                const bf16x8 uf = tlk < LTOK ? cur[k] : (bf16x8){0, 0, 0, 0, 0, 0, 0, 0};
                const f32x16 z16 = (f32x16){0.f, 0.f, 0.f, 0.f, 0.f, 0.f, 0.f, 0.f, 0.f, 0.f, 0.f, 0.f, 0.f, 0.f, 0.f, 0.f};
#pragma unroll
                for (int b = 0; b < 2; ++b) {
                    const f32x16 xr = __builtin_amdgcn_mfma_f32_32x32x16_bf16(uf, bbf[b], z16, 0, 0, 0);
                    const f32x16 xi = __builtin_amdgcn_mfma_f32_32x32x16_bf16(uf, bbf[b + 2], z16, 0, 0, 0);
                    float er = 0.f, ei = 0.f;
#pragma unroll
                    for (int i = 0; i < 16; ++i) { er += w[b][i].x * xr[i] - w[b][i].y * xi[i]; ei += w[b][i].x * xi[i] + w[b][i].y * xr[i]; }
                    er += __shfl_xor(er, 32); ei += __shfl_xor(ei, 32);
                    const f32x2 s = S[b]; S[b] = (f32x2){a32[b].x * s.x - a32[b].y * s.y + er, a32[b].x * s.y + a32[b].y * s.x + ei};
                }
            } }
#pragma unroll
            for (int k = 0; k < PF1; ++k) cur[k] = nxt[k];
        }
        if (hh == 0) { f32x2* Ep = E + ((size_t)(dir * NG + g) * NSEG + seg) * 64 + pl; Ep[0] = S[0]; Ep[32] = S[1]; }
    }
}

template <bool PASS2>
__device__ __forceinline__ void scan_pass(LAS unsigned char* lds, int layer, const bf16* u, const f32x2* abar, const f32x2* aseg, const bf16* BBt, const bf16* CCt, f32x2* E,
                                          float* yf, float* yb, const float* Dv, bf16* sout, int wave, int lane, int tid) {
    LAS unsigned char* xb = lds + wave * XBUF;
    const int dir = wave & 1;
    float* ybuf = dir ? yb : yf;
    for (int pi0 = (int)blockIdx.x * 4; pi0 < NG * NSEG; pi0 += (int)gridDim.x * 4) {
        const int pi = pi0 + (wave >> 1), g = pi & 63, seg = pi >> 6, ldg = (layer * 2 + dir) * NG + g;
        const f32x2 a = abar[ldg * 64 + lane]; const float nay = -a.y;
        bf16x8 bbf[4];
#pragma unroll
        for (int nb = 0; nb < 4; ++nb) bbf[nb] = *(const GAS bf16x8*)(BBt + ((size_t)ldg * 128 + 32 * nb + (lane & 31)) * 16 + 8 * (lane >> 5));
        bf16x8 ccf[4];
        float sr = 0.f, si = 0.f;
        if (PASS2) {
#pragma unroll
            for (int ks = 0; ks < 4; ++ks) ccf[ks] = *(const GAS bf16x8*)(CCt + ((size_t)ldg * 16 + (lane & 15)) * 128 + 32 * ks + 8 * (lane >> 4));
            const f32x2 as = aseg[ldg * 64 + lane]; const f32x2* Eb = E + ((size_t)(dir * NG + g) * NSEG) * 64 + lane;
            if (dir == 0) { for (int s2 = 0; s2 < seg; ++s2) { const f32x2 e = Eb[s2 * 64]; const float nr = as.x * sr - as.y * si + e.x, ni = as.x * si + as.y * sr + e.y; sr = nr; si = ni; } }
            else { for (int s2 = NSEG - 1; s2 > seg; --s2) { const f32x2 e = Eb[s2 * 64]; const float nr = as.x * sr - as.y * si + e.x, ni = as.x * si + as.y * sr + e.y; sr = nr; si = ni; } }
        }
        int nv = (LTOK - seg * SEGLEN + CHT - 1) / CHT; nv = nv > NCH ? NCH : nv; nv = __builtin_amdgcn_readfirstlane(nv);
        const bf16* ubase = u + (size_t)g * 16 + 8 * (lane >> 5);
        constexpr int PF2 = 2;
        bf16x8 cur[PF2], nxt[PF2];
#pragma unroll
        for (int k = 0; k < PF2; ++k) { const int cc = k < nv ? k : nv - 1; int tl = seg * SEGLEN + (dir ? nv - 1 - cc : cc) * CHT + (lane & 31); tl = tl < LTOK ? tl : LTOK - 1; cur[k] = *(const GAS bf16x8*)(ubase + (size_t)tl * DSS); }
        __builtin_amdgcn_s_waitcnt(0x0F70);
        for (int cb = 0; cb < nv; cb += PF2) {
#pragma unroll
          for (int k = 0; k < PF2; ++k) { const int cn = cb + PF2 + k, cc = cn < nv ? cn : nv - 1; int tl = seg * SEGLEN + (dir ? nv - 1 - cc : cc) * CHT + (lane & 31); tl = tl < LTOK ? tl : LTOK - 1; nxt[k] = *(const GAS bf16x8*)(ubase + (size_t)tl * DSS); }
#pragma unroll
          for (int k = 0; k < PF2; ++k) { const int ci = cb + k; if (ci < nv) {
            const int c = dir ? (nv - 1 - ci) : ci; const int t0 = __builtin_amdgcn_readfirstlane(seg * SEGLEN + c * CHT);
            const bf16x8 uf = (t0 + (lane & 31)) < LTOK ? cur[k] : (bf16x8){0, 0, 0, 0, 0, 0, 0, 0};
            const f32x16 z16 = (f32x16){0.f, 0.f, 0.f, 0.f, 0.f, 0.f, 0.f, 0.f, 0.f, 0.f, 0.f, 0.f, 0.f, 0.f, 0.f, 0.f};
#pragma unroll
            for (int b = 0; b < 2; ++b) {
                const f32x16 xr = __builtin_amdgcn_mfma_f32_32x32x16_bf16(uf, bbf[b], z16, 0, 0, 0);
                const f32x16 xi = __builtin_amdgcn_mfma_f32_32x32x16_bf16(uf, bbf[b + 2], z16, 0, 0, 0);
                LAS unsigned char* wp = xb + (4 * (lane >> 5)) * XROW + (32 * b + (lane & 31)) * 8;
#pragma unroll
                for (int i = 0; i < 16; ++i) { LAS float* q = (LAS float*)(wp + ((i & 3) + 8 * (i >> 2)) * XROW); q[0] = xr[i]; q[1] = xi[i]; }
            }
            LDS_WAIT();
            f32x2 xs[CHT];
#pragma unroll
            for (int j = 0; j < CHT; ++j) xs[j] = *(const LAS f32x2*)(xb + j * XROW + lane * 8);
            if (dir == 0) {
#pragma unroll
                for (int j = 0; j < CHT; ++j) { const float t1 = fma_s(a.x, sr, xs[j].x), t2 = fma_s(a.x, si, xs[j].y); const float nr = fma_s(nay, si, t1), ni = fma_s(a.y, sr, t2); sr = nr; si = ni; if (PASS2) { xs[j].x = sr; xs[j].y = si; } }
            } else {
#pragma unroll
                for (int j = CHT - 1; j >= 0; --j) { const float t1 = fma_s(a.x, sr, xs[j].x), t2 = fma_s(a.x, si, xs[j].y); const float nr = fma_s(nay, si, t1), ni = fma_s(a.y, sr, t2); sr = nr; si = ni; if (PASS2) { xs[j].x = sr; xs[j].y = si; } }
            }
            if (PASS2) {
#pragma unroll
                for (int j = 0; j < CHT; ++j) *(LAS unsigned*)(xb + j * XROW + 4 * lane) = pk2(xs[j].x, xs[j].y);
                LDS_WAIT();
#pragma unroll
                for (int mb = 0; mb < 2; ++mb) {
                    f32x4 y = (f32x4){0.f, 0.f, 0.f, 0.f};
#pragma unroll
                    for (int ks = 0; ks < 4; ++ks) { const bf16x8 af = *(const LAS bf16x8*)(xb + (16 * mb + (lane & 15)) * XROW + (32 * ks + 8 * (lane >> 4)) * 2);
                        y = __builtin_amdgcn_mfma_f32_16x16x32_bf16(ccf[ks], af, y, 0, 0, 0); }
                    { const int tok = t0 + 16 * mb + (lane & 15); *(GAS f32x4*)(ybuf + (size_t)tok * DSS + g * 16 + 4 * (lane >> 4)) = y; }
                }
                LDS_WAIT();
            }
          } }
#pragma unroll
          for (int k = 0; k < PF2; ++k) cur[k] = nxt[k];
        }
        if (!PASS2) E[((size_t)(dir * NG + g) * NSEG + seg) * 64 + lane] = (f32x2){sr, si};
        if (PASS2) {
            VM_WAIT(); __syncthreads();
            const int g0 = pi0 & 63, sg = pi0 >> 6, cq = tid & 15, tb = sg * SEGLEN;
            const int te = (tb + SEGLEN < LTOK) ? tb + SEGLEN : LTOK;
            const f32x4 dv = *(const GAS f32x4*)(Dv + g0 * 16 + 4 * cq);
            for (int t0 = tb + (tid >> 4); t0 < te; t0 += 128) {
                f32x4 a1[4], a2[4]; v2u uu[4];
#pragma unroll
                for (int q = 0; q < 4; ++q) { const int t = t0 + 32 * q, tc = t < te ? t : te - 1; const size_t off = (size_t)tc * DSS + g0 * 16 + 4 * cq;
                    a1[q] = *(const GAS f32x4*)(yf + off); a2[q] = *(const GAS f32x4*)(yb + off); uu[q] = *(const GAS v2u*)(u + off); }
#pragma unroll
                for (int q = 0; q < 4; ++q) { const int t = t0 + 32 * q;
                    if (t < te) {
                        const float v0 = a1[q].x + a2[q].x + dv.x * bf_lo(uu[q].x), v1 = a1[q].y + a2[q].y + dv.y * bf_hi(uu[q].x), v2 = a1[q].z + a2[q].z + dv.z * bf_lo(uu[q].y), v3 = a1[q].w + a2[q].w + dv.w * bf_hi(uu[q].y);
                        v2u w; w.x = pk2(pg8::gelu_t(v0), pg8::gelu_t(v1)); w.y = pk2(pg8::gelu_t(v2), pg8::gelu_t(v3));
                        *(GAS v2u*)(sout + pg8::tix(t, g0 * 16 + 4 * cq, DSS)) = w; } }
            }
            __syncthreads();
        }
    }
}

struct Args { const float* in[21]; float* out; unsigned char* ws; int ph_lo, ph_hi; };
__global__ void __launch_bounds__(NWAVES * 64, 2) mk_fwd(Args args) {
    extern __shared__ __attribute__((aligned(16))) unsigned char lds_raw[];
    LAS unsigned char* lds = (LAS unsigned char*)lds_raw;
    const int G = gridDim.x, bx = blockIdx.x, ngw = G * NWAVES, nthr = G * NWAVES * 64;
#define SITE_IDS() int tid = threadIdx.x; asm volatile("" : "+v"(tid)); const int lane = tid & 63, wave = __builtin_amdgcn_readfirstlane(tid >> 6), gw = bx * NWAVES + wave, gtid = bx * (NWAVES * 64) + tid; (void)lane; (void)wave; (void)gw; (void)gtid
    unsigned char* ws = args.ws;
    volatile LAS unsigned* MISC = (volatile LAS unsigned*)(lds + LDSCTL_OFF);
    for (int i = threadIdx.x; i < (LDS_BYTES - LDSCTL_OFF) / 4; i += NWAVES * 64) MISC[i] = 0u;
    __syncthreads();
    const int lo = args.ph_lo, hi = args.ph_hi;
    XcdBarrier bar; bar.bar = (unsigned*)(ws + WS_CTL) + 4096; bar.x = 0; bar.st = nullptr;
    if (hi - lo > 1) bar = xcd_barrier_post((unsigned*)(ws + WS_CTL) + 4096, MISC + 8);
#ifndef SITE_MASK
#define SITE_MASK 0xFFFF
#endif
#define EN(s) ((SITE_MASK >> (s)) & 1)
#define IN(k) (lo <= (k) && (k) < hi)
#define SEAM(k) do { if (IN((k) + 1)) xcd_barrier(bar); } while (0)

    const float* x = args.in[0]; const float* meta = args.in[1];
    signed char* hb8 = (signed char*)(ws + WS_HB8); signed char* wg8 = (signed char*)(ws + WS_WG8); float* rs8b = (float*)(ws + WS_RS8); float* cs8b = (float*)(ws + WS_CS8); float* csub = (float*)(ws + WS_RSTD + 1 * MiB);
    bf16* hb = (bf16*)(ws + WS_H);
    bf16* bgb = (bf16*)(ws + WS_R + R_BG); bf16* cvb = (bf16*)(ws + WS_R + R_CV); bf16* ub = (bf16*)(ws + WS_R + R_U); bf16* gab = (bf16*)(ws + WS_R + R_GA); bf16* gbb = (bf16*)(ws + WS_R + R_GB);
    bf16* ainb = (bf16*)(ws + WS_R + R_AIN); bf16* sb = (bf16*)(ws + WS_R + R_S); bf16* mb = (bf16*)(ws + WS_R + R_M); float* yfb = (float*)(ws + WS_R + R_YF); float* ybb = (float*)(ws + WS_R + R_YB);
    bf16* m1b = (bf16*)(ws + WS_R);
    bf16* dlt = (bf16*)(ws + WS_R + 650 * MiB);     float* rstdb = (float*)(ws + WS_RSTD);
    float* zedge = (float*)(ws + WS_R); float* ztail = (float*)(ws + WS_R + 32 * MiB); bf16* actb = (bf16*)(ws + WS_R + 64 * MiB);
    f32x2* abar = (f32x2*)(ws + WS_ABAR); f32x2* aseg = (f32x2*)(ws + WS_ASEG); bf16* BBt = (bf16*)(ws + WS_BBT); bf16* CCt = (bf16*)(ws + WS_CCT); f32x2* Eb = (f32x2*)(ws + WS_E);

    if (EN(0) && IN(0)) { SITE_IDS();
        LAS float* scr = (LAS float*)(lds + wave * 16640);
        for (int l = 0; l < 2; ++l) {
            unsigned char* wl = ws + WS_W + (size_t)l * W_LAYER;
            convert_matrix(args.in[3] + (size_t)l * DM * NIN, args.in[2] + l * DM, DM, NIN, (bf16*)(wl + W_IN), 1, scr, gw, ngw, lane, 7168);
            convert_matrix(args.in[5] + (size_t)l * DC * DM, nullptr, DC, DM, (bf16*)(wl + W_A), 0, scr, gw, ngw, lane);
            convert_matrix(args.in[14] + (size_t)l * DSS * 2 * DM, nullptr, DSS, 2 * DM, (bf16*)(wl + W_GLU), 2, scr, gw, ngw, lane);
            convert_matrix(args.in[15] + (size_t)l * DM * DM, nullptr, DM, DM, (bf16*)(wl + W_OUT), 0, scr, gw, ngw, lane);
            convert_matrix(args.in[19] + (size_t)l * DFF * DM, nullptr, DFF, DM, (bf16*)(wl + W_DOWN), 0, scr, gw, ngw, lane);
        }
        __syncthreads();
        for (int t = bx; t < 512 + 1536; t += G) {
            if (t < 512) { const int ly = t >> 8, cbk = t & 255;
                weights_i8(lds, args.in[3] + (size_t)ly * DM * NIN, NIN, args.in[2] + ly * DM, wg8 + (size_t)ly * (32 * MiB), cs8b + ly * 8192, 7168 + 32 * cbk, 32 * cbk, wave, lane, tid, -1.44269504089f); }
            else { const int u = t - 512, ly = u / 768, cbk = u % 768;
                weights_i8(lds, args.in[17] + (size_t)ly * DM * 2 * DFF, 2 * DFF, args.in[16] + ly * DM, (signed char*)(ws + WS_W + (size_t)ly * W_LAYER + W_UP), csub + ly * 24576, 32 * cbk, dest_row(2, 2 * DFF, 32 * cbk), wave, lane, tid); }
        }
        if (gtid < 2 * 2 * NG * 64) scan_params(gtid, args.in[6], args.in[7], args.in[8], args.in[9], args.in[10], args.in[11], args.in[12], abar, aseg, BBt, CCt);
        for (int r = gw; r < LTOK; r += ngw) {
            const GAS f32x4* xr = (const GAS f32x4*)(r < NMETA ? meta + (size_t)r * DM : x + (size_t)(r - NMETA) * DM) + 4 * lane;
            float s = 0.f; float vv[4][16];
#pragma unroll
            for (int j = 0; j < 4; ++j)
#pragma unroll
                for (int q = 0; q < 4; ++q) { const f32x4 v = xr[256 * j + q]; vv[j][4 * q] = v.x; vv[j][4 * q + 1] = v.y; vv[j][4 * q + 2] = v.z; vv[j][4 * q + 3] = v.w; }
#pragma unroll
            for (int j = 0; j < 4; ++j) {
#pragma unroll
                for (int e = 0; e < 16; ++e) s += vv[j][e] * vv[j][e];
                bf16* hp = hb + pg8::tix(r, 16 * lane + 1024 * j, DM);
#pragma unroll
                for (int h = 0; h < 2; ++h) { v4u w; w.x = pk2(vv[j][8 * h], vv[j][8 * h + 1]); w.y = pk2(vv[j][8 * h + 2], vv[j][8 * h + 3]); w.z = pk2(vv[j][8 * h + 4], vv[j][8 * h + 5]); w.w = pk2(vv[j][8 * h + 6], vv[j][8 * h + 7]);
                    *(GAS v4u*)(hp + 8 * h) = w; } }
            s = wave_sum(s);
            const float rstd_r = 1.0f / sqrtf(s * (1.0f / DM) + EPS);
            if (lane == 0) rstdb[r] = rstd_r;
            { const float ms = quant_row8x(vv, hb8, r, lane); if (lane == 0) rs8b[r] = ms * rstd_r; }
        }
        SEAM(0);
    }
    for (int l = 0; l < 2; ++l) {
        const int pb = 1 + 11 * l;
        unsigned char* wl = ws + WS_W + (size_t)l * W_LAYER;
        if (EN(1) && IN(pb + 0) && l > 0) { SITE_IDS(); stat_phase(hb, rstdb, hb8, rs8b, LTOK, gw, ngw, lane); SEAM(pb + 0); }
        if (EN(2) && IN(pb + 1)) {
            pg8::Gemm g{hb, (const bf16*)(wl + W_IN), MG, 7168, DM}; pg8::StaticOrder S; S.init(MG, 7168, G, bx);
            pg8::EpiIn E{bgb, cvb, ub, gab, gbb, rstdb};
            pg8::gemm_phase<pg8::EpiIn, pg8::StaticOrder, true, true, true, WTILED>(lds, g, S, E);
            { pg8::Gemm g8{(const bf16*)hb8, (const bf16*)(wg8 + (size_t)l * (32 * MiB)), MG, 8192, 2048}; pg8::StaticOrder S8; S8.init(MG, 8192, G, bx);
              pg8::EpiGate8 E8{pg8::EpiIn{bgb, cvb, ub, gab, gbb, rs8b}, cs8b + l * 8192};
              pg8::gemm_phase<pg8::EpiGate8, pg8::StaticOrder, true, true, true, true, true>(lds, g8, S8, E8); }
            pg8::tail_gemm<decltype(E), WTILED>(lds, hb, (const bf16*)(wl + W_IN), 7168, DM, MG, E);
            { pg8::EpiGate8 E8{pg8::EpiIn{bgb, cvb, ub, gab, gbb, rs8b}, cs8b + l * 8192}; pg8::tail_gemm<decltype(E8), true, true>(lds, (const bf16*)hb8, (const bf16*)(wg8 + (size_t)l * (32 * MiB)), 8192, 2048, MG, E8); }
            SEAM(pb + 1);
        }
        if (EN(3) && IN(pb + 2)) { SITE_IDS();
            scan_pass1_reg(l, ub, abar, BBt, Eb, wave, lane);
            conv_a_phase(bgb, cvb, args.in[4] + l * 3 * DC, ainb, gtid, nthr);
            SEAM(pb + 2);
        }
        if (EN(4) && IN(pb + 3)) { SITE_IDS();
            scan_pass<true>(lds, l, ub, abar, aseg, BBt, CCt, Eb, yfb, ybb, args.in[13] + l * DSS, sb, wave, lane, tid);
        }
        if (EN(5) && IN(pb + 3)) {
            pg8::Gemm g{ainb, (const bf16*)(wl + W_A), MG, DM, DC}; pg8::StaticOrder S; S.init(MG, DM, G, bx);
            pg8::EpiMulGate E{gab, m1b};
            pg8::gemm_phase<pg8::EpiMulGate, pg8::StaticOrder, true, true, true, WTILED>(lds, g, S, E);
            pg8::tail_gemm<decltype(E), WTILED>(lds, ainb, (const bf16*)(wl + W_A), DM, DC, MG, E);
            SEAM(pb + 4);
        }
        if (EN(6) && IN(pb + 5)) {
            pg8::Gemm g{sb, (const bf16*)(wl + W_GLU), MG, 2 * DM, DSS}; pg8::StaticOrder S; S.init(MG, 2 * DM, G, bx);
            pg8::EpiGlu E{gbb, m1b, mb};
            pg8::gemm_phase<pg8::EpiGlu, pg8::StaticOrder, true, true, true, WTILED>(lds, g, S, E);
            pg8::tail_gemm<decltype(E), WTILED>(lds, sb, (const bf16*)(wl + W_GLU), 2 * DM, DSS, MG, E);
            SEAM(pb + 5);
        }
        if (EN(7) && IN(pb + 6)) {
            pg8::Gemm g{mb, (const bf16*)(wl + W_OUT), MG, DM, DM}; pg8::StaticOrder S; S.init(MG, DM, G, bx);
            pg8::EpiResid E{hb, dlt, true};
            pg8::gemm_phase<pg8::EpiResid, pg8::StaticOrder, true, true, true, WTILED>(lds, g, S, E);
            pg8::tail_gemm<decltype(E), WTILED>(lds, mb, (const bf16*)(wl + W_OUT), DM, DM, MG, E);
            SEAM(pb + 6);
        }
        if (EN(8) && IN(pb + 7)) { SITE_IDS(); stat_phase(hb, rstdb, hb8, rs8b, LTOK, gw, ngw, lane); SEAM(pb + 7); }
        if (EN(9) && IN(pb + 8)) {
            unsigned char* wsl = ws; asm volatile("" : "+s"(wsl));
            const bf16* a8 = (const bf16*)(wsl + WS_HB8); const bf16* w8 = (const bf16*)(wsl + WS_W + (size_t)l * W_LAYER + W_UP);
            pg8::Gemm g{a8, w8, MG, 2 * DFF, 2048}; pg8::StaticOrder S; S.init(MG, 2 * DFF, G, bx);
            pg8::EpiUp8 E{pg8::EpiUpConv{args.in[18] + (size_t)l * 3 * 2 * DFF, (bf16*)(wsl + WS_R + 64 * MiB), (float*)(wsl + WS_R), (LAS float*)(lds + pg8::STAGE_BYTES), (float*)(wsl + WS_R + 32 * MiB), (const float*)(wsl + WS_RS8), (const float*)(wsl + WS_RSTD + 1 * MiB) + l * 24576}};
            pg8::gemm_phase<pg8::EpiUp8, pg8::StaticOrder, true, true, true, true, true>(lds, g, S, E);
            pg8::tail_gemm<decltype(E), true, true>(lds, a8, w8, 2 * DFF, 2048, MG, E);
            SEAM(pb + 8);
        }
        if (EN(10) && IN(pb + 9)) { SITE_IDS(); conv_edge_phase(zedge, ztail, args.in[18] + (size_t)l * 3 * 2 * DFF, actb, gtid, nthr); SEAM(pb + 9); }
        if (EN(11) && IN(pb + 10)) {
            pg8::Gemm g{actb, (const bf16*)(wl + W_DOWN), MG, DM, DFF}; pg8::StaticOrder S; S.init(MG, DM, G, bx);
            pg8::EpiResid E{hb, dlt, l == 0};
            pg8::gemm_phase<pg8::EpiResid, pg8::StaticOrder, true, true, true, WTILED>(lds, g, S, E);
            pg8::tail_gemm<decltype(E), WTILED>(lds, actb, (const bf16*)(wl + W_DOWN), DM, DFF, MG, E);
            SEAM(pb + 10);
        }
    }
    if (EN(12) && IN(23)) { SITE_IDS(); final_norm(hb, NMETA, dlt + (size_t)NMETA * DM, args.in[20], args.out, SEQ, gw, ngw, lane); }
#undef IN
#undef SEAM
}

extern "C" void kernel_launch(void* const* d_in, const int* in_sizes, int n_in, void* d_out, int out_size, void* d_ws, size_t ws_size, hipStream_t stream) {
    static int grid = 0;
    if (grid == 0) {
        if (n_in != 21 || out_size != SEQ * DM || ws_size < WS_END) { fprintf(stderr, "kernel_launch: unexpected shapes: n_in %d out %d ws %zu (need %zu)\n", n_in, out_size, ws_size, (size_t)WS_END); grid = -1; return; }
        int dev = 0, cus = 0, per_cu = 0;
        if (hipGetDevice(&dev) != hipSuccess || hipDeviceGetAttribute(&cus, hipDeviceAttributeMultiprocessorCount, dev) != hipSuccess) { grid = -1; return; }
        if (hipFuncSetAttribute((const void*)mk_fwd, hipFuncAttributeMaxDynamicSharedMemorySize, LDS_BYTES) != hipSuccess) { fprintf(stderr, "kernel_launch: hipFuncSetAttribute failed\n"); grid = -1; return; }
        if (hipOccupancyMaxActiveBlocksPerMultiprocessor(&per_cu, (const void*)mk_fwd, NWAVES * 64, LDS_BYTES) != hipSuccess || per_cu < 1) { fprintf(stderr, "kernel_launch: occupancy query says %d\n", per_cu); }
        (void)hipGetLastError();
        grid = cus;
    }
    if (grid < 0) return;
    if (hipMemsetAsync((char*)d_ws + WS_CTL, 0, CTL_ZERO_BYTES, stream) != hipSuccess) return;
    Args a{};
    for (int i = 0; i < 21; ++i) a.in[i] = (const float*)d_in[i];
    a.out = (float*)d_out; a.ws = (unsigned char*)d_ws;
#if MK_N_LAUNCHES == 1
    a.ph_lo = 0; a.ph_hi = NPH;
    hipLaunchKernelGGL(mk_fwd, dim3(grid), dim3(NWAVES * 64), LDS_BYTES, stream, a);
#else
    for (int p = 0; p < NPH; ++p) { a.ph_lo = p; a.ph_hi = p + 1; hipLaunchKernelGGL(mk_fwd, dim3(grid), dim3(NWAVES * 64), LDS_BYTES, stream, a); }
#endif
}
```
